# Optimizing an MI355X kernel written in HIP

```python
import math
import jax
import jax.numpy as jnp
from jax import lax
import numpy as np

D_MODEL = 1024
BATCH = 2
SEQ = 8192
DEPTH = 2

GRID_W = 64
CTX_LEN = 256
N_DIRS = 2
NORM_EPS = 1e-6
D_MIX = D_MODEL

DA_HEADS = 4
DA_QK_DIM = 64
DA_V_DIM = 2 * DA_QK_DIM
DA_WIDTH = DA_HEADS * DA_V_DIM
DA_Q_BLOCK = 128
ROPE_BASE = 10000.0
ROPE_FREQS = DA_QK_DIM // 4

GDN_HEADS = 4
GDN_HEAD_DIM = 64
GDN_WIDTH = GDN_HEADS * GDN_HEAD_DIM
GDN_CONV = 5
GDN_CHUNK = 64

RWKV_HEADS = 4
RWKV_HEAD_DIM = 64
RWKV_WIDTH = RWKV_HEADS * RWKV_HEAD_DIM
RWKV_W_LORA = 32
RWKV_A_LORA = 32
RWKV_G_LORA = 64
RWKV_DECAY_SCALE = 0.6065306597126334
RWKV_GN_EPS = 64e-5

N_EXPERTS = 16
EC_CAPACITY_FACTOR = 2
D_EXPERT = 1024

IN_SIZES = (DA_HEADS * 2 * DA_QK_DIM, DA_HEADS * 2 * DA_QK_DIM, DA_WIDTH,
            3 * GDN_WIDTH, GDN_WIDTH, N_DIRS * GDN_HEADS, N_DIRS * GDN_HEADS,
            3 * RWKV_WIDTH, RWKV_W_LORA, RWKV_A_LORA, RWKV_G_LORA)
D_IN = sum(IN_SIZES)

kernel_name = 'hybrid_parallel_heads_diffusion_trunk'


def _rmsnorm(x, g):
    xf = x.astype(jnp.float32)
    y = xf * lax.rsqrt(jnp.mean(xf * xf, axis=-1, keepdims=True) + NORM_EPS)
    return (y * g.astype(jnp.float32)).astype(x.dtype)


def _l2norm(x):
    return x * lax.rsqrt(jnp.sum(x * x, axis=-1, keepdims=True) + 1e-12)


def _flip(t):
    return jnp.flip(t, axis=1)


def _ident(t):
    return t


def _modulation(cond, w, b, dtype):
    m = jnp.dot(cond, w.astype(jnp.float32)) + b.astype(jnp.float32)
    return [t.astype(dtype) for t in jnp.split(m[:, None, :], 6, axis=-1)]


def _modulate(h, shift, scale):
    return h * (1 + scale) + shift


def _split_cols(p):
    out, off = [], 0
    for n in IN_SIZES:
        out.append(p[..., off:off + n])
        off += n
    return out


def _axial_rope_tables(rows):
    row = jnp.repeat(jnp.arange(rows, dtype=jnp.float32), GRID_W)
    col = jnp.tile(jnp.arange(GRID_W, dtype=jnp.float32), rows)
    freqs = ROPE_BASE ** (-jnp.arange(ROPE_FREQS, dtype=jnp.float32) / ROPE_FREQS)
    ang = jnp.stack([row[:, None] * freqs, col[:, None] * freqs], axis=1)
    return jnp.cos(ang), jnp.sin(ang)


def _rope_2d(x, cos, sin):
    shp = x.shape
    xs = x.astype(jnp.float32).reshape(shp[:-1] + (2, 2, ROPE_FREQS))
    x1, x2 = xs[..., 0, :], xs[..., 1, :]
    cb, sb = cos[None, :, None, None], sin[None, :, None, None]
    y = jnp.stack([x1 * cb - x2 * sb, x2 * cb + x1 * sb], axis=-2)
    return y.reshape(shp).astype(x.dtype)


def _da_heads(p):
    B, T, _ = p[0].shape
    q = p[0].reshape(B, T, DA_HEADS, 2, DA_QK_DIM)
    k = p[1].reshape(B, T, DA_HEADS, 2, DA_QK_DIM)
    v = p[2].reshape(B, T, DA_HEADS, DA_V_DIM)
    return q, k, v


def _diff_lambda(lv, lam_init):
    lv = lv.astype(jnp.float32)
    return jnp.exp(jnp.sum(lv[0] * lv[1])) - jnp.exp(jnp.sum(lv[2] * lv[3])) + lam_init


def _diff_attention(q_c, k_c, v_c, q_l, k_l, v_l, cos, sin, lam, lam_init, norm_g, need_ctx):
    dtype = v_l.dtype
    scale = DA_QK_DIM ** -0.5
    q_l = _rope_2d(q_l, cos, sin)
    k_l = _rope_2d(k_l, cos, sin)
    k_all = jnp.concatenate([k_c, k_l], axis=1)
    v_all = jnp.concatenate([v_c, v_l], axis=1).astype(jnp.float32)

    def attend(q, k, v):
        s = jnp.einsum('bqhmd,bkhmd->bhmqk', q, k, preferred_element_type=jnp.float32) * scale
        p = jax.nn.softmax(s, axis=-1)
        w = p[:, :, 0] - lam * p[:, :, 1]
        return jnp.einsum('bhqk,bkhd->bqhd', w, v)

    def finish(o):
        B, T = o.shape[:2]
        return (_rmsnorm(o, norm_g) * (1.0 - lam_init)).reshape(B, T, DA_WIDTH).astype(dtype)

    B, T = q_l.shape[:2]
    n_blk = T // DA_Q_BLOCK
    q_blocks = jnp.swapaxes(q_l.reshape((B, n_blk, DA_Q_BLOCK) + q_l.shape[2:]), 0, 1)
    o_l = lax.map(lambda qb: attend(qb, k_all, v_all), q_blocks)
    o_l = jnp.swapaxes(o_l, 0, 1).reshape(B, T, DA_HEADS, DA_V_DIM)
    o_c = finish(attend(q_c, k_c, v_c.astype(jnp.float32))) if need_ctx else None
    return o_c, finish(o_l)


def _short_conv(x, w):
    pad = GDN_CONV // 2
    y = lax.conv_general_dilated(x, w[:, None, :].astype(x.dtype), window_strides=(1,), padding=[(pad, pad)],
                                 dimension_numbers=('NWC', 'WIO', 'NWC'), feature_group_count=x.shape[-1])
    return jax.nn.silu(y)


def _gdn_prepare(qkv, a_in, b_in, conv_w, a_log, dt_bias):
    B, T, _ = qkv.shape
    qkv = _short_conv(qkv, conv_w).astype(jnp.float32).reshape(B, T, 3, GDN_HEADS, GDN_HEAD_DIM)
    q = _l2norm(qkv[:, :, 0]) * GDN_HEAD_DIM ** -0.5
    k = _l2norm(qkv[:, :, 1])
    v = qkv[:, :, 2]
    a = a_in.astype(jnp.float32).reshape(B, T, N_DIRS, GDN_HEADS)
    g = -jnp.exp(a_log.astype(jnp.float32)) * jax.nn.softplus(a + dt_bias.astype(jnp.float32))
    beta = jax.nn.sigmoid(b_in.astype(jnp.float32).reshape(B, T, N_DIRS, GDN_HEADS))
    return q, k, v, g, beta


def _gdn_chunked(q, k, v, g, beta, s0):
    B, T, H, _ = q.shape
    C = GDN_CHUNK
    n = T // C

    def chunks(t):
        t = t.reshape((B, n, C, H) + t.shape[3:])
        return jnp.moveaxis(t, (1, 3), (0, 2))

    qc, kc, vc, gch, bch = (chunks(t) for t in (q, k, v, g, beta))
    gcum = jnp.cumsum(gch, axis=-1)
    incl = jnp.tril(jnp.ones((C, C), dtype=bool))
    strict = jnp.tril(jnp.ones((C, C), dtype=bool), -1)
    decay = jnp.exp(jnp.where(incl, gcum[..., :, None] - gcum[..., None, :], -jnp.inf))
    kb = kc * bch[..., None]
    a_mat = jnp.where(strict, jnp.einsum('nbhid,nbhjd->nbhij', kb, kc) * decay, 0.0)
    eye = jnp.eye(C, dtype=jnp.float32)
    t_inv = lax.linalg.triangular_solve(eye + a_mat, jnp.broadcast_to(eye, a_mat.shape),
                                        left_side=True, lower=True, unit_diagonal=True)
    u = jnp.einsum('nbhij,nbhjd->nbhid', t_inv, vc * bch[..., None])
    w = jnp.einsum('nbhij,nbhjd->nbhid', t_inv, kb * jnp.exp(gcum)[..., None])
    qk = jnp.einsum('nbhid,nbhjd->nbhij', qc, kc) * decay
    q_dec = qc * jnp.exp(gcum)[..., None]
    k_dec = kc * jnp.exp(gcum[..., -1:] - gcum)[..., None]
    g_tot = jnp.exp(gcum[..., -1])

    def step(s, xs):
        u_i, w_i, qk_i, qd_i, kd_i, gt_i = xs
        v_new = u_i - jnp.einsum('bhid,bhdv->bhiv', w_i, s)
        o_i = jnp.einsum('bhid,bhdv->bhiv', qd_i, s) + jnp.einsum('bhij,bhjv->bhiv', qk_i, v_new)
        s = s * gt_i[..., None, None] + jnp.einsum('bhid,bhiv->bhdv', kd_i, v_new)
        return s, o_i

    s_fin, o = lax.scan(step, s0, (u, w, qk, q_dec, k_dec, g_tot))
    o = jnp.moveaxis(o, (0, 2), (1, 3)).reshape(B, T, H, v.shape[-1])
    return s_fin, o


def _gdn_out(o, gate, norm_g, dtype):
    B, T = o.shape[:2]
    y = _rmsnorm(o, norm_g) * jax.nn.silu(gate.astype(jnp.float32).reshape(B, T, GDN_HEADS, GDN_HEAD_DIM))
    return y.reshape(B, T, GDN_WIDTH).astype(dtype)


def _gdn_mixer(p_c, p_l, conv_w, a_log, dt_bias, norm_g):
    dtype = p_l[3].dtype
    qc, kc, vc, gc, bc = _gdn_prepare(p_c[3], p_c[5], p_c[6], conv_w, a_log, dt_bias)
    ql, kl, vl, gl, bl = _gdn_prepare(p_l[3], p_l[5], p_l[6], conv_w, a_log, dt_bias)
    s0 = jnp.zeros((ql.shape[0], GDN_HEADS, GDN_HEAD_DIM, GDN_HEAD_DIM), jnp.float32)
    o_c, o_l = [], []
    for d in range(N_DIRS):
        f = _flip if d == 1 else _ident
        s_c, oc = _gdn_chunked(f(qc), f(kc), f(vc), f(gc[:, :, d]), f(bc[:, :, d]), s0)
        _, ol = _gdn_chunked(f(ql), f(kl), f(vl), f(gl[:, :, d]), f(bl[:, :, d]), s_c)
        o_c.append(f(oc))
        o_l.append(f(ol))
    return (_gdn_out(o_c[0] + o_c[1], p_c[4], norm_g, dtype),
            _gdn_out(o_l[0] + o_l[1], p_l[4], norm_g, dtype))


def _rwkv_prepare(rkv, xw, xa, xg, w0, w_up, a0, a_up, g_up, k_k, k_a):
    rkv, xw, xa, xg = (t.astype(jnp.float32) for t in (rkv, xw, xa, xg))
    B, T, _ = rkv.shape

    def heads(t):
        return t.reshape(B, T, RWKV_HEADS, RWKV_HEAD_DIM)

    r, k, v = rkv[..., :RWKV_WIDTH], rkv[..., RWKV_WIDTH:2 * RWKV_WIDTH], rkv[..., 2 * RWKV_WIDTH:]
    kk = _l2norm(heads(k * k_k))
    g = jnp.dot(jax.nn.sigmoid(xg), g_up.astype(jnp.float32))
    decay, a, kd = [], [], []
    for d in range(N_DIRS):
        logw = -RWKV_DECAY_SCALE * jax.nn.sigmoid(w0[d] + jnp.dot(jnp.tanh(xw), w_up[d].astype(jnp.float32)))
        a_d = jax.nn.sigmoid(a0[d] + jnp.dot(xa, a_up[d].astype(jnp.float32)))
        decay.append(heads(jnp.exp(logw)))
        a.append(heads(a_d))
        kd.append(heads(k * (1.0 + (a_d - 1.0) * k_a)))
    return heads(r), heads(v), kk, g, decay, a, kd


def _rwkv_scan(r, w, k, v, kk, a, s0):
    def step(s, xs):
        r_t, w_t, k_t, v_t, kk_t, a_t = xs
        read = jnp.einsum('bhk,bhkv->bhv', -kk_t, s)
        s = w_t[..., :, None] * s + (kk_t * a_t)[..., :, None] * read[..., None, :] + k_t[..., :, None] * v_t[..., None, :]
        return s, jnp.einsum('bhk,bhkv->bhv', r_t, s)

    xs = tuple(jnp.moveaxis(t, 1, 0) for t in (r, w, k, v, kk, a))
    s_fin, y = lax.scan(step, s0, xs)
    return s_fin, jnp.moveaxis(y, 0, 1)


def _rwkv_out(y, prep, r_k, gn_w, gn_b, dtype):
    r, v, _, g, _, _, kd = prep
    B, T = y.shape[:2]
    mu = jnp.mean(y, axis=-1, keepdims=True)
    var = jnp.mean(jnp.square(y - mu), axis=-1, keepdims=True)
    yn = ((y - mu) * lax.rsqrt(var + RWKV_GN_EPS)).reshape(B, T, RWKV_WIDTH) * gn_w + gn_b
    bonus = (jnp.sum(r * (kd[0] + kd[1]) * r_k, axis=-1, keepdims=True) * v).reshape(B, T, RWKV_WIDTH)
    return ((yn + bonus) * g).astype(dtype)


def _rwkv_mixer(p_c, p_l, w0, w_up, a0, a_up, g_up, k_k, k_a, r_k, gn_w, gn_b):
    dtype = p_l[7].dtype
    prm = (w0, w_up, a0, a_up, g_up, k_k, k_a)
    c_in = _rwkv_prepare(p_c[7], p_c[8], p_c[9], p_c[10], *prm)
    l_in = _rwkv_prepare(p_l[7], p_l[8], p_l[9], p_l[10], *prm)
    rc, vc, kkc, _, wc, ac, kc = c_in
    rl, vl, kkl, _, wl, al, kl = l_in
    s0 = jnp.zeros((rl.shape[0], RWKV_HEADS, RWKV_HEAD_DIM, RWKV_HEAD_DIM), jnp.float32)
    y_c, y_l = [], []
    for d in range(N_DIRS):
        f = _flip if d == 1 else _ident
        s_c, yc = _rwkv_scan(f(rc), f(wc[d]), f(kc[d]), f(vc), f(kkc), f(ac[d]), s0)
        _, yl = _rwkv_scan(f(rl), f(wl[d]), f(kl[d]), f(vl), f(kkl), f(al[d]), s_c)
        y_c.append(f(yc))
        y_l.append(f(yl))
    return (_rwkv_out(y_c[0] + y_c[1], c_in, r_k, gn_w, gn_b, dtype),
            _rwkv_out(y_l[0] + y_l[1], l_in, r_k, gn_w, gn_b, dtype))


def _expert_choice_moe(h, router, w_gate, w_up, w_down):
    B, T, _ = h.shape
    cap = EC_CAPACITY_FACTOR * T // N_EXPERTS
    logits = jnp.einsum('btd,de->bte', h, router, preferred_element_type=jnp.float32)
    aff = jax.nn.softmax(logits, axis=-1)
    top_aff, top_idx = lax.top_k(jnp.swapaxes(aff, 1, 2), cap)
    b_idx = jnp.arange(B)[:, None, None]
    xe = h[b_idx, top_idx]
    hid = jax.nn.silu(jnp.einsum('becd,edf->becf', xe, w_gate)) * jnp.einsum('becd,edf->becf', xe, w_up)
    ye = jnp.einsum('becf,efd->becd', hid, w_down) * top_aff[..., None].astype(h.dtype)
    return jnp.zeros_like(h).at[b_idx, top_idx].add(ye.astype(h.dtype))


def setup_inputs(seed: int = 0) -> dict:
    key = jax.random.key(seed)
    ks = jax.random.split(key, 32)
    f32 = jnp.float32
    D = D_MODEL

    def nrm(i, shape, s):
        return jax.random.normal(ks[i], shape, f32) * s

    dt = jnp.exp(jax.random.uniform(ks[14], (DEPTH, N_DIRS, GDN_HEADS), f32, math.log(1e-3), math.log(1e-1)))
    return {
        'x': nrm(0, (BATCH, SEQ, D), 1.0),
        'c': nrm(1, (BATCH, D), 1.0),
        'ctx': nrm(2, (BATCH, CTX_LEN, D), 1.0),
        'c_ctx': nrm(3, (D,), 1.0),
        'w_mod': nrm(4, (DEPTH, D, 6 * D), 0.5 * D ** -0.5),
        'b_mod': nrm(5, (DEPTH, 6 * D), 0.02),
        'norm_pre': 1.0 + nrm(6, (DEPTH, 2, D), 0.02),
        'norm_post': 1.0 + nrm(7, (DEPTH, 2, D), 0.02),
        'w_in': nrm(8, (DEPTH, D, D_IN), D ** -0.5),
        'w_out': nrm(9, (DEPTH, D_MIX, D), D_MIX ** -0.5),
        'da_lambda': nrm(10, (DEPTH, 4, DA_QK_DIM), 0.1),
        'da_norm': 1.0 + nrm(11, (DEPTH, DA_V_DIM), 0.02),
        'gdn_conv': nrm(12, (DEPTH, GDN_CONV, 3 * GDN_WIDTH), GDN_CONV ** -0.5),
        'gdn_a_log': jnp.log(jax.random.uniform(ks[13], (DEPTH, N_DIRS, GDN_HEADS), f32, 1.0, 16.0)),
        'gdn_dt_bias': dt + jnp.log(-jnp.expm1(-dt)),
        'gdn_norm': 1.0 + nrm(15, (DEPTH, GDN_HEAD_DIM), 0.02),
        'rwkv_w0': nrm(16, (DEPTH, N_DIRS, RWKV_WIDTH), 1.0),
        'rwkv_w_up': nrm(17, (DEPTH, N_DIRS, RWKV_W_LORA, RWKV_WIDTH), 0.1),
        'rwkv_a0': nrm(18, (DEPTH, N_DIRS, RWKV_WIDTH), 0.5),
        'rwkv_a_up': nrm(19, (DEPTH, N_DIRS, RWKV_A_LORA, RWKV_WIDTH), 0.1),
        'rwkv_g_up': nrm(20, (DEPTH, RWKV_G_LORA, RWKV_WIDTH), RWKV_G_LORA ** -0.5),
        'rwkv_k_k': 0.85 + nrm(21, (DEPTH, RWKV_WIDTH), 0.02),
        'rwkv_k_a': 1.0 + nrm(22, (DEPTH, RWKV_WIDTH), 0.02),
        'rwkv_r_k': nrm(23, (DEPTH, RWKV_HEADS, RWKV_HEAD_DIM), 0.1),
        'rwkv_gn_w': 1.0 + nrm(24, (DEPTH, RWKV_WIDTH), 0.02),
        'rwkv_gn_b': nrm(25, (DEPTH, RWKV_WIDTH), 0.02),
        'moe_router': nrm(26, (DEPTH, D, N_EXPERTS), D ** -0.5),
        'moe_w_gate': nrm(27, (DEPTH, N_EXPERTS, D, D_EXPERT), D ** -0.5),
        'moe_w_up': nrm(28, (DEPTH, N_EXPERTS, D, D_EXPERT), D ** -0.5),
        'moe_w_down': nrm(29, (DEPTH, N_EXPERTS, D_EXPERT, D), D_EXPERT ** -0.5),
    }


def reference(x, c, ctx, c_ctx, w_mod, b_mod, norm_pre, norm_post, w_in, w_out,
              da_lambda, da_norm, gdn_conv, gdn_a_log, gdn_dt_bias, gdn_norm,
              rwkv_w0, rwkv_w_up, rwkv_a0, rwkv_a_up, rwkv_g_up, rwkv_k_k, rwkv_k_a,
              rwkv_r_k, rwkv_gn_w, rwkv_gn_b, moe_router, moe_w_gate, moe_w_up, moe_w_down):
    dtype = x.dtype
    T = x.shape[1]
    ROWS = T // GRID_W
    cos, sin = _axial_rope_tables(ROWS)
    cond_lat = jax.nn.silu(c.astype(jnp.float32))
    cond_ctx = jax.nn.silu(c_ctx.astype(jnp.float32))[None, :]
    x_lat, x_ctx = x, ctx.astype(dtype)
    for i in range(DEPTH):
        last = i == DEPTH - 1
        sh1_l, sc1_l, gt1_l, sh2_l, sc2_l, gt2_l = _modulation(cond_lat, w_mod[i], b_mod[i], dtype)
        sh1_c, sc1_c, gt1_c, sh2_c, sc2_c, gt2_c = _modulation(cond_ctx, w_mod[i], b_mod[i], dtype)

        h_c = _modulate(_rmsnorm(x_ctx, norm_pre[i, 0]), sh1_c, sc1_c)
        h_l = _modulate(_rmsnorm(x_lat, norm_pre[i, 0]), sh1_l, sc1_l)
        p_c = _split_cols(h_c @ w_in[i])
        p_l = _split_cols(h_l @ w_in[i])
        lam_init = 0.8 - 0.6 * math.exp(-0.3 * i)
        lam = _diff_lambda(da_lambda[i], lam_init)
        a_c, a_l = _diff_attention(*_da_heads(p_c), *_da_heads(p_l), cos, sin, lam, lam_init, da_norm[i], not last)
        g_c, g_l = _gdn_mixer(p_c, p_l, gdn_conv[i], gdn_a_log[i], gdn_dt_bias[i], gdn_norm[i])
        r_c, r_l = _rwkv_mixer(p_c, p_l, rwkv_w0[i], rwkv_w_up[i], rwkv_a0[i], rwkv_a_up[i], rwkv_g_up[i],
                               rwkv_k_k[i], rwkv_k_a[i], rwkv_r_k[i], rwkv_gn_w[i], rwkv_gn_b[i])
        mix_l = jnp.concatenate([a_l, g_l, r_l], axis=-1) @ w_out[i]
        x_lat = x_lat + gt1_l * _rmsnorm(mix_l, norm_post[i, 0])
        if not last:
            mix_c = jnp.concatenate([a_c, g_c, r_c], axis=-1) @ w_out[i]
            x_ctx = x_ctx + gt1_c * _rmsnorm(mix_c, norm_post[i, 0])

        h_l = _modulate(_rmsnorm(x_lat, norm_pre[i, 1]), sh2_l, sc2_l)
        y_l = _expert_choice_moe(h_l, moe_router[i], moe_w_gate[i], moe_w_up[i], moe_w_down[i])
        x_lat = x_lat + gt2_l * _rmsnorm(y_l, norm_post[i, 1])
        if not last:
            h_c = _modulate(_rmsnorm(x_ctx, norm_pre[i, 1]), sh2_c, sc2_c)
            y_c = _expert_choice_moe(h_c, moe_router[i], moe_w_gate[i], moe_w_up[i], moe_w_down[i])
            x_ctx = x_ctx + gt2_c * _rmsnorm(y_c, norm_post[i, 1])
    return x_lat
```

```cpp
#include <hip/hip_runtime.h>
#include <stdint.h>
#include <stdio.h>

#define NB 2
#define TL 8192
#define CL 256
#define SS 8448
#define RR 16896
#define DM 1024
#define DIN 3472
#define NE 16
#define CAPL 1024
#define CAPC 32
#define OQ 0
#define OKK 512
#define OV 1024
#define OGQKV 1536
#define OGGATE 2304
#define OGA 2560
#define OGB 2568
#define ORKV 2576
#define OXW 3344
#define OXA 3376
#define OXG 3408

__device__ __forceinline__ float siluf(float x) { return x / (1.f + expf(-x)); }
__device__ __forceinline__ float sigmf(float x) { return 1.f / (1.f + expf(-x)); }
__device__ __forceinline__ float wave_sum(float v) {
#pragma unroll
    for (int o = 1; o < 64; o <<= 1) v += __shfl_xor(v, o);
    return v;
}
__device__ __forceinline__ float* xrow_ptr(float* ctxs, float* out, int r) {
    int b = r / SS, s = r % SS;
    return s < CL ? ctxs + ((size_t)(b * CL + s)) * DM : out + ((size_t)(b * TL + (s - CL))) * DM;
}
__device__ __forceinline__ int modrow(int r) { int b = r / SS, s = r % SS; return s < CL ? 2 : b; }

__global__ void k_init(const float* __restrict__ x, const float* __restrict__ ctx, float* out, float* ctxs) {
    size_t i = (size_t)blockIdx.x * blockDim.x + threadIdx.x;
    size_t n1 = (size_t)NB * TL * DM / 4, n2 = (size_t)NB * CL * DM / 4;
    for (size_t j = i; j < n1; j += (size_t)gridDim.x * blockDim.x) ((float4*)out)[j] = ((const float4*)x)[j];
    for (size_t j = i; j < n2; j += (size_t)gridDim.x * blockDim.x) ((float4*)ctxs)[j] = ((const float4*)ctx)[j];
}

__global__ void k_mod(const float* __restrict__ c, const float* __restrict__ c_ctx, const float* __restrict__ w_mod,
                      const float* __restrict__ b_mod, float* mod) {
    __shared__ float cs[3][DM];
    for (int i = threadIdx.x; i < DM; i += blockDim.x) {
        cs[0][i] = siluf(c[i]); cs[1][i] = siluf(c[DM + i]); cs[2][i] = siluf(c_ctx[i]);
    }
    __syncthreads();
    int idx = blockIdx.x * blockDim.x + threadIdx.x;
    int l = idx / (6 * DM), n = idx % (6 * DM);
    const float* w = w_mod + (size_t)l * DM * 6 * DM + n;
    float a0 = 0.f, a1 = 0.f, a2 = 0.f;
    for (int k = 0; k < DM; ++k) { float wv = w[(size_t)k * 6 * DM]; a0 += cs[0][k] * wv; a1 += cs[1][k] * wv; a2 += cs[2][k] * wv; }
    float bb = b_mod[l * 6 * DM + n];
    mod[(l * 3 + 0) * 6 * DM + n] = a0 + bb;
    mod[(l * 3 + 1) * 6 * DM + n] = a1 + bb;
    mod[(l * 3 + 2) * 6 * DM + n] = a2 + bb;
}

__global__ void k_normmod(float* ctxs, float* out, const float* __restrict__ g, const float* __restrict__ modl, int sh_off, int sc_off, float* h) {
    int r = blockIdx.x * 4 + (threadIdx.x >> 6), lane = threadIdx.x & 63;
    const float* x = xrow_ptr(ctxs, out, r);
    const float* m = modl + modrow(r) * 6 * DM;
    float v[16]; float ss = 0.f;
#pragma unroll
    for (int j = 0; j < 16; ++j) { v[j] = x[lane + 64 * j]; ss += v[j] * v[j]; }
    ss = wave_sum(ss);
    float rstd = rsqrtf(ss * (1.f / DM) + 1e-6f);
#pragma unroll
    for (int j = 0; j < 16; ++j) { int cidx = lane + 64 * j; h[(size_t)r * DM + cidx] = v[j] * rstd * g[cidx] * (1.f + m[sc_off + cidx]) + m[sh_off + cidx]; }
}

struct GP {
    const float* A; int lda; const int* gidx; long a_gstride; int gidx_gstride;
    const float* B; const float* B2; int ldb; long b_estride;
    float* C; int ldc; long c_gstride;
    const float* aff;
    int M, N, K;
};
template <int MODE>
__global__ __launch_bounds__(256) void k_gemm(GP p) {
    __shared__ float As[16][68];
    __shared__ float Bs[16][64];
    __shared__ float Bs2[MODE == 1 ? 16 : 1][64];
    const int g = blockIdx.z, e = g % NE;
    const float* A = p.A + (size_t)g * p.a_gstride;
    const int* gidx = p.gidx ? p.gidx + (size_t)g * p.gidx_gstride : nullptr;
    const float* B = p.B + (size_t)e * p.b_estride;
    const float* B2 = MODE == 1 ? p.B2 + (size_t)e * p.b_estride : nullptr;
    float* C = p.C + (size_t)g * p.c_gstride;
    const int tid = threadIdx.x, tx = tid & 15, ty = tid >> 4;
    const int m0 = blockIdx.y * 64, n0 = blockIdx.x * 64;
    const int arow = tid >> 2, akq = (tid & 3) * 4;
    const int am = m0 + arow;
    const float* Ap = nullptr;
    if (am < p.M) Ap = A + (size_t)((gidx && MODE != 2) ? gidx[am] : am) * p.lda;
    const int bk = tid >> 4, bn = (tid & 15) * 4;
    const bool bok = (n0 + bn) < p.N;
    float acc[4][4], acc2[4][4];
#pragma unroll
    for (int i = 0; i < 4; ++i)
#pragma unroll
        for (int j = 0; j < 4; ++j) { acc[i][j] = 0.f; acc2[i][j] = 0.f; }
    for (int k0 = 0; k0 < p.K; k0 += 16) {
        float4 av = Ap ? *(const float4*)(Ap + k0 + akq) : make_float4(0.f, 0.f, 0.f, 0.f);
        float4 bv = bok ? *(const float4*)(B + (size_t)(k0 + bk) * p.ldb + n0 + bn) : make_float4(0.f, 0.f, 0.f, 0.f);
        float4 bv2 = make_float4(0.f, 0.f, 0.f, 0.f);
        if (MODE == 1) bv2 = bok ? *(const float4*)(B2 + (size_t)(k0 + bk) * p.ldb + n0 + bn) : make_float4(0.f, 0.f, 0.f, 0.f);
        __syncthreads();
        As[akq + 0][arow] = av.x; As[akq + 1][arow] = av.y; As[akq + 2][arow] = av.z; As[akq + 3][arow] = av.w;
        *(float4*)&Bs[bk][bn] = bv;
        if (MODE == 1) *(float4*)&Bs2[bk][bn] = bv2;
        __syncthreads();
#pragma unroll
        for (int kk = 0; kk < 16; ++kk) {
            float4 a4 = *(const float4*)&As[kk][ty * 4];
            float4 b4 = *(const float4*)&Bs[kk][tx * 4];
            float a[4] = {a4.x, a4.y, a4.z, a4.w}, b[4] = {b4.x, b4.y, b4.z, b4.w};
#pragma unroll
            for (int i = 0; i < 4; ++i)
#pragma unroll
                for (int j = 0; j < 4; ++j) acc[i][j] += a[i] * b[j];
            if (MODE == 1) {
                float4 c4 = *(const float4*)&Bs2[kk][tx * 4];
                float cc[4] = {c4.x, c4.y, c4.z, c4.w};
#pragma unroll
                for (int i = 0; i < 4; ++i)
#pragma unroll
                    for (int j = 0; j < 4; ++j) acc2[i][j] += a[i] * cc[j];
            }
        }
    }
#pragma unroll
    for (int i = 0; i < 4; ++i) {
        int m = m0 + ty * 4 + i;
        if (m >= p.M) continue;
        float sc = 1.f;
        if (MODE == 2) sc = p.aff[(size_t)gidx[m] * NE + e];
#pragma unroll
        for (int j = 0; j < 4; ++j) {
            int n = n0 + tx * 4 + j;
            if (n >= p.N) continue;
            float v = acc[i][j];
            if (MODE == 1) v = siluf(v) * acc2[i][j];
            if (MODE == 2) v *= sc;
            C[(size_t)m * p.ldc + n] = v;
        }
    }
}

__global__ void k_rope(float* p) {
    size_t idx = (size_t)blockIdx.x * blockDim.x + threadIdx.x;
    int r = idx / 512, w = idx % 512;
    int s = r % SS; if (s < CL) return;
    int t = s - CL;
    int f = w & 15, axis = (w >> 4) & 1, hm = (w >> 5) & 7, qk = w >> 8;
    float pos = axis == 0 ? (float)(t / 64) : (float)(t % 64);
    float freq = powf(10000.f, -(float)f / 16.f);
    float ang = pos * freq;
    float cs = cosf(ang), sn = sinf(ang);
    float* base = p + (size_t)r * DIN + (qk ? OKK : OQ) + hm * 64 + axis * 32 + f;
    float x1 = base[0], x2 = base[16];
    base[0] = x1 * cs - x2 * sn;
    base[16] = x2 * cs + x1 * sn;
}

__global__ __launch_bounds__(256) void k_attn(const float* __restrict__ p, const float* __restrict__ da_lambda, const float* __restrict__ da_norm,
                                              float lam_init, float* cat) {
    __shared__ float Ks[32][128];
    __shared__ float Vs[32][128];
    const int tid = threadIdx.x, map = tid & 1, quarter = (tid >> 1) & 3, ql = tid >> 3;
    const int h = blockIdx.y;
    const int r = blockIdx.x * 32 + ql;
    const int b = r / SS, s = r % SS;
    const int nkeys = s < CL ? CL : SS;
    float s01 = 0.f, s23 = 0.f;
    for (int d = 0; d < 64; ++d) { s01 += da_lambda[d] * da_lambda[64 + d]; s23 += da_lambda[128 + d] * da_lambda[192 + d]; }
    const float lam = expf(s01) - expf(s23) + lam_init;
    float q[64];
    const float* qp = p + (size_t)r * DIN + OQ + h * 128 + map * 64;
#pragma unroll
    for (int d = 0; d < 64; ++d) q[d] = qp[d] * 0.125f;
    float o[32];
#pragma unroll
    for (int i = 0; i < 32; ++i) o[i] = 0.f;
    float mx = -1e30f, l = 0.f;
    for (int k0 = 0; k0 < nkeys; k0 += 32) {
        __syncthreads();
        for (int i = tid; i < 32 * 128; i += 256) {
            int j = i >> 7, cix = i & 127;
            const float* rowp = p + (size_t)(b * SS + k0 + j) * DIN;
            Ks[j][cix] = rowp[OKK + h * 128 + cix];
            Vs[j][cix] = rowp[OV + h * 128 + cix];
        }
        __syncthreads();
        float sc[32]; float tmax = -1e30f;
#pragma unroll
        for (int j = 0; j < 32; ++j) {
            float a = 0.f;
#pragma unroll
            for (int d = 0; d < 64; ++d) a += q[d] * Ks[j][map * 64 + d];
            sc[j] = a; tmax = fmaxf(tmax, a);
        }
        float mn = fmaxf(mx, tmax);
        float corr = expf(mx - mn);
        l *= corr;
#pragma unroll
        for (int i = 0; i < 32; ++i) o[i] *= corr;
#pragma unroll
        for (int j = 0; j < 32; ++j) {
            float pj = expf(sc[j] - mn);
            l += pj;
#pragma unroll
            for (int i = 0; i < 32; ++i) o[i] += pj * Vs[j][quarter * 32 + i];
        }
        mx = mn;
    }
    float inv = 1.f / l;
    float res[32]; float ssq = 0.f;
#pragma unroll
    for (int i = 0; i < 32; ++i) {
        float v = o[i] * inv;
        float other = __shfl_xor(v, 1);
        res[i] = v - lam * other;
        ssq += res[i] * res[i];
    }
    ssq += __shfl_xor(ssq, 2); ssq += __shfl_xor(ssq, 4);
    float rstd = rsqrtf(ssq * (1.f / 128.f) + 1e-6f);
    if (map == 0) {
#pragma unroll
        for (int i = 0; i < 32; ++i) cat[(size_t)r * DM + h * 128 + quarter * 32 + i] = res[i] * rstd * da_norm[quarter * 32 + i] * (1.f - lam_init);
    }
}

__global__ __launch_bounds__(256) void k_gdn_prep(const float* __restrict__ p, const float* __restrict__ conv_w, const float* __restrict__ a_log,
                                                  const float* __restrict__ dt_bias, float* gq, float* gk, float* gv, float* gab) {
    const int r = blockIdx.x, c = threadIdx.x;
    const int b = r / SS, s = r % SS;
    int seg_lo = s < CL ? 0 : CL, seg_hi = s < CL ? CL : SS;
    float val[3];
#pragma unroll
    for (int j3 = 0; j3 < 3; ++j3) {
        int ch = j3 * 256 + c;
        float acc = 0.f;
#pragma unroll
        for (int j = 0; j < 5; ++j) {
            int s2 = s + j - 2;
            if (s2 >= seg_lo && s2 < seg_hi) acc += p[(size_t)(b * SS + s2) * DIN + OGQKV + ch] * conv_w[j * 768 + ch];
        }
        val[j3] = siluf(acc);
    }
    float sq = wave_sum(val[0] * val[0]);
    float sk = wave_sum(val[1] * val[1]);
    gq[(size_t)r * 256 + c] = val[0] * rsqrtf(sq + 1e-12f) * 0.125f;
    gk[(size_t)r * 256 + c] = val[1] * rsqrtf(sk + 1e-12f);
    gv[(size_t)r * 256 + c] = val[2];
    if (c < 8) {
        float a = p[(size_t)r * DIN + OGA + c];
        float xx = a + dt_bias[c];
        float sp = xx > 20.f ? xx : log1pf(expf(xx));
        float gg = -expf(a_log[c]) * sp;
        gab[(size_t)r * 16 + c] = expf(gg);
    } else if (c < 16) {
        float bb = p[(size_t)r * DIN + OGB + (c - 8)];
        gab[(size_t)r * 16 + c] = sigmf(bb);
    }
}

__global__ __launch_bounds__(256) void k_rwkv_prep(const float* __restrict__ p, const float* __restrict__ w0, const float* __restrict__ w_up,
                                                   const float* __restrict__ a0, const float* __restrict__ a_up, const float* __restrict__ k_k,
                                                   const float* __restrict__ k_a, float* kk_o, float* w_o, float* kka_o, float* kd_o) {
    __shared__ float xw[32], xa[32];
    const int r = blockIdx.x, c = threadIdx.x;
    const float* pr = p + (size_t)r * DIN;
    if (c < 32) xw[c] = tanhf(pr[OXW + c]);
    else if (c < 64) xa[c - 32] = pr[OXA + (c - 32)];
    __syncthreads();
    float k = pr[ORKV + 256 + c];
    float kq = k * k_k[c];
    float ss = wave_sum(kq * kq);
    float kk = kq * rsqrtf(ss + 1e-12f);
    kk_o[(size_t)r * 256 + c] = kk;
#pragma unroll
    for (int d = 0; d < 2; ++d) {
        float aw = w0[d * 256 + c], aa = a0[d * 256 + c];
        for (int j = 0; j < 32; ++j) { aw += xw[j] * w_up[(d * 32 + j) * 256 + c]; aa += xa[j] * a_up[(d * 32 + j) * 256 + c]; }
        float logw = -0.6065306597126334f * sigmf(aw);
        float ad = sigmf(aa);
        w_o[(size_t)r * 512 + d * 256 + c] = expf(logw);
        kka_o[(size_t)r * 512 + d * 256 + c] = kk * ad;
        kd_o[(size_t)r * 512 + d * 256 + c] = k * (1.f + (ad - 1.f) * k_a[c]);
    }
}

#define SCB 16
__global__ __launch_bounds__(64) void k_scan(const float* __restrict__ p, const float* __restrict__ gq, const float* __restrict__ gk, const float* __restrict__ gv,
                                             const float* __restrict__ gab, const float* __restrict__ kk_i, const float* __restrict__ w_i,
                                             const float* __restrict__ kka_i, const float* __restrict__ kd_i, float* cat, float* so1) {
    __shared__ float L[5][SCB][64];
    __shared__ float Lv[SCB][64];
    __shared__ float Lab[SCB][2];
    const int lane = threadIdx.x;
    const int bid = blockIdx.x;
    const int mixer = bid >> 4, b = (bid >> 3) & 1, h = (bid >> 1) & 3, dir = bid & 1;
    float st[64];
#pragma unroll
    for (int j = 0; j < 64; ++j) st[j] = 0.f;
    for (int pos0 = 0; pos0 < SS; pos0 += SCB) {
        __syncthreads();
        for (int i = 0; i < SCB; ++i) {
            int pos = pos0 + i;
            int s = dir == 0 ? pos : (pos < CL ? (CL - 1 - pos) : (CL + (TL - 1 - (pos - CL))));
            size_t r = (size_t)b * SS + s;
            if (mixer == 0) {
                L[0][i][lane] = gk[r * 256 + h * 64 + lane];
                L[1][i][lane] = gq[r * 256 + h * 64 + lane];
                Lv[i][lane] = gv[r * 256 + h * 64 + lane];
                if (lane < 2) Lab[i][lane] = gab[r * 16 + lane * 8 + dir * 4 + h];
            } else {
                L[0][i][lane] = kk_i[r * 256 + h * 64 + lane];
                L[1][i][lane] = w_i[r * 512 + dir * 256 + h * 64 + lane];
                L[2][i][lane] = kka_i[r * 512 + dir * 256 + h * 64 + lane];
                L[3][i][lane] = kd_i[r * 512 + dir * 256 + h * 64 + lane];
                L[4][i][lane] = p[r * DIN + ORKV + h * 64 + lane];
                Lv[i][lane] = p[r * DIN + ORKV + 512 + h * 64 + lane];
            }
        }
        __syncthreads();
        for (int i = 0; i < SCB; ++i) {
            int pos = pos0 + i;
            int s = dir == 0 ? pos : (pos < CL ? (CL - 1 - pos) : (CL + (TL - 1 - (pos - CL))));
            size_t r = (size_t)b * SS + s;
            float v = Lv[i][lane];
            float outv = 0.f;
            if (mixer == 0) {
                float alpha = Lab[i][0], beta = Lab[i][1];
                float kS = 0.f;
#pragma unroll
                for (int j = 0; j < 64; ++j) kS += L[0][i][j] * st[j];
                float vn = beta * (v - alpha * kS);
#pragma unroll
                for (int j = 0; j < 64; ++j) { st[j] = alpha * st[j] + L[0][i][j] * vn; outv += L[1][i][j] * st[j]; }
                if (dir == 0) cat[r * DM + 512 + h * 64 + lane] = outv; else so1[r * 512 + h * 64 + lane] = outv;
            } else {
                float rd = 0.f;
#pragma unroll
                for (int j = 0; j < 64; ++j) rd -= L[0][i][j] * st[j];
#pragma unroll
                for (int j = 0; j < 64; ++j) { st[j] = L[1][i][j] * st[j] + L[2][i][j] * rd + L[3][i][j] * v; outv += L[4][i][j] * st[j]; }
                if (dir == 0) cat[r * DM + 768 + h * 64 + lane] = outv; else so1[r * 512 + 256 + h * 64 + lane] = outv;
            }
        }
    }
}

__global__ __launch_bounds__(256) void k_mix_out(const float* __restrict__ p, float* cat, const float* __restrict__ so1, const float* __restrict__ gdn_norm,
                                                 const float* __restrict__ kd_i, const float* __restrict__ g_up, const float* __restrict__ r_k,
                                                 const float* __restrict__ gn_w, const float* __restrict__ gn_b) {
    __shared__ float xg[64];
    const int r = blockIdx.x, c = threadIdx.x;
    const float* pr = p + (size_t)r * DIN;
    if (c < 64) xg[c] = sigmf(pr[OXG + c]);
    __syncthreads();
    float o = cat[(size_t)r * DM + 512 + c] + so1[(size_t)r * 512 + c];
    float ss = wave_sum(o * o);
    float y = o * rsqrtf(ss * (1.f / 64.f) + 1e-6f) * gdn_norm[c & 63] * siluf(pr[OGGATE + c]);
    float yv = cat[(size_t)r * DM + 768 + c] + so1[(size_t)r * 512 + 256 + c];
    float mu = wave_sum(yv) * (1.f / 64.f);
    float dv = yv - mu;
    float var = wave_sum(dv * dv) * (1.f / 64.f);
    float yn = dv * rsqrtf(var + 64e-5f) * gn_w[c] + gn_b[c];
    float rr = pr[ORKV + c], vv = pr[ORKV + 512 + c];
    float kds = kd_i[(size_t)r * 512 + c] + kd_i[(size_t)r * 512 + 256 + c];
    float bs = wave_sum(rr * kds * r_k[c]);
    float g = 0.f;
    for (int j = 0; j < 64; ++j) g += xg[j] * g_up[j * 256 + c];
    float ro = (yn + bs * vv) * g;
    __syncthreads();
    cat[(size_t)r * DM + 512 + c] = y;
    cat[(size_t)r * DM + 768 + c] = ro;
}

__global__ void k_resid1(float* ctxs, float* out, const float* __restrict__ mix, const float* __restrict__ g_post, const float* __restrict__ g_pre2,
                         const float* __restrict__ modl, const float* __restrict__ router, float* h2, float* aff) {
    int r = blockIdx.x * 4 + (threadIdx.x >> 6), lane = threadIdx.x & 63;
    float* x = xrow_ptr(ctxs, out, r);
    const float* m = modl + modrow(r) * 6 * DM;
    float v[16], xv[16]; float ss = 0.f;
#pragma unroll
    for (int j = 0; j < 16; ++j) { v[j] = mix[(size_t)r * DM + lane + 64 * j]; ss += v[j] * v[j]; }
    ss = wave_sum(ss);
    float rstd = rsqrtf(ss * (1.f / DM) + 1e-6f);
    float s2 = 0.f;
#pragma unroll
    for (int j = 0; j < 16; ++j) { int cidx = lane + 64 * j; xv[j] = x[cidx] + m[2048 + cidx] * (v[j] * rstd * g_post[cidx]); x[cidx] = xv[j]; s2 += xv[j] * xv[j]; }
    s2 = wave_sum(s2);
    float rstd2 = rsqrtf(s2 * (1.f / DM) + 1e-6f);
    float lg[NE];
#pragma unroll
    for (int e = 0; e < NE; ++e) lg[e] = 0.f;
#pragma unroll
    for (int j = 0; j < 16; ++j) {
        int cidx = lane + 64 * j;
        float hv = xv[j] * rstd2 * g_pre2[cidx] * (1.f + m[4096 + cidx]) + m[3072 + cidx];
        h2[(size_t)r * DM + cidx] = hv;
#pragma unroll
        for (int e = 0; e < NE; ++e) lg[e] += hv * router[cidx * NE + e];
    }
    float mxv = -1e30f;
#pragma unroll
    for (int e = 0; e < NE; ++e) { lg[e] = wave_sum(lg[e]); mxv = fmaxf(mxv, lg[e]); }
    float sum = 0.f;
#pragma unroll
    for (int e = 0; e < NE; ++e) { lg[e] = expf(lg[e] - mxv); sum += lg[e]; }
    if (lane < NE) {
        float val = 0.f;
#pragma unroll
        for (int e = 0; e < NE; ++e) if (e == lane) val = lg[e];
        aff[(size_t)r * NE + lane] = val / sum;
    }
}

__global__ __launch_bounds__(256) void k_topk(const float* __restrict__ aff, int* sel_lat, int* sel_ctx, int* slot) {
    __shared__ float vals[TL];
    const int set = blockIdx.x >> 5, b = (blockIdx.x >> 4) & 1, e = blockIdx.x & 15;
    const int n = set == 0 ? TL : CL, cap = set == 0 ? CAPL : CAPC;
    const int rbase = b * SS + (set == 0 ? CL : 0);
    for (int t = threadIdx.x; t < n; t += 256) vals[t] = aff[(size_t)(rbase + t) * NE + e];
    __syncthreads();
    for (int t = threadIdx.x; t < n; t += 256) {
        float v = vals[t]; int rank = 0;
        for (int u = 0; u < n; ++u) { float w = vals[u]; rank += (w > v || (w == v && u < t)) ? 1 : 0; }
        int sl = rank < cap ? rank : -1;
        slot[(size_t)e * RR + rbase + t] = sl;
        if (sl >= 0) { if (set == 0) sel_lat[(b * NE + e) * CAPL + sl] = rbase + t; else sel_ctx[(b * NE + e) * CAPC + sl] = rbase + t; }
    }
}

__global__ void k_resid2(float* ctxs, float* out, const float* __restrict__ ye_lat, const float* __restrict__ ye_ctx, const int* __restrict__ slot,
                         const float* __restrict__ g_post, const float* __restrict__ modl) {
    int r = blockIdx.x * 4 + (threadIdx.x >> 6), lane = threadIdx.x & 63;
    float* x = xrow_ptr(ctxs, out, r);
    const float* m = modl + modrow(r) * 6 * DM;
    int b = r / SS, s = r % SS;
    float y[16];
#pragma unroll
    for (int j = 0; j < 16; ++j) y[j] = 0.f;
    for (int e = 0; e < NE; ++e) {
        int sl = slot[(size_t)e * RR + r];
        if (sl < 0) continue;
        const float* src = s < CL ? ye_ctx + ((size_t)(b * NE + e) * CAPC + sl) * DM : ye_lat + ((size_t)(b * NE + e) * CAPL + sl) * DM;
#pragma unroll
        for (int j = 0; j < 16; ++j) y[j] += src[lane + 64 * j];
    }
    float ss = 0.f;
#pragma unroll
    for (int j = 0; j < 16; ++j) ss += y[j] * y[j];
    ss = wave_sum(ss);
    float rstd = rsqrtf(ss * (1.f / DM) + 1e-6f);
#pragma unroll
    for (int j = 0; j < 16; ++j) { int cidx = lane + 64 * j; x[cidx] += m[5120 + cidx] * (y[j] * rstd * g_post[cidx]); }
}

static inline size_t al256(size_t x) { return (x + 255) & ~(size_t)255; }

extern "C" void kernel_launch(void* const* d_in, const int* in_sizes, int n_in, void* d_out, int out_size, void* d_ws, size_t ws_size, hipStream_t stream) {
    const float* x = (const float*)d_in[0]; const float* c = (const float*)d_in[1]; const float* ctx = (const float*)d_in[2]; const float* c_ctx = (const float*)d_in[3];
    const float* w_mod = (const float*)d_in[4]; const float* b_mod = (const float*)d_in[5]; const float* norm_pre = (const float*)d_in[6]; const float* norm_post = (const float*)d_in[7];
    const float* w_in = (const float*)d_in[8]; const float* w_out = (const float*)d_in[9]; const float* da_lambda = (const float*)d_in[10]; const float* da_norm = (const float*)d_in[11];
    const float* gdn_conv = (const float*)d_in[12]; const float* gdn_a_log = (const float*)d_in[13]; const float* gdn_dt_bias = (const float*)d_in[14]; const float* gdn_norm = (const float*)d_in[15];
    const float* rwkv_w0 = (const float*)d_in[16]; const float* rwkv_w_up = (const float*)d_in[17]; const float* rwkv_a0 = (const float*)d_in[18]; const float* rwkv_a_up = (const float*)d_in[19];
    const float* rwkv_g_up = (const float*)d_in[20]; const float* rwkv_k_k = (const float*)d_in[21]; const float* rwkv_k_a = (const float*)d_in[22]; const float* rwkv_r_k = (const float*)d_in[23];
    const float* rwkv_gn_w = (const float*)d_in[24]; const float* rwkv_gn_b = (const float*)d_in[25]; const float* moe_router = (const float*)d_in[26];
    const float* moe_w_gate = (const float*)d_in[27]; const float* moe_w_up = (const float*)d_in[28]; const float* moe_w_down = (const float*)d_in[29];
    float* out = (float*)d_out;

    char* w = (char*)d_ws; size_t off = 0;
    auto take = [&](size_t bytes) { char* q = w + off; off += al256(bytes); return q; };
    float* mod = (float*)take((size_t)2 * 3 * 6 * DM * 4);
    float* ctxs = (float*)take((size_t)NB * CL * DM * 4);
    float* aff = (float*)take((size_t)RR * NE * 4);
    int* slot = (int*)take((size_t)NE * RR * 4);
    int* sel_lat = (int*)take((size_t)32 * CAPL * 4);
    int* sel_ctx = (int*)take((size_t)32 * CAPC * 4);
    float* bufA = (float*)take((size_t)RR * DM * 4);
    float* so1 = (float*)take((size_t)RR * 512 * 4);
    float* P = (float*)take((size_t)RR * DIN * 4);
    char* prep = take((size_t)RR * 2576 * 4);
    if (off > ws_size) { fprintf(stderr, "workspace too small: need %zu have %zu\n", off, ws_size); return; }
    float* gq = (float*)prep; float* gk = gq + (size_t)RR * 256; float* gv = gk + (size_t)RR * 256; float* gab = gv + (size_t)RR * 256;
    float* kk_b = gab + (size_t)RR * 16; float* w_b = kk_b + (size_t)RR * 256; float* kka_b = w_b + (size_t)RR * 512; float* kd_b = kka_b + (size_t)RR * 512;
    float* mix = (float*)prep;
    float* ye_lat = (float*)prep; float* ye_ctx = ye_lat + (size_t)32 * CAPL * DM;
    float* hid_lat = P; float* hid_ctx = P + (size_t)32 * CAPL * DM;
    float* h = bufA; float* cat = bufA; float* h2 = bufA;

    k_init<<<2048, 256, 0, stream>>>(x, ctx, out, ctxs);
    k_mod<<<(2 * 6 * DM) / 256, 256, 0, stream>>>(c, c_ctx, w_mod, b_mod, mod);

    for (int i = 0; i < 2; ++i) {
        const float* modl = mod + (size_t)i * 3 * 6 * DM;
        const float lam_init = 0.8f - 0.6f * expf(-0.3f * (float)i);
        k_normmod<<<RR / 4, 256, 0, stream>>>(ctxs, out, norm_pre + (size_t)(i * 2 + 0) * DM, modl, 0, 1024, h);
        {
            GP g{}; g.A = h; g.lda = DM; g.gidx = nullptr; g.a_gstride = 0; g.gidx_gstride = 0; g.B = w_in + (size_t)i * DM * DIN; g.B2 = nullptr; g.ldb = DIN; g.b_estride = 0;
            g.C = P; g.ldc = DIN; g.c_gstride = 0; g.aff = nullptr; g.M = RR; g.N = DIN; g.K = DM;
            k_gemm<0><<<dim3((DIN + 63) / 64, RR / 64, 1), 256, 0, stream>>>(g);
        }
        k_rope<<<(RR * 512) / 256, 256, 0, stream>>>(P);
        k_attn<<<dim3(RR / 32, 4), 256, 0, stream>>>(P, da_lambda + (size_t)i * 256, da_norm + (size_t)i * 128, lam_init, cat);
        k_gdn_prep<<<RR, 256, 0, stream>>>(P, gdn_conv + (size_t)i * 5 * 768, gdn_a_log + i * 8, gdn_dt_bias + i * 8, gq, gk, gv, gab);
        k_rwkv_prep<<<RR, 256, 0, stream>>>(P, rwkv_w0 + i * 512, rwkv_w_up + (size_t)i * 2 * 32 * 256, rwkv_a0 + i * 512, rwkv_a_up + (size_t)i * 2 * 32 * 256,
                                            rwkv_k_k + i * 256, rwkv_k_a + i * 256, kk_b, w_b, kka_b, kd_b);
        k_scan<<<32, 64, 0, stream>>>(P, gq, gk, gv, gab, kk_b, w_b, kka_b, kd_b, cat, so1);
        k_mix_out<<<RR, 256, 0, stream>>>(P, cat, so1, gdn_norm + i * 64, kd_b, rwkv_g_up + (size_t)i * 64 * 256, rwkv_r_k + i * 256, rwkv_gn_w + i * 256, rwkv_gn_b + i * 256);
        {
            GP g{}; g.A = cat; g.lda = DM; g.B = w_out + (size_t)i * DM * DM; g.ldb = DM; g.C = mix; g.ldc = DM; g.M = RR; g.N = DM; g.K = DM;
            k_gemm<0><<<dim3(DM / 64, RR / 64, 1), 256, 0, stream>>>(g);
        }
        k_resid1<<<RR / 4, 256, 0, stream>>>(ctxs, out, mix, norm_post + (size_t)(i * 2 + 0) * DM, norm_pre + (size_t)(i * 2 + 1) * DM, modl, moe_router + (size_t)i * DM * NE, h2, aff);
        k_topk<<<64, 256, 0, stream>>>(aff, sel_lat, sel_ctx, slot);
        for (int set = 0; set < 2; ++set) {
            const int cap = set == 0 ? CAPL : CAPC;
            float* hid = set == 0 ? hid_lat : hid_ctx; float* ye = set == 0 ? ye_lat : ye_ctx; const int* sel = set == 0 ? sel_lat : sel_ctx;
            GP g{}; g.A = h2; g.lda = DM; g.gidx = sel; g.a_gstride = 0; g.gidx_gstride = cap;
            g.B = moe_w_gate + (size_t)i * NE * DM * DM; g.B2 = moe_w_up + (size_t)i * NE * DM * DM; g.ldb = DM; g.b_estride = (long)DM * DM;
            g.C = hid; g.ldc = DM; g.c_gstride = (long)cap * DM; g.aff = nullptr; g.M = cap; g.N = DM; g.K = DM;
            k_gemm<1><<<dim3(DM / 64, (cap + 63) / 64, 32), 256, 0, stream>>>(g);
            GP g2{}; g2.A = hid; g2.lda = DM; g2.gidx = sel; g2.a_gstride = (long)cap * DM; g2.gidx_gstride = cap;
            g2.B = moe_w_down + (size_t)i * NE * DM * DM; g2.B2 = nullptr; g2.ldb = DM; g2.b_estride = (long)DM * DM;
            g2.C = ye; g2.ldc = DM; g2.c_gstride = (long)cap * DM; g2.aff = aff; g2.M = cap; g2.N = DM; g2.K = DM;
            k_gemm<2><<<dim3(DM / 64, (cap + 63) / 64, 32), 256, 0, stream>>>(g2);
        }
        k_resid2<<<RR / 4, 256, 0, stream>>>(ctxs, out, ye_lat, ye_ctx, slot, norm_post + (size_t)(i * 2 + 1) * DM, modl);
    }
}
```

```cpp
#include <hip/hip_runtime.h>
#include <stdint.h>
#include <stdio.h>
#include <hip/hip_cooperative_groups.h>
namespace cg = cooperative_groups;

#define NB 2
#define TL 8192
#define CL 256
#define SS 8448
#define RR 16896
#define DM 1024
#define DIN 3472
#define NE 16
#define CAPL 1024
#define CAPC 32
#define OQ 0
#define OKK 512
#define OV 1024
#define OGQKV 1536
#define OGGATE 2304
#define OGA 2560
#define OGB 2568
#define ORKV 2576
#define OXW 3344
#define OXA 3376
#define OXG 3408

__device__ __forceinline__ float siluf(float x) { return x / (1.f + expf(-x)); }
__device__ __forceinline__ float sigmf(float x) { return 1.f / (1.f + expf(-x)); }
__device__ __forceinline__ float wave_sum(float v) {
#pragma unroll
    for (int o = 1; o < 64; o <<= 1) v += __shfl_xor(v, o);
    return v;
}
__device__ __forceinline__ float* xrow_ptr(float* ctxs, float* out, int r) {
    int b = r / SS, s = r % SS;
    return s < CL ? ctxs + ((size_t)(b * CL + s)) * DM : out + ((size_t)(b * TL + (s - CL))) * DM;
}
__device__ __forceinline__ int modrow(int r) { int b = r / SS, s = r % SS; return s < CL ? 2 : b; }

__device__ __forceinline__ void f_init(const float* __restrict__ x, const float* __restrict__ ctx, float* out, float* ctxs, int vb, int nvb) {
    size_t i = (size_t)vb * 256 + threadIdx.x;
    size_t n1 = (size_t)NB * TL * DM / 4, n2 = (size_t)NB * CL * DM / 4;
    for (size_t j = i; j < n1; j += (size_t)nvb * 256) ((float4*)out)[j] = ((const float4*)x)[j];
    for (size_t j = i; j < n2; j += (size_t)nvb * 256) ((float4*)ctxs)[j] = ((const float4*)ctx)[j];
}

__device__ __forceinline__ void f_mod(const float* __restrict__ c, const float* __restrict__ c_ctx, const float* __restrict__ w_mod,
                      const float* __restrict__ b_mod, float* mod, int vb, float* lds) {
    float (*cs)[DM] = (float (*)[DM])lds;
    __syncthreads();
    for (int i = threadIdx.x; i < DM; i += 256) {
        cs[0][i] = siluf(c[i]); cs[1][i] = siluf(c[DM + i]); cs[2][i] = siluf(c_ctx[i]);
    }
    __syncthreads();
    int idx = vb * 256 + threadIdx.x;
    int l = idx / (6 * DM), n = idx % (6 * DM);
    const float* w = w_mod + (size_t)l * DM * 6 * DM + n;
    float a0 = 0.f, a1 = 0.f, a2 = 0.f;
    for (int k = 0; k < DM; ++k) { float wv = w[(size_t)k * 6 * DM]; a0 += cs[0][k] * wv; a1 += cs[1][k] * wv; a2 += cs[2][k] * wv; }
    float bb = b_mod[l * 6 * DM + n];
    mod[(l * 3 + 0) * 6 * DM + n] = a0 + bb;
    mod[(l * 3 + 1) * 6 * DM + n] = a1 + bb;
    mod[(l * 3 + 2) * 6 * DM + n] = a2 + bb;
}

__device__ __forceinline__ void f_normmod(float* ctxs, float* out, const float* __restrict__ g, const float* __restrict__ modl, int sh_off, int sc_off, float* h, int vb) {
    int r = vb * 4 + (threadIdx.x >> 6), lane = threadIdx.x & 63;
    const float* x = xrow_ptr(ctxs, out, r);
    const float* m = modl + modrow(r) * 6 * DM;
    float v[16]; float ss = 0.f;
#pragma unroll
    for (int j = 0; j < 16; ++j) { v[j] = x[lane + 64 * j]; ss += v[j] * v[j]; }
    ss = wave_sum(ss);
    float rstd = rsqrtf(ss * (1.f / DM) + 1e-6f);
#pragma unroll
    for (int j = 0; j < 16; ++j) { int cidx = lane + 64 * j; h[(size_t)r * DM + cidx] = v[j] * rstd * g[cidx] * (1.f + m[sc_off + cidx]) + m[sh_off + cidx]; }
}

struct GP {
    const float* A; int lda; const int* gidx; long a_gstride; int gidx_gstride;
    const float* B; const float* B2; int ldb; long b_estride;
    float* C; int ldc; long c_gstride;
    const float* aff;
    int M, N, K;
};
template <int MODE>
__device__ __forceinline__ void f_gemm(const GP& p, int bx, int by, int bz, float* lds) {
    float (*As)[68] = (float (*)[68])lds;
    float (*Bs)[64] = (float (*)[64])(lds + 16 * 68);
    float (*Bs2)[64] = (float (*)[64])(lds + 16 * 68 + 16 * 64);
    const int g = bz, e = g % NE;
    const float* A = p.A + (size_t)g * p.a_gstride;
    const int* gidx = p.gidx ? p.gidx + (size_t)g * p.gidx_gstride : nullptr;
    const float* B = p.B + (size_t)e * p.b_estride;
    const float* B2 = MODE == 1 ? p.B2 + (size_t)e * p.b_estride : nullptr;
    float* C = p.C + (size_t)g * p.c_gstride;
    const int tid = threadIdx.x, tx = tid & 15, ty = tid >> 4;
    const int m0 = by * 64, n0 = bx * 64;
    const int arow = tid >> 2, akq = (tid & 3) * 4;
    const int am = m0 + arow;
    const float* Ap = nullptr;
    if (am < p.M) Ap = A + (size_t)((gidx && MODE != 2) ? gidx[am] : am) * p.lda;
    const int bk = tid >> 4, bn = (tid & 15) * 4;
    const bool bok = (n0 + bn) < p.N;
    float acc[4][4], acc2[4][4];
#pragma unroll
    for (int i = 0; i < 4; ++i)
#pragma unroll
        for (int j = 0; j < 4; ++j) { acc[i][j] = 0.f; acc2[i][j] = 0.f; }
    for (int k0 = 0; k0 < p.K; k0 += 16) {
        float4 av = Ap ? *(const float4*)(Ap + k0 + akq) : make_float4(0.f, 0.f, 0.f, 0.f);
        float4 bv = bok ? *(const float4*)(B + (size_t)(k0 + bk) * p.ldb + n0 + bn) : make_float4(0.f, 0.f, 0.f, 0.f);
        float4 bv2 = make_float4(0.f, 0.f, 0.f, 0.f);
        if (MODE == 1) bv2 = bok ? *(const float4*)(B2 + (size_t)(k0 + bk) * p.ldb + n0 + bn) : make_float4(0.f, 0.f, 0.f, 0.f);
        __syncthreads();
        As[akq + 0][arow] = av.x; As[akq + 1][arow] = av.y; As[akq + 2][arow] = av.z; As[akq + 3][arow] = av.w;
        *(float4*)&Bs[bk][bn] = bv;
        if (MODE == 1) *(float4*)&Bs2[bk][bn] = bv2;
        __syncthreads();
#pragma unroll
        for (int kk = 0; kk < 16; ++kk) {
            float4 a4 = *(const float4*)&As[kk][ty * 4];
            float4 b4 = *(const float4*)&Bs[kk][tx * 4];
            float a[4] = {a4.x, a4.y, a4.z, a4.w}, b[4] = {b4.x, b4.y, b4.z, b4.w};
#pragma unroll
            for (int i = 0; i < 4; ++i)
#pragma unroll
                for (int j = 0; j < 4; ++j) acc[i][j] += a[i] * b[j];
            if (MODE == 1) {
                float4 c4 = *(const float4*)&Bs2[kk][tx * 4];
                float cc[4] = {c4.x, c4.y, c4.z, c4.w};
#pragma unroll
                for (int i = 0; i < 4; ++i)
#pragma unroll
                    for (int j = 0; j < 4; ++j) acc2[i][j] += a[i] * cc[j];
            }
        }
    }
#pragma unroll
    for (int i = 0; i < 4; ++i) {
        int m = m0 + ty * 4 + i;
        if (m >= p.M) continue;
        float sc = 1.f;
        if (MODE == 2) sc = p.aff[(size_t)gidx[m] * NE + e];
#pragma unroll
        for (int j = 0; j < 4; ++j) {
            int n = n0 + tx * 4 + j;
            if (n >= p.N) continue;
            float v = acc[i][j];
            if (MODE == 1) v = siluf(v) * acc2[i][j];
            if (MODE == 2) v *= sc;
            C[(size_t)m * p.ldc + n] = v;
        }
    }
}

__device__ __forceinline__ void f_rope(float* p, int vb) {
    size_t idx = (size_t)vb * 256 + threadIdx.x;
    int r = idx / 512, w = idx % 512;
    int s = r % SS; if (s < CL) return;
    int t = s - CL;
    int f = w & 15, axis = (w >> 4) & 1, hm = (w >> 5) & 7, qk = w >> 8;
    float pos = axis == 0 ? (float)(t / 64) : (float)(t % 64);
    float freq = powf(10000.f, -(float)f / 16.f);
    float ang = pos * freq;
    float cs = cosf(ang), sn = sinf(ang);
    float* base = p + (size_t)r * DIN + (qk ? OKK : OQ) + hm * 64 + axis * 32 + f;
    float x1 = base[0], x2 = base[16];
    base[0] = x1 * cs - x2 * sn;
    base[16] = x2 * cs + x1 * sn;
}

__device__ __forceinline__ void f_attn(const float* __restrict__ p, const float* __restrict__ da_lambda, const float* __restrict__ da_norm,
                                              float lam_init, float* cat, int bx, int by, float* lds) {
    float (*Ks)[128] = (float (*)[128])lds;
    float (*Vs)[128] = (float (*)[128])(lds + 32 * 128);
    const int tid = threadIdx.x, map = tid & 1, quarter = (tid >> 1) & 3, ql = tid >> 3;
    const int h = by;
    const int r = bx * 32 + ql;
    const int b = r / SS, s = r % SS;
    const int nkeys = s < CL ? CL : SS;
    float s01 = 0.f, s23 = 0.f;
    for (int d = 0; d < 64; ++d) { s01 += da_lambda[d] * da_lambda[64 + d]; s23 += da_lambda[128 + d] * da_lambda[192 + d]; }
    const float lam = expf(s01) - expf(s23) + lam_init;
    float q[64];
    const float* qp = p + (size_t)r * DIN + OQ + h * 128 + map * 64;
#pragma unroll
    for (int d = 0; d < 64; ++d) q[d] = qp[d] * 0.125f;
    float o[32];
#pragma unroll
    for (int i = 0; i < 32; ++i) o[i] = 0.f;
    float mx = -1e30f, l = 0.f;
    for (int k0 = 0; k0 < nkeys; k0 += 32) {
        __syncthreads();
        for (int i = tid; i < 32 * 128; i += 256) {
            int j = i >> 7, cix = i & 127;
            const float* rowp = p + (size_t)(b * SS + k0 + j) * DIN;
            Ks[j][cix] = rowp[OKK + h * 128 + cix];
            Vs[j][cix] = rowp[OV + h * 128 + cix];
        }
        __syncthreads();
        float sc[32]; float tmax = -1e30f;
#pragma unroll
        for (int j = 0; j < 32; ++j) {
            float a = 0.f;
#pragma unroll
            for (int d = 0; d < 64; ++d) a += q[d] * Ks[j][map * 64 + d];
            sc[j] = a; tmax = fmaxf(tmax, a);
        }
        float mn = fmaxf(mx, tmax);
        float corr = expf(mx - mn);
        l *= corr;
#pragma unroll
        for (int i = 0; i < 32; ++i) o[i] *= corr;
#pragma unroll
        for (int j = 0; j < 32; ++j) {
            float pj = expf(sc[j] - mn);
            l += pj;
#pragma unroll
            for (int i = 0; i < 32; ++i) o[i] += pj * Vs[j][quarter * 32 + i];
        }
        mx = mn;
    }
    float inv = 1.f / l;
    float res[32]; float ssq = 0.f;
#pragma unroll
    for (int i = 0; i < 32; ++i) {
        float v = o[i] * inv;
        float other = __shfl_xor(v, 1);
        res[i] = v - lam * other;
        ssq += res[i] * res[i];
    }
    ssq += __shfl_xor(ssq, 2); ssq += __shfl_xor(ssq, 4);
    float rstd = rsqrtf(ssq * (1.f / 128.f) + 1e-6f);
    if (map == 0) {
#pragma unroll
        for (int i = 0; i < 32; ++i) cat[(size_t)r * DM + h * 128 + quarter * 32 + i] = res[i] * rstd * da_norm[quarter * 32 + i] * (1.f - lam_init);
    }
}

__device__ __forceinline__ void f_gdn_prep(const float* __restrict__ p, const float* __restrict__ conv_w, const float* __restrict__ a_log,
                                                  const float* __restrict__ dt_bias, float* gq, float* gk, float* gv, float* gab, int vb) {
    const int r = vb, c = threadIdx.x;
    const int b = r / SS, s = r % SS;
    int seg_lo = s < CL ? 0 : CL, seg_hi = s < CL ? CL : SS;
    float val[3];
#pragma unroll
    for (int j3 = 0; j3 < 3; ++j3) {
        int ch = j3 * 256 + c;
        float acc = 0.f;
#pragma unroll
        for (int j = 0; j < 5; ++j) {
            int s2 = s + j - 2;
            if (s2 >= seg_lo && s2 < seg_hi) acc += p[(size_t)(b * SS + s2) * DIN + OGQKV + ch] * conv_w[j * 768 + ch];
        }
        val[j3] = siluf(acc);
    }
    float sq = wave_sum(val[0] * val[0]);
    float sk = wave_sum(val[1] * val[1]);
    gq[(size_t)r * 256 + c] = val[0] * rsqrtf(sq + 1e-12f) * 0.125f;
    gk[(size_t)r * 256 + c] = val[1] * rsqrtf(sk + 1e-12f);
    gv[(size_t)r * 256 + c] = val[2];
    if (c < 8) {
        float a = p[(size_t)r * DIN + OGA + c];
        float xx = a + dt_bias[c];
        float sp = xx > 20.f ? xx : log1pf(expf(xx));
        float gg = -expf(a_log[c]) * sp;
        gab[(size_t)r * 16 + c] = expf(gg);
    } else if (c < 16) {
        float bb = p[(size_t)r * DIN + OGB + (c - 8)];
        gab[(size_t)r * 16 + c] = sigmf(bb);
    }
}

__device__ __forceinline__ void f_rwkv_prep(const float* __restrict__ p, const float* __restrict__ w0, const float* __restrict__ w_up,
                                                   const float* __restrict__ a0, const float* __restrict__ a_up, const float* __restrict__ k_k,
                                                   const float* __restrict__ k_a, float* kk_o, float* w_o, float* kka_o, float* kd_o, int vb, float* lds) {
    float* xw = lds; float* xa = lds + 32;
    __syncthreads();
    const int r = vb, c = threadIdx.x;
    const float* pr = p + (size_t)r * DIN;
    if (c < 32) xw[c] = tanhf(pr[OXW + c]);
    else if (c < 64) xa[c - 32] = pr[OXA + (c - 32)];
    __syncthreads();
    float k = pr[ORKV + 256 + c];
    float kq = k * k_k[c];
    float ss = wave_sum(kq * kq);
    float kk = kq * rsqrtf(ss + 1e-12f);
    kk_o[(size_t)r * 256 + c] = kk;
#pragma unroll
    for (int d = 0; d < 2; ++d) {
        float aw = w0[d * 256 + c], aa = a0[d * 256 + c];
        for (int j = 0; j < 32; ++j) { aw += xw[j] * w_up[(d * 32 + j) * 256 + c]; aa += xa[j] * a_up[(d * 32 + j) * 256 + c]; }
        float logw = -0.6065306597126334f * sigmf(aw);
        float ad = sigmf(aa);
        w_o[(size_t)r * 512 + d * 256 + c] = expf(logw);
        kka_o[(size_t)r * 512 + d * 256 + c] = kk * ad;
        kd_o[(size_t)r * 512 + d * 256 + c] = k * (1.f + (ad - 1.f) * k_a[c]);
    }
}

#define SCB 16
__device__ __forceinline__ void f_scan(const float* __restrict__ p, const float* __restrict__ gq, const float* __restrict__ gk, const float* __restrict__ gv,
                                             const float* __restrict__ gab, const float* __restrict__ kk_i, const float* __restrict__ w_i,
                                             const float* __restrict__ kka_i, const float* __restrict__ kd_i, float* cat, float* so1, int bid, float* lds) {
    float (*L)[SCB][64] = (float (*)[SCB][64])lds;
    float (*Lv)[64] = (float (*)[64])(lds + 5 * SCB * 64);
    float (*Lab)[2] = (float (*)[2])(lds + 6 * SCB * 64);
    const int lane = threadIdx.x & 63;
    const bool act = threadIdx.x < 64;
    const int mixer = bid >> 4, b = (bid >> 3) & 1, h = (bid >> 1) & 3, dir = bid & 1;
    float st[64];
#pragma unroll
    for (int j = 0; j < 64; ++j) st[j] = 0.f;
    for (int pos0 = 0; pos0 < SS; pos0 += SCB) {
        __syncthreads();
        if (act) for (int i = 0; i < SCB; ++i) {
            int pos = pos0 + i;
            int s = dir == 0 ? pos : (pos < CL ? (CL - 1 - pos) : (CL + (TL - 1 - (pos - CL))));
            size_t r = (size_t)b * SS + s;
            if (mixer == 0) {
                L[0][i][lane] = gk[r * 256 + h * 64 + lane];
                L[1][i][lane] = gq[r * 256 + h * 64 + lane];
                Lv[i][lane] = gv[r * 256 + h * 64 + lane];
                if (lane < 2) Lab[i][lane] = gab[r * 16 + lane * 8 + dir * 4 + h];
            } else {
                L[0][i][lane] = kk_i[r * 256 + h * 64 + lane];
                L[1][i][lane] = w_i[r * 512 + dir * 256 + h * 64 + lane];
                L[2][i][lane] = kka_i[r * 512 + dir * 256 + h * 64 + lane];
                L[3][i][lane] = kd_i[r * 512 + dir * 256 + h * 64 + lane];
                L[4][i][lane] = p[r * DIN + ORKV + h * 64 + lane];
                Lv[i][lane] = p[r * DIN + ORKV + 512 + h * 64 + lane];
            }
        }
        __syncthreads();
        if (act) for (int i = 0; i < SCB; ++i) {
            int pos = pos0 + i;
            int s = dir == 0 ? pos : (pos < CL ? (CL - 1 - pos) : (CL + (TL - 1 - (pos - CL))));
            size_t r = (size_t)b * SS + s;
            float v = Lv[i][lane];
            float outv = 0.f;
            if (mixer == 0) {
                float alpha = Lab[i][0], beta = Lab[i][1];
                float kS = 0.f;
#pragma unroll
                for (int j = 0; j < 64; ++j) kS += L[0][i][j] * st[j];
                float vn = beta * (v - alpha * kS);
#pragma unroll
                for (int j = 0; j < 64; ++j) { st[j] = alpha * st[j] + L[0][i][j] * vn; outv += L[1][i][j] * st[j]; }
                if (dir == 0) cat[r * DM + 512 + h * 64 + lane] = outv; else so1[r * 512 + h * 64 + lane] = outv;
            } else {
                float rd = 0.f;
#pragma unroll
                for (int j = 0; j < 64; ++j) rd -= L[0][i][j] * st[j];
#pragma unroll
                for (int j = 0; j < 64; ++j) { st[j] = L[1][i][j] * st[j] + L[2][i][j] * rd + L[3][i][j] * v; outv += L[4][i][j] * st[j]; }
                if (dir == 0) cat[r * DM + 768 + h * 64 + lane] = outv; else so1[r * 512 + 256 + h * 64 + lane] = outv;
            }
        }
    }
}

__device__ __forceinline__ void f_mix_out(const float* __restrict__ p, float* cat, const float* __restrict__ so1, const float* __restrict__ gdn_norm,
                                                 const float* __restrict__ kd_i, const float* __restrict__ g_up, const float* __restrict__ r_k,
                                                 const float* __restrict__ gn_w, const float* __restrict__ gn_b, int vb, float* lds) {
    float* xg = lds;
    __syncthreads();
    const int r = vb, c = threadIdx.x;
    const float* pr = p + (size_t)r * DIN;
    if (c < 64) xg[c] = sigmf(pr[OXG + c]);
    __syncthreads();
    float o = cat[(size_t)r * DM + 512 + c] + so1[(size_t)r * 512 + c];
    float ss = wave_sum(o * o);
    float y = o * rsqrtf(ss * (1.f / 64.f) + 1e-6f) * gdn_norm[c & 63] * siluf(pr[OGGATE + c]);
    float yv = cat[(size_t)r * DM + 768 + c] + so1[(size_t)r * 512 + 256 + c];
    float mu = wave_sum(yv) * (1.f / 64.f);
    float dv = yv - mu;
    float var = wave_sum(dv * dv) * (1.f / 64.f);
    float yn = dv * rsqrtf(var + 64e-5f) * gn_w[c] + gn_b[c];
    float rr = pr[ORKV + c], vv = pr[ORKV + 512 + c];
    float kds = kd_i[(size_t)r * 512 + c] + kd_i[(size_t)r * 512 + 256 + c];
    float bs = wave_sum(rr * kds * r_k[c]);
    float g = 0.f;
    for (int j = 0; j < 64; ++j) g += xg[j] * g_up[j * 256 + c];
    float ro = (yn + bs * vv) * g;
    __syncthreads();
    cat[(size_t)r * DM + 512 + c] = y;
    cat[(size_t)r * DM + 768 + c] = ro;
}

__device__ __forceinline__ void f_resid1(float* ctxs, float* out, const float* __restrict__ mix, const float* __restrict__ g_post, const float* __restrict__ g_pre2,
                         const float* __restrict__ modl, const float* __restrict__ router, float* h2, float* aff, int vb) {
    int r = vb * 4 + (threadIdx.x >> 6), lane = threadIdx.x & 63;
    float* x = xrow_ptr(ctxs, out, r);
    const float* m = modl + modrow(r) * 6 * DM;
    float v[16], xv[16]; float ss = 0.f;
#pragma unroll
    for (int j = 0; j < 16; ++j) { v[j] = mix[(size_t)r * DM + lane + 64 * j]; ss += v[j] * v[j]; }
    ss = wave_sum(ss);
    float rstd = rsqrtf(ss * (1.f / DM) + 1e-6f);
    float s2 = 0.f;
#pragma unroll
    for (int j = 0; j < 16; ++j) { int cidx = lane + 64 * j; xv[j] = x[cidx] + m[2048 + cidx] * (v[j] * rstd * g_post[cidx]); x[cidx] = xv[j]; s2 += xv[j] * xv[j]; }
    s2 = wave_sum(s2);
    float rstd2 = rsqrtf(s2 * (1.f / DM) + 1e-6f);
    float lg[NE];
#pragma unroll
    for (int e = 0; e < NE; ++e) lg[e] = 0.f;
#pragma unroll
    for (int j = 0; j < 16; ++j) {
        int cidx = lane + 64 * j;
        float hv = xv[j] * rstd2 * g_pre2[cidx] * (1.f + m[4096 + cidx]) + m[3072 + cidx];
        h2[(size_t)r * DM + cidx] = hv;
#pragma unroll
        for (int e = 0; e < NE; ++e) lg[e] += hv * router[cidx * NE + e];
    }
    float mxv = -1e30f;
#pragma unroll
    for (int e = 0; e < NE; ++e) { lg[e] = wave_sum(lg[e]); mxv = fmaxf(mxv, lg[e]); }
    float sum = 0.f;
#pragma unroll
    for (int e = 0; e < NE; ++e) { lg[e] = expf(lg[e] - mxv); sum += lg[e]; }
    if (lane < NE) {
        float val = 0.f;
#pragma unroll
        for (int e = 0; e < NE; ++e) if (e == lane) val = lg[e];
        aff[(size_t)r * NE + lane] = val / sum;
    }
}

__device__ __forceinline__ void f_topk(const float* __restrict__ aff, int* sel_lat, int* sel_ctx, int* slot, int vb, float* lds) {
    float* vals = lds;
    __syncthreads();
    const int set = vb >> 5, b = (vb >> 4) & 1, e = vb & 15;
    const int n = set == 0 ? TL : CL, cap = set == 0 ? CAPL : CAPC;
    const int rbase = b * SS + (set == 0 ? CL : 0);
    for (int t = threadIdx.x; t < n; t += 256) vals[t] = aff[(size_t)(rbase + t) * NE + e];
    __syncthreads();
    for (int t = threadIdx.x; t < n; t += 256) {
        float v = vals[t]; int rank = 0;
        for (int u = 0; u < n; ++u) { float w = vals[u]; rank += (w > v || (w == v && u < t)) ? 1 : 0; }
        int sl = rank < cap ? rank : -1;
        slot[(size_t)e * RR + rbase + t] = sl;
        if (sl >= 0) { if (set == 0) sel_lat[(b * NE + e) * CAPL + sl] = rbase + t; else sel_ctx[(b * NE + e) * CAPC + sl] = rbase + t; }
    }
}

__device__ __forceinline__ void f_resid2(float* ctxs, float* out, const float* __restrict__ ye_lat, const float* __restrict__ ye_ctx, const int* __restrict__ slot,
                         const float* __restrict__ g_post, const float* __restrict__ modl, int vb) {
    int r = vb * 4 + (threadIdx.x >> 6), lane = threadIdx.x & 63;
    float* x = xrow_ptr(ctxs, out, r);
    const float* m = modl + modrow(r) * 6 * DM;
    int b = r / SS, s = r % SS;
    float y[16];
#pragma unroll
    for (int j = 0; j < 16; ++j) y[j] = 0.f;
    for (int e = 0; e < NE; ++e) {
        int sl = slot[(size_t)e * RR + r];
        if (sl < 0) continue;
        const float* src = s < CL ? ye_ctx + ((size_t)(b * NE + e) * CAPC + sl) * DM : ye_lat + ((size_t)(b * NE + e) * CAPL + sl) * DM;
#pragma unroll
        for (int j = 0; j < 16; ++j) y[j] += src[lane + 64 * j];
    }
    float ss = 0.f;
#pragma unroll
    for (int j = 0; j < 16; ++j) ss += y[j] * y[j];
    ss = wave_sum(ss);
    float rstd = rsqrtf(ss * (1.f / DM) + 1e-6f);
#pragma unroll
    for (int j = 0; j < 16; ++j) { int cidx = lane + 64 * j; x[cidx] += m[5120 + cidx] * (y[j] * rstd * g_post[cidx]); }
}

struct MP {
    const float *x, *c, *ctx, *c_ctx, *w_mod, *b_mod, *norm_pre, *norm_post, *w_in, *w_out, *da_lambda, *da_norm, *gdn_conv, *gdn_a_log, *gdn_dt_bias, *gdn_norm;
    const float *rwkv_w0, *rwkv_w_up, *rwkv_a0, *rwkv_a_up, *rwkv_g_up, *rwkv_k_k, *rwkv_k_a, *rwkv_r_k, *rwkv_gn_w, *rwkv_gn_b, *moe_router, *moe_w_gate, *moe_w_up, *moe_w_down;
    float *out, *mod, *ctxs, *aff, *bufA, *so1, *P, *prep;
    int *slot, *sel_lat, *sel_ctx;
    void* pad;
};

__global__ __launch_bounds__(256) void mega(MP a) {
    __shared__ __attribute__((aligned(16))) float lds[8192 + 64];
    cg::grid_group grid = cg::this_grid();
    const int nb = gridDim.x, bid = blockIdx.x;
    float* gq = a.prep; float* gk = gq + (size_t)RR * 256; float* gv = gk + (size_t)RR * 256; float* gab = gv + (size_t)RR * 256;
    float* kk_b = gab + (size_t)RR * 16; float* w_b = kk_b + (size_t)RR * 256; float* kka_b = w_b + (size_t)RR * 512; float* kd_b = kka_b + (size_t)RR * 512;
    float* mix = a.prep;
    float* ye_lat = a.prep; float* ye_ctx = ye_lat + (size_t)32 * CAPL * DM;
    float* hid_lat = a.P; float* hid_ctx = a.P + (size_t)32 * CAPL * DM;
    float* h = a.bufA; float* cat = a.bufA; float* h2 = a.bufA;

    f_init(a.x, a.ctx, a.out, a.ctxs, bid, nb);
    for (int vb = bid; vb < (2 * 6 * DM) / 256; vb += nb) f_mod(a.c, a.c_ctx, a.w_mod, a.b_mod, a.mod, vb, lds);
    grid.sync();

    for (int i = 0; i < 2; ++i) {
        const float* modl = a.mod + (size_t)i * 3 * 6 * DM;
        const float lam_init = 0.8f - 0.6f * expf(-0.3f * (float)i);
        for (int vb = bid; vb < RR / 4; vb += nb) f_normmod(a.ctxs, a.out, a.norm_pre + (size_t)(i * 2 + 0) * DM, modl, 0, 1024, h, vb);
        grid.sync();
        {
            GP g{}; g.A = h; g.lda = DM; g.gidx = nullptr; g.a_gstride = 0; g.gidx_gstride = 0; g.B = a.w_in + (size_t)i * DM * DIN; g.B2 = nullptr; g.ldb = DIN; g.b_estride = 0;
            g.C = a.P; g.ldc = DIN; g.c_gstride = 0; g.aff = nullptr; g.M = RR; g.N = DIN; g.K = DM;
            const int nx = (DIN + 63) / 64, ny = RR / 64;
            for (int vb = bid; vb < nx * ny; vb += nb) f_gemm<0>(g, vb % nx, vb / nx, 0, lds);
        }
        grid.sync();
        for (int vb = bid; vb < (RR * 512) / 256; vb += nb) f_rope(a.P, vb);
        for (int vb = bid; vb < RR; vb += nb) f_gdn_prep(a.P, a.gdn_conv + (size_t)i * 5 * 768, a.gdn_a_log + i * 8, a.gdn_dt_bias + i * 8, gq, gk, gv, gab, vb);
        for (int vb = bid; vb < RR; vb += nb) f_rwkv_prep(a.P, a.rwkv_w0 + i * 512, a.rwkv_w_up + (size_t)i * 2 * 32 * 256, a.rwkv_a0 + i * 512, a.rwkv_a_up + (size_t)i * 2 * 32 * 256,
                                                           a.rwkv_k_k + i * 256, a.rwkv_k_a + i * 256, kk_b, w_b, kka_b, kd_b, vb, lds);
        grid.sync();
        if (bid < 32) {
            f_scan(a.P, gq, gk, gv, gab, kk_b, w_b, kka_b, kd_b, cat, a.so1, bid, lds);
        } else {
            const int nx = RR / 32;
            for (int vb = bid - 32; vb < nx * 4; vb += nb - 32) f_attn(a.P, a.da_lambda + (size_t)i * 256, a.da_norm + (size_t)i * 128, lam_init, cat, vb % nx, vb / nx, lds);
        }
        grid.sync();
        for (int vb = bid; vb < RR; vb += nb) f_mix_out(a.P, cat, a.so1, a.gdn_norm + i * 64, kd_b, a.rwkv_g_up + (size_t)i * 64 * 256, a.rwkv_r_k + i * 256, a.rwkv_gn_w + i * 256, a.rwkv_gn_b + i * 256, vb, lds);
        grid.sync();
        {
            GP g{}; g.A = cat; g.lda = DM; g.B = a.w_out + (size_t)i * DM * DM; g.ldb = DM; g.C = mix; g.ldc = DM; g.M = RR; g.N = DM; g.K = DM;
            const int nx = DM / 64, ny = RR / 64;
            for (int vb = bid; vb < nx * ny; vb += nb) f_gemm<0>(g, vb % nx, vb / nx, 0, lds);
        }
        grid.sync();
        for (int vb = bid; vb < RR / 4; vb += nb) f_resid1(a.ctxs, a.out, mix, a.norm_post + (size_t)(i * 2 + 0) * DM, a.norm_pre + (size_t)(i * 2 + 1) * DM, modl, a.moe_router + (size_t)i * DM * NE, h2, a.aff, vb);
        grid.sync();
        for (int vb = bid; vb < 64; vb += nb) f_topk(a.aff, a.sel_lat, a.sel_ctx, a.slot, vb, lds);
        grid.sync();
        for (int set = 0; set < 2; ++set) {
            const int cap = set == 0 ? CAPL : CAPC;
            GP g{}; g.A = h2; g.lda = DM; g.gidx = set == 0 ? a.sel_lat : a.sel_ctx; g.a_gstride = 0; g.gidx_gstride = cap;
            g.B = a.moe_w_gate + (size_t)i * NE * DM * DM; g.B2 = a.moe_w_up + (size_t)i * NE * DM * DM; g.ldb = DM; g.b_estride = (long)DM * DM;
            g.C = set == 0 ? hid_lat : hid_ctx; g.ldc = DM; g.c_gstride = (long)cap * DM; g.aff = nullptr; g.M = cap; g.N = DM; g.K = DM;
            const int nx = DM / 64, ny = (cap + 63) / 64;
            for (int vb = bid; vb < nx * ny * 32; vb += nb) f_gemm<1>(g, vb % nx, (vb / nx) % ny, vb / (nx * ny), lds);
        }
        grid.sync();
        for (int set = 0; set < 2; ++set) {
            const int cap = set == 0 ? CAPL : CAPC;
            GP g{}; g.A = set == 0 ? hid_lat : hid_ctx; g.lda = DM; g.gidx = set == 0 ? a.sel_lat : a.sel_ctx; g.a_gstride = (long)cap * DM; g.gidx_gstride = cap;
            g.B = a.moe_w_down + (size_t)i * NE * DM * DM; g.B2 = nullptr; g.ldb = DM; g.b_estride = (long)DM * DM;
            g.C = set == 0 ? ye_lat : ye_ctx; g.ldc = DM; g.c_gstride = (long)cap * DM; g.aff = a.aff; g.M = cap; g.N = DM; g.K = DM;
            const int nx = DM / 64, ny = (cap + 63) / 64;
            for (int vb = bid; vb < nx * ny * 32; vb += nb) f_gemm<2>(g, vb % nx, (vb / nx) % ny, vb / (nx * ny), lds);
        }
        grid.sync();
        for (int vb = bid; vb < RR / 4; vb += nb) f_resid2(a.ctxs, a.out, ye_lat, ye_ctx, a.slot, a.norm_post + (size_t)(i * 2 + 1) * DM, modl, vb);
        grid.sync();
    }
}

static inline size_t al256(size_t x) { return (x + 255) & ~(size_t)255; }

extern "C" void kernel_launch(void* const* d_in, const int* in_sizes, int n_in, void* d_out, int out_size, void* d_ws, size_t ws_size, hipStream_t stream) {
    static int grid_blocks = 0;
    if (!grid_blocks) {
        int dev = 0, cus = 0, per_cu = 0;
        (void)hipGetDevice(&dev);
        (void)hipDeviceGetAttribute(&cus, hipDeviceAttributeMultiprocessorCount, dev);
        (void)hipOccupancyMaxActiveBlocksPerMultiprocessor(&per_cu, mega, 256, 0);
        if (per_cu < 1) per_cu = 1;
        if (per_cu > 2) per_cu = 2;
        grid_blocks = cus * per_cu;
    }
    MP a{};
    const float** ins = (const float**)&a;
    for (int i = 0; i < 30; ++i) ins[i] = (const float*)d_in[i];
    a.out = (float*)d_out;
    char* w = (char*)d_ws; size_t off = 0;
    auto take = [&](size_t bytes) { char* q = w + off; off += al256(bytes); return q; };
    a.mod = (float*)take((size_t)2 * 3 * 6 * DM * 4);
    a.ctxs = (float*)take((size_t)NB * CL * DM * 4);
    a.aff = (float*)take((size_t)RR * NE * 4);
    a.slot = (int*)take((size_t)NE * RR * 4);
    a.sel_lat = (int*)take((size_t)32 * CAPL * 4);
    a.sel_ctx = (int*)take((size_t)32 * CAPC * 4);
    a.bufA = (float*)take((size_t)RR * DM * 4);
    a.so1 = (float*)take((size_t)RR * 512 * 4);
    a.P = (float*)take((size_t)RR * DIN * 4);
    a.prep = (float*)take((size_t)RR * 2576 * 4);
    if (off > ws_size) { fprintf(stderr, "workspace too small: need %zu have %zu\n", off, ws_size); return; }
    void* args[] = {&a};
    hipError_t e = hipLaunchCooperativeKernel((void*)mega, dim3(grid_blocks), dim3(256), args, 0, stream);
    if (e != hipSuccess) fprintf(stderr, "cooperative launch failed: %s (grid %d)\n", hipGetErrorString(e), grid_blocks);
}
```

```cpp
#include <hip/hip_runtime.h>
#include <stdint.h>
#include <stdio.h>
#include <hip/hip_cooperative_groups.h>
namespace cg = cooperative_groups;

#define NB 2
#define TL 8192
#define CL 256
#define SS 8448
#define RR 16896
#define DM 1024
#define DIN 3472
#define DINP 3584
#define NE 16
#define CAPL 1024
#define CAPC 32
#define OQ 0
#define OKK 512
#define OV 1024
#define OGQKV 1536
#define OGGATE 2304
#define OGA 2560
#define OGB 2568
#define ORKV 2576
#define OXW 3344
#define OXA 3376
#define OXG 3408

typedef unsigned short bf16_t;
typedef short bf16x8 __attribute__((ext_vector_type(8)));
typedef float f32x4 __attribute__((ext_vector_type(4)));
typedef unsigned u32x4 __attribute__((ext_vector_type(4)));
typedef unsigned u32x2 __attribute__((ext_vector_type(2)));
typedef float f32x16 __attribute__((ext_vector_type(16)));
#define MFMA32(a, b, c) __builtin_amdgcn_mfma_f32_32x32x16_bf16((a), (b), (c), 0, 0, 0)
__device__ __forceinline__ int crow(int r, int h) { return (r & 3) + 8 * (r >> 2) + 4 * h; }

#define LAUNDER(x) asm volatile("" : "+v"(x))
__device__ __forceinline__ int ltid() { int t = threadIdx.x; LAUNDER(t); return t; }
__device__ __forceinline__ float siluf(float x) { return x / (1.f + expf(-x)); }
__device__ __forceinline__ float sigmf(float x) { return 1.f / (1.f + expf(-x)); }
__device__ __forceinline__ float wave_sum(float v) {
#pragma unroll
    for (int o = 1; o < 64; o <<= 1) v += __shfl_xor(v, o);
    return v;
}
__device__ __forceinline__ unsigned pk2bf(float lo, float hi) {
    typedef float f2 __attribute__((ext_vector_type(2))); typedef __bf16 b2 __attribute__((ext_vector_type(2)));
    f2 v = {lo, hi}; b2 b = __builtin_convertvector(v, b2); return __builtin_bit_cast(unsigned, b);
}
__device__ __forceinline__ bf16_t f2bf(float f) { return (bf16_t)(pk2bf(f, 0.f) & 0xffffu); }
__device__ __forceinline__ float bf2f(bf16_t u) { return __uint_as_float(((unsigned)u) << 16); }
__device__ __forceinline__ float* xrow_ptr(float* ctxs, float* out, int r) {
    int b = r / SS, s = r % SS;
    return s < CL ? ctxs + ((size_t)(b * CL + s)) * DM : out + ((size_t)(b * TL + (s - CL))) * DM;
}
__device__ __forceinline__ int modrow(int r) { int b = r / SS, s = r % SS; return s < CL ? 2 : b; }

__device__ __forceinline__ void f_init(const float* __restrict__ x, const float* __restrict__ ctx, float* out, float* ctxs, int vb, int nvb) {
    const int TID = ltid();
    size_t i = (size_t)vb * 256 + TID;
    size_t n1 = (size_t)NB * TL * DM / 4, n2 = (size_t)NB * CL * DM / 4;
    for (size_t j = i; j < n1; j += (size_t)nvb * 256) ((float4*)out)[j] = ((const float4*)x)[j];
    for (size_t j = i; j < n2; j += (size_t)nvb * 256) ((float4*)ctxs)[j] = ((const float4*)ctx)[j];
}

__device__ __forceinline__ void f_mod(const float* __restrict__ c, const float* __restrict__ c_ctx, const float* __restrict__ w_mod,
                      const float* __restrict__ b_mod, float* mod, int vb, float* lds) {
    const int TID = ltid();
    float (*cs)[DM] = (float (*)[DM])lds;
    __syncthreads();
    for (int i = TID; i < DM; i += 256) {
        cs[0][i] = siluf(c[i]); cs[1][i] = siluf(c[DM + i]); cs[2][i] = siluf(c_ctx[i]);
    }
    __syncthreads();
    int idx = vb * 256 + TID;
    int l = idx / (6 * DM), n = idx % (6 * DM);
    const float* w = w_mod + (size_t)l * DM * 6 * DM + n;
    float a0 = 0.f, a1 = 0.f, a2 = 0.f;
    for (int k = 0; k < DM; ++k) { float wv = w[(size_t)k * 6 * DM]; a0 += cs[0][k] * wv; a1 += cs[1][k] * wv; a2 += cs[2][k] * wv; }
    float bb = b_mod[l * 6 * DM + n];
    mod[(l * 3 + 0) * 6 * DM + n] = a0 + bb;
    mod[(l * 3 + 1) * 6 * DM + n] = a1 + bb;
    mod[(l * 3 + 2) * 6 * DM + n] = a2 + bb;
}

__device__ __forceinline__ void f_wconv(const float* __restrict__ W, int N, bf16_t* Wt, int rowmap, int kt, int nt, float* lds) {
    const int TID = ltid();
    float (*T)[65] = (float (*)[65])lds;
    const int tid = TID;
    __syncthreads();
#pragma unroll
    for (int i = 0; i < 16; ++i) {
        int k = (tid >> 6) + 4 * i, n = tid & 63;
        int gn = nt * 64 + n;
        T[k][n] = gn < N ? W[(size_t)(kt * 64 + k) * N + gn] : 0.f;
    }
    __syncthreads();
#pragma unroll
    for (int i = 0; i < 2; ++i) {
        int n = (tid >> 3) + 32 * i, kc = tid & 7;
        int gn = nt * 64 + n;
        int drow = rowmap == 0 ? gn : (32 * (gn >> 4) + (gn & 15) + (rowmap == 2 ? 16 : 0));
        u32x4 o;
        o[0] = pk2bf(T[kc * 8 + 0][n], T[kc * 8 + 1][n]); o[1] = pk2bf(T[kc * 8 + 2][n], T[kc * 8 + 3][n]);
        o[2] = pk2bf(T[kc * 8 + 4][n], T[kc * 8 + 5][n]); o[3] = pk2bf(T[kc * 8 + 6][n], T[kc * 8 + 7][n]);
        *(u32x4*)(Wt + (size_t)drow * DM + kt * 64 + kc * 8) = o;
    }
}

__device__ __forceinline__ void f_normmod(float* ctxs, float* out, const float* __restrict__ g, const float* __restrict__ modl, int sh_off, int sc_off, bf16_t* h, int vb) {
    const int TID = ltid();
    int r = vb * 4 + (TID >> 6), lane = TID & 63;
    const float* x = xrow_ptr(ctxs, out, r);
    const float* m = modl + modrow(r) * 6 * DM;
    f32x4 v[4]; float ss = 0.f;
#pragma unroll
    for (int j = 0; j < 4; ++j) { v[j] = *(const f32x4*)(x + 4 * lane + 256 * j); ss += v[j][0] * v[j][0] + v[j][1] * v[j][1] + v[j][2] * v[j][2] + v[j][3] * v[j][3]; }
    ss = wave_sum(ss);
    float rstd = rsqrtf(ss * (1.f / DM) + 1e-6f);
#pragma unroll
    for (int j = 0; j < 4; ++j) {
        int c0 = 4 * lane + 256 * j;
        f32x4 gg = *(const f32x4*)(g + c0), sc = *(const f32x4*)(m + sc_off + c0), sh = *(const f32x4*)(m + sh_off + c0);
        f32x4 o4 = v[j] * rstd * gg * (1.f + sc) + sh;
        u32x2 o; o[0] = pk2bf(o4[0], o4[1]); o[1] = pk2bf(o4[2], o4[3]);
        *(u32x2*)(h + (size_t)r * DM + c0) = o;
    }
}

template <class AP, class BP, class Epi>
__device__ __forceinline__ void gemm128(const AP& aptr, const BP& bptr, int K, const Epi& epi, char* lds) {
    const int TID = ltid();
    const int tid = TID, lane = tid & 63, wid = tid >> 6, wr = wid >> 1, wc = wid & 1, fr = lane & 15, fq = lane >> 4;
    const bf16_t* ag[4]; const bf16_t* bg[4]; int lo[4];
#pragma unroll
    for (int i = 0; i < 4; ++i) {
        int row = (tid >> 3) + 32 * i, ch = tid & 7;
        ag[i] = aptr(row) + ch * 8; bg[i] = bptr(row) + ch * 8;
        lo[i] = row * 128 + ((ch ^ ((row >> 1) & 7)) << 4);
    }
    f32x4 acc[4][4];
#pragma unroll
    for (int m = 0; m < 4; ++m)
#pragma unroll
        for (int n = 0; n < 4; ++n) acc[m][n] = (f32x4){0.f, 0.f, 0.f, 0.f};
    u32x4 ra[4], rb[4];
#pragma unroll
    for (int i = 0; i < 4; ++i) { ra[i] = *(const u32x4*)(ag[i]); rb[i] = *(const u32x4*)(bg[i]); }
    __syncthreads();
#pragma unroll
    for (int i = 0; i < 4; ++i) { *(u32x4*)(lds + lo[i]) = ra[i]; *(u32x4*)(lds + 16384 + lo[i]) = rb[i]; }
    __syncthreads();
    const int nk = K / 64;
    const int swz = fr >> 1;
    for (int kt = 0; kt < nk; ++kt) {
        const int buf = kt & 1;
        if (kt + 1 < nk) {
#pragma unroll
            for (int i = 0; i < 4; ++i) { ra[i] = *(const u32x4*)(ag[i] + (kt + 1) * 64); rb[i] = *(const u32x4*)(bg[i] + (kt + 1) * 64); }
        }
        const char* la = lds + buf * 32768; const char* lb = la + 16384;
#pragma unroll
        for (int ks = 0; ks < 2; ++ks) {
            bf16x8 af[4], bfr[4];
            const int coff = ((ks * 4 + fq) ^ swz) << 4;
#pragma unroll
            for (int m = 0; m < 4; ++m) af[m] = *(const bf16x8*)(la + (wr * 64 + m * 16 + fr) * 128 + coff);
#pragma unroll
            for (int n = 0; n < 4; ++n) bfr[n] = *(const bf16x8*)(lb + (wc * 64 + n * 16 + fr) * 128 + coff);
#pragma unroll
            for (int m = 0; m < 4; ++m)
#pragma unroll
                for (int n = 0; n < 4; ++n) acc[m][n] = __builtin_amdgcn_mfma_f32_16x16x32_bf16(bfr[n], af[m], acc[m][n], 0, 0, 0);
        }
        if (kt + 1 < nk) {
            char* wa = lds + (buf ^ 1) * 32768;
#pragma unroll
            for (int i = 0; i < 4; ++i) { *(u32x4*)(wa + lo[i]) = ra[i]; *(u32x4*)(wa + 16384 + lo[i]) = rb[i]; }
        }
        __syncthreads();
    }
    epi(acc, wr, wc, fr, fq);
}

struct RowDense { const bf16_t* base; size_t ld; __device__ __forceinline__ const bf16_t* operator()(int row) const { return base + (size_t)row * ld; } };
struct RowGather { const bf16_t* base; const int* idx; int maxrow; __device__ __forceinline__ const bf16_t* operator()(int row) const { int r = row < maxrow ? row : maxrow - 1; return base + (size_t)idx[r] * DM; } };

struct EpiInProj {
    bf16_t* P; bf16_t* VT; const float2* tab; int m0, n0;
    __device__ __forceinline__ void operator()(f32x4 (&acc)[4][4], int wr, int wc, int fr, int fq) const {
        const bool rope = n0 < 1024;
        const bool isv = n0 >= OV && n0 < OGQKV;
#pragma unroll
        for (int m = 0; m < 4; ++m) {
            const int r = m0 + wr * 64 + m * 16 + fr;
            const int b = r / SS, s = r % SS;
            if (rope && s >= CL) {
                const int t = s - CL;
#pragma unroll
                for (int ax = 0; ax < 2; ++ax) {
                    const int pos = ax == 0 ? (t >> 6) : (t & 63);
#pragma unroll
                    for (int j = 0; j < 4; ++j) {
                        const float2 cs = tab[pos * 16 + 4 * fq + j];
                        const float x1 = acc[m][2 * ax][j], x2 = acc[m][2 * ax + 1][j];
                        acc[m][2 * ax][j] = x1 * cs.x - x2 * cs.y;
                        acc[m][2 * ax + 1][j] = x2 * cs.x + x1 * cs.y;
                    }
                }
            }
            if (isv) {
                const int u = s & 15;
                const int ps = (s & ~15) | (((u >> 2) & 1) << 3) | ((u >> 3) << 2) | (u & 3);
#pragma unroll
                for (int n = 0; n < 4; ++n)
#pragma unroll
                    for (int j = 0; j < 4; ++j) {
                        const int c = n0 - OV + wc * 64 + n * 16 + 4 * fq + j;
                        VT[((size_t)(b * 4 + (c >> 7)) * 128 + (c & 127)) * SS + ps] = f2bf(acc[m][n][j]);
                    }
            } else {
#pragma unroll
                for (int n = 0; n < 4; ++n) {
                    u32x2 o; o[0] = pk2bf(acc[m][n][0], acc[m][n][1]); o[1] = pk2bf(acc[m][n][2], acc[m][n][3]);
                    *(u32x2*)(P + (size_t)r * DINP + n0 + wc * 64 + n * 16 + 4 * fq) = o;
                }
            }
        }
    }
};
struct EpiF32 {
    float* C; int ldc; int m0, n0;
    __device__ __forceinline__ void operator()(f32x4 (&acc)[4][4], int wr, int wc, int fr, int fq) const {
#pragma unroll
        for (int m = 0; m < 4; ++m)
#pragma unroll
            for (int n = 0; n < 4; ++n) *(f32x4*)(C + (size_t)(m0 + wr * 64 + m * 16 + fr) * ldc + n0 + wc * 64 + n * 16 + 4 * fq) = acc[m][n];
    }
};
struct EpiMoE1 {
    bf16_t* hid; int m0, n0, cap;
    __device__ __forceinline__ void operator()(f32x4 (&acc)[4][4], int wr, int wc, int fr, int fq) const {
#pragma unroll
        for (int m = 0; m < 4; ++m) {
            const int r = m0 + wr * 64 + m * 16 + fr;
            if (r >= cap) continue;
#pragma unroll
            for (int q = 0; q < 2; ++q) {
                float v[4];
#pragma unroll
                for (int j = 0; j < 4; ++j) v[j] = siluf(acc[m][2 * q][j]) * acc[m][2 * q + 1][j];
                u32x2 o; o[0] = pk2bf(v[0], v[1]); o[1] = pk2bf(v[2], v[3]);
                *(u32x2*)(hid + (size_t)r * DM + (n0 >> 1) + wc * 32 + q * 16 + 4 * fq) = o;
            }
        }
    }
};
struct EpiMoE2 {
    bf16_t* ye; const float* aff; const int* sel; int e, m0, n0, cap;
    __device__ __forceinline__ void operator()(f32x4 (&acc)[4][4], int wr, int wc, int fr, int fq) const {
#pragma unroll
        for (int m = 0; m < 4; ++m) {
            const int r = m0 + wr * 64 + m * 16 + fr;
            if (r >= cap) continue;
            const float sc = aff[(size_t)sel[r] * NE + e];
#pragma unroll
            for (int n = 0; n < 4; ++n) {
                u32x2 o; o[0] = pk2bf(acc[m][n][0] * sc, acc[m][n][1] * sc); o[1] = pk2bf(acc[m][n][2] * sc, acc[m][n][3] * sc);
                *(u32x2*)(ye + (size_t)r * DM + n0 + wc * 64 + n * 16 + 4 * fq) = o;
            }
        }
    }
};

__device__ __forceinline__ void f_attn(const bf16_t* __restrict__ P, const bf16_t* __restrict__ VT, const float* __restrict__ da_lambda, const float* __restrict__ da_norm,
                                       float lam_init, bf16_t* cat, int bh, int qb, char* lds) {
    const int TID = ltid();
    const int lane = TID & 63, wid = TID >> 6, ql = lane & 31, hi = lane >> 5;
    const int map = wid >> 1, qsub = wid & 1;
    const int b = bh >> 2, h = bh & 3;
    const int row0 = b * SS + qb * 64;
    const int ntiles = (qb < 4 ? CL : SS) / 64;
    const float C = 0.125f * 1.4426950408889634f;
    float* wsf = (float*)(lds + 65536) + wid * 64;
    const bf16_t* kg[4]; const bf16_t* vg[4]; int klo[4], vlo[4];
#pragma unroll
    for (int i = 0; i < 4; ++i) {
        const int ch = TID & 7;
        const int krow = (TID >> 3) + 32 * (i & 1), km = i >> 1;
        kg[i] = P + (size_t)(b * SS + krow) * DINP + OKK + h * 128 + km * 64 + ch * 8;
        klo[i] = km * 8192 + krow * 128 + ((ch ^ ((krow >> 1) & 7)) << 4);
        const int vrow = (TID >> 3) + 32 * i;
        vg[i] = VT + (size_t)(bh * 128 + vrow) * SS + ch * 8;
        vlo[i] = 16384 + vrow * 128 + ((ch ^ ((vrow >> 1) & 7)) << 4);
    }
    bf16x8 qf[4];
    {
        const bf16_t* qp = P + (size_t)(row0 + qsub * 32 + ql) * DINP + OQ + h * 128 + map * 64 + 8 * hi;
#pragma unroll
        for (int d0 = 0; d0 < 4; ++d0) qf[d0] = *(const bf16x8*)(qp + 16 * d0);
    }
    f32x16 O[4];
#pragma unroll
    for (int cb = 0; cb < 4; ++cb)
#pragma unroll
        for (int r = 0; r < 16; ++r) O[cb][r] = 0.f;
    float mrun = -1e30f, lrun = 0.f;
    u32x4 rk[4], rv[4];
#pragma unroll
    for (int i = 0; i < 4; ++i) { rk[i] = *(const u32x4*)(kg[i]); rv[i] = *(const u32x4*)(vg[i]); }
    __syncthreads();
#pragma unroll
    for (int i = 0; i < 4; ++i) { *(u32x4*)(lds + klo[i]) = rk[i]; *(u32x4*)(lds + vlo[i]) = rv[i]; }
    __syncthreads();
    const int swz = (ql >> 1) & 7;
    for (int t = 0; t < ntiles; ++t) {
        const int buf = t & 1;
        if (t + 1 < ntiles) {
#pragma unroll
            for (int i = 0; i < 4; ++i) { rk[i] = *(const u32x4*)(kg[i] + (size_t)(t + 1) * 64 * DINP); rv[i] = *(const u32x4*)(vg[i] + (t + 1) * 64); }
        }
        const char* kb = lds + buf * 32768 + map * 8192;
        const char* vb = lds + buf * 32768 + 16384;
        f32x16 p0, p1;
#pragma unroll
        for (int r = 0; r < 16; ++r) { p0[r] = 0.f; p1[r] = 0.f; }
#pragma unroll
        for (int d0 = 0; d0 < 4; ++d0) {
            const int co = ((2 * d0 + hi) ^ swz) << 4;
            const bf16x8 k0f = *(const bf16x8*)(kb + ql * 128 + co);
            const bf16x8 k1f = *(const bf16x8*)(kb + (32 + ql) * 128 + co);
            p0 = MFMA32(k0f, qf[d0], p0);
            p1 = MFMA32(k1f, qf[d0], p1);
        }
        float tm = fmaxf(p0[0], p1[0]);
#pragma unroll
        for (int r = 1; r < 16; ++r) tm = fmaxf(tm, fmaxf(p0[r], p1[r]));
        tm = fmaxf(tm, __shfl_xor(tm, 32));
        const float mnew = fmaxf(mrun, tm);
        if (__any(mnew > mrun)) {
            const float alpha = __builtin_amdgcn_exp2f((mrun - mnew) * C);
            lrun *= alpha; mrun = mnew;
            if (hi == 0) wsf[ql] = alpha;
            __builtin_amdgcn_s_waitcnt(0xc07f);
#pragma unroll
            for (int r = 0; r < 16; ++r) {
                const float f = wsf[crow(r, hi)];
#pragma unroll
                for (int cb = 0; cb < 4; ++cb) O[cb][r] *= f;
            }
        }
        const float mc = mrun * C;
        float ls = 0.f;
#pragma unroll
        for (int r = 0; r < 16; ++r) {
            p0[r] = __builtin_amdgcn_exp2f(fmaf(p0[r], C, -mc)); p1[r] = __builtin_amdgcn_exp2f(fmaf(p1[r], C, -mc));
            ls += p0[r] + p1[r];
        }
        lrun += ls;
        bf16x8 pf[4];
#pragma unroll
        for (int s = 0; s < 4; ++s) {
            u32x4 w;
#pragma unroll
            for (int j = 0; j < 4; ++j) w[j] = (s < 2) ? pk2bf(p0[8 * (s & 1) + 2 * j], p0[8 * (s & 1) + 2 * j + 1]) : pk2bf(p1[8 * (s & 1) + 2 * j], p1[8 * (s & 1) + 2 * j + 1]);
            pf[s] = __builtin_bit_cast(bf16x8, w);
        }
#pragma unroll
        for (int cb = 0; cb < 4; ++cb)
#pragma unroll
            for (int s = 0; s < 4; ++s) {
                const bf16x8 vf = *(const bf16x8*)(vb + (cb * 32 + ql) * 128 + (((2 * s + hi) ^ swz) << 4));
                O[cb] = MFMA32(pf[s], vf, O[cb]);
            }
        if (t + 1 < ntiles) {
            char* wb = lds + (buf ^ 1) * 32768;
#pragma unroll
            for (int i = 0; i < 4; ++i) { *(u32x4*)(wb + klo[i]) = rk[i]; *(u32x4*)(wb + vlo[i]) = rv[i]; }
        }
        __syncthreads();
    }
    lrun += __shfl_xor(lrun, 32);
    if (hi == 0) wsf[ql] = 1.f / lrun;
    __builtin_amdgcn_s_waitcnt(0xc07f);
    float* ost = (float*)lds + wid * 4096;
#pragma unroll
    for (int r = 0; r < 16; ++r) {
        const int q = crow(r, hi);
        const float f = wsf[q];
#pragma unroll
        for (int cb = 0; cb < 4; ++cb) ost[q * 128 + cb * 32 + ql] = O[cb][r] * f;
    }
    __syncthreads();
    float s01 = 0.f, s23 = 0.f;
    for (int d = 0; d < 64; ++d) { s01 += da_lambda[d] * da_lambda[64 + d]; s23 += da_lambda[128 + d] * da_lambda[192 + d]; }
    const float lam = expf(s01) - expf(s23) + lam_init;
    const float g0 = da_norm[lane] * (1.f - lam_init), g1 = da_norm[lane + 64] * (1.f - lam_init);
    for (int qq = 0; qq < 16; ++qq) {
        const int q = wid * 16 + qq, qs = q >> 5, qlq = q & 31;
        const float* o0 = (const float*)lds + qs * 4096 + qlq * 128;
        const float* o1 = (const float*)lds + (2 + qs) * 4096 + qlq * 128;
        const float v0 = o0[lane] - lam * o1[lane], v1 = o0[lane + 64] - lam * o1[lane + 64];
        const float ssq = wave_sum(v0 * v0 + v1 * v1);
        const float rstd = rsqrtf(ssq * (1.f / 128.f) + 1e-6f);
        bf16_t* dst = cat + (size_t)(row0 + q) * DM + h * 128;
        dst[lane] = f2bf(v0 * rstd * g0); dst[lane + 64] = f2bf(v1 * rstd * g1);
    }
}

__device__ __forceinline__ void f_gdn_prep(const bf16_t* __restrict__ p, const float* __restrict__ conv_w, const float* __restrict__ a_log,
                                                  const float* __restrict__ dt_bias, bf16_t* gq, bf16_t* gk, bf16_t* gv, float* gab, int vb) {
    const int TID = ltid();
    const int r = vb, c = TID;
    const int b = r / SS, s = r % SS;
    int seg_lo = s < CL ? 0 : CL, seg_hi = s < CL ? CL : SS;
    float val[3];
#pragma unroll
    for (int j3 = 0; j3 < 3; ++j3) {
        int ch = j3 * 256 + c;
        float acc = 0.f;
#pragma unroll
        for (int j = 0; j < 5; ++j) {
            int s2 = s + j - 2;
            if (s2 >= seg_lo && s2 < seg_hi) acc += bf2f(p[(size_t)(b * SS + s2) * DINP + OGQKV + ch]) * conv_w[j * 768 + ch];
        }
        val[j3] = siluf(acc);
    }
    float sq = wave_sum(val[0] * val[0]);
    float sk = wave_sum(val[1] * val[1]);
    gq[(size_t)r * 256 + c] = f2bf(val[0] * rsqrtf(sq + 1e-12f) * 0.125f);
    gk[(size_t)r * 256 + c] = f2bf(val[1] * rsqrtf(sk + 1e-12f));
    gv[(size_t)r * 256 + c] = f2bf(val[2]);
    if (c < 8) {
        float a = bf2f(p[(size_t)r * DINP + OGA + c]);
        float xx = a + dt_bias[c];
        float sp = xx > 20.f ? xx : log1pf(expf(xx));
        float gg = -expf(a_log[c]) * sp;
        gab[(size_t)r * 16 + c] = gg;
    } else if (c < 16) {
        float bb = bf2f(p[(size_t)r * DINP + OGB + (c - 8)]);
        gab[(size_t)r * 16 + c] = sigmf(bb);
    }
}

__device__ __forceinline__ void f_rwkv_prep(const bf16_t* __restrict__ p, const float* __restrict__ w0, const float* __restrict__ w_up,
                                                   const float* __restrict__ a0, const float* __restrict__ a_up, const float* __restrict__ k_k,
                                                   const float* __restrict__ k_a, bf16_t* kk_o, float* w_o, bf16_t* kka_o, bf16_t* kd_o, int vb, float* lds) {
    const int TID = ltid();
    float* xw = lds; float* xa = lds + 32;
    __syncthreads();
    const int r = vb, c = TID;
    const bf16_t* pr = p + (size_t)r * DINP;
    if (c < 32) xw[c] = tanhf(bf2f(pr[OXW + c]));
    else if (c < 64) xa[c - 32] = bf2f(pr[OXA + (c - 32)]);
    __syncthreads();
    float k = bf2f(pr[ORKV + 256 + c]);
    float kq = k * k_k[c];
    float ss = wave_sum(kq * kq);
    float kk = kq * rsqrtf(ss + 1e-12f);
    kk_o[(size_t)r * 256 + c] = f2bf(kk);
#pragma unroll
    for (int d = 0; d < 2; ++d) {
        float aw = w0[d * 256 + c], aa = a0[d * 256 + c];
        for (int j = 0; j < 32; ++j) { aw += xw[j] * w_up[(d * 32 + j) * 256 + c]; aa += xa[j] * a_up[(d * 32 + j) * 256 + c]; }
        float logw = -0.6065306597126334f * sigmf(aw);
        float ad = sigmf(aa);
        w_o[(size_t)r * 512 + d * 256 + c] = logw;
        kka_o[(size_t)r * 512 + d * 256 + c] = f2bf(kk * ad);
        kd_o[(size_t)r * 512 + d * 256 + c] = f2bf(k * (1.f + (ad - 1.f) * k_a[c]));
    }
}

#define MFMA16(a, b, c) __builtin_amdgcn_mfma_f32_16x16x32_bf16((a), (b), (c), 0, 0, 0)
__device__ __forceinline__ int scan_row(int b, int dir, int p) {
    const int s = dir == 0 ? p : (p < CL ? (CL - 1 - p) : (CL + (TL - 1 - (p - CL))));
    return b * SS + s;
}
__device__ __forceinline__ void mm64(const char* A, const char* Bt, f32x4 (&acc)[4], int w, int fr, int fq) {
#pragma unroll
    for (int ks = 0; ks < 2; ++ks) {
        const int co = ((ks * 4 + fq) ^ (fr >> 1)) << 4;
        const bf16x8 af = *(const bf16x8*)(A + (16 * w + fr) * 128 + co);
#pragma unroll
        for (int n = 0; n < 4; ++n) { const bf16x8 bfr = *(const bf16x8*)(Bt + (16 * n + fr) * 128 + co); acc[n] = MFMA16(bfr, af, acc[n]); }
    }
}
__device__ __forceinline__ void zero4(f32x4 (&acc)[4]) {
#pragma unroll
    for (int n = 0; n < 4; ++n) acc[n] = (f32x4){0.f, 0.f, 0.f, 0.f};
}
__device__ __forceinline__ void tile_row_write(char* T, int c, const float (&x)[64]) {
#pragma unroll
    for (int ch = 0; ch < 8; ++ch) {
        u32x4 o; o[0] = pk2bf(x[8 * ch], x[8 * ch + 1]); o[1] = pk2bf(x[8 * ch + 2], x[8 * ch + 3]); o[2] = pk2bf(x[8 * ch + 4], x[8 * ch + 5]); o[3] = pk2bf(x[8 * ch + 6], x[8 * ch + 7]);
        *(u32x4*)(T + c * 128 + ((ch ^ ((c >> 1) & 7)) << 4)) = o;
    }
}
__device__ __forceinline__ void tri_solve(const float* Am, float (&x)[64]) {
#pragma unroll
    for (int i = 1; i < 64; ++i) {
        float acc = x[i];
#pragma unroll
        for (int j = 0; j < i; ++j) acc -= Am[i * 64 + j] * x[j];
        x[i] = acc;
    }
}
__device__ __forceinline__ void store_perm(bf16_t* dst, const f32x4 (&acc)[4], int w, int fr, int fq) {
#pragma unroll
    for (int n = 0; n < 4; ++n) {
        u32x2 o; o[0] = pk2bf(acc[n][0], acc[n][1]); o[1] = pk2bf(acc[n][2], acc[n][3]);
        *(u32x2*)(dst + (16 * w + fr) * 64 + 32 * (n >> 1) + 8 * fq + 4 * (n & 1)) = o;
    }
}
__device__ __forceinline__ void store_acc(bf16_t* dst, const f32x4 (&acc)[4], int w, int fr, int fq) {
#pragma unroll
    for (int n = 0; n < 4; ++n)
#pragma unroll
        for (int jj = 0; jj < 4; ++jj) dst[((n * 4 + w) * 64 + (4 * fq + jj) + 16 * (fr >> 2)) * 4 + (fr & 3)] = f2bf(acc[n][jj]);
}

#define TILE(k) (lds + (k) * 8192)
#define SCAL ((float*)(lds + 73728))
__device__ __forceinline__ float tile_get(const char* T, int i, int c3, int clow) { return bf2f(*(const bf16_t*)(T + i * 128 + (((c3 ^ ((i >> 1) & 7)) << 4) | clow))); }
__device__ __forceinline__ void tile_put(char* T, int i, int c3, int clow, float v) { *(bf16_t*)(T + i * 128 + (((c3 ^ ((i >> 1) & 7)) << 4) | clow)) = f2bf(v); }
__device__ __forceinline__ void stage_tile(char* T, const bf16_t* base, size_t ld, int b, int dir, int p0, int TID) {
#pragma unroll
    for (int k = 0; k < 2; ++k) {
        const int id = TID + 256 * k, row = id >> 3, chn = id & 7;
        const size_t r = scan_row(b, dir, p0 + row);
        *(u32x4*)(T + row * 128 + ((chn ^ ((row >> 1) & 7)) << 4)) = *(const u32x4*)(base + r * ld + chn * 8);
    }
}
__device__ __forceinline__ f32x4 tile_get4(const char* T, int i, int j0) {
    const u32x2 rv = *(const u32x2*)(T + i * 128 + (((j0 >> 3) ^ ((i >> 1) & 7)) << 4) + (j0 & 7) * 2);
    return (f32x4){bf2f((bf16_t)(rv[0] & 0xffffu)), bf2f((bf16_t)(rv[0] >> 16)), bf2f((bf16_t)(rv[1] & 0xffffu)), bf2f((bf16_t)(rv[1] >> 16))};
}
__device__ __forceinline__ void tile_put4(char* T, int i, int j0, float v0, float v1, float v2, float v3) {
    u32x2 o; o[0] = pk2bf(v0, v1); o[1] = pk2bf(v2, v3);
    *(u32x2*)(T + i * 128 + (((j0 >> 3) ^ ((i >> 1) & 7)) << 4) + (j0 & 7) * 2) = o;
}

__device__ __forceinline__ void f_chunk_gdn(const bf16_t* __restrict__ gq, const bf16_t* __restrict__ gk, const bf16_t* __restrict__ gv, const float* __restrict__ gab,
                                            bf16_t* X, int chain, int n, char* lds) {
    const int TID = ltid();
    const int lane = TID & 63, w = TID >> 6, fr = lane & 15, fq = lane >> 4;
    const int dir = chain & 1, h = (chain >> 1) & 3, b = chain >> 3;
    float* gcs = SCAL; float* bts = SCAL + 64;
    float* Am = (float*)TILE(7);
    __syncthreads();
    if (TID < 64) {
        const int r = scan_row(b, dir, n * 64 + TID);
        float g = gab[(size_t)r * 16 + dir * 4 + h];
#pragma unroll
        for (int o = 1; o < 64; o <<= 1) { const float t = __shfl_up(g, o); if (lane >= o) g += t; }
        gcs[TID] = g; bts[TID] = gab[(size_t)r * 16 + 8 + dir * 4 + h];
    }
    stage_tile(TILE(0), gq + h * 64, 256, b, dir, n * 64, TID);
    stage_tile(TILE(1), gk + h * 64, 256, b, dir, n * 64, TID);
    stage_tile(TILE(3), gv + h * 64, 256, b, dir, n * 64, TID);
    __syncthreads();
    {
        const int i = 16 * w + fr; const float gi = gcs[i], bi = bts[i];
        f32x4 acc[4]; zero4(acc); mm64(TILE(1), TILE(1), acc, w, fr, fq);
#pragma unroll
        for (int nn = 0; nn < 4; ++nn)
#pragma unroll
            for (int jj = 0; jj < 4; ++jj) { const int j = 16 * nn + 4 * fq + jj; Am[i * 64 + j] = j < i ? bi * acc[nn][jj] * __expf(gi - gcs[j]) : 0.f; }
        zero4(acc); mm64(TILE(0), TILE(1), acc, w, fr, fq);
#pragma unroll
        for (int nn = 0; nn < 4; ++nn) {
            float v[4];
#pragma unroll
            for (int jj = 0; jj < 4; ++jj) { const int j = 16 * nn + 4 * fq + jj; v[jj] = j <= i ? acc[nn][jj] * __expf(gi - gcs[j]) : 0.f; }
            tile_put4(TILE(2), i, 16 * nn + 4 * fq, v[0], v[1], v[2], v[3]);
        }
    }
    __syncthreads();
    if (TID < 192) {
        const int c = lane, c3 = c >> 3, clow = (c & 7) << 1;
        float x[64];
        if (w == 0) {
#pragma unroll
            for (int i = 0; i < 64; ++i) x[i] = tile_get(TILE(3), i, c3, clow) * bts[i];
            tri_solve(Am, x); tile_row_write(TILE(4), c, x);
        } else if (w == 1) {
#pragma unroll
            for (int i = 0; i < 64; ++i) x[i] = tile_get(TILE(1), i, c3, clow) * bts[i] * __expf(gcs[i]);
            tri_solve(Am, x); tile_row_write(TILE(5), c, x);
        } else {
            const float g63 = gcs[63];
#pragma unroll
            for (int i = 0; i < 64; ++i) x[i] = tile_get(TILE(1), i, c3, clow) * __expf(g63 - gcs[i]);
            tile_row_write(TILE(6), c, x);
        }
    }
    __syncthreads();
    {
        bf16_t* Xi = X + ((size_t)(chain * 132 + n)) * 16384;
        const int i = 16 * w + fr;
        f32x4 acc[4];
        zero4(acc); mm64(TILE(2), TILE(4), acc, w, fr, fq); store_acc(Xi + 8192, acc, w, fr, fq);
        zero4(acc); mm64(TILE(2), TILE(5), acc, w, fr, fq);
        {
            const float eg = __expf(gcs[i]);
#pragma unroll
            for (int nn = 0; nn < 4; ++nn) { const f32x4 qv = tile_get4(TILE(0), i, 16 * nn + 4 * fq); acc[nn] = qv * eg - acc[nn]; }
            store_perm(Xi + 4096, acc, w, fr, fq);
        }
        zero4(acc); mm64(TILE(6), TILE(5), acc, w, fr, fq);
        {
            const float gt = __expf(gcs[63]);
#pragma unroll
            for (int nn = 0; nn < 4; ++nn)
#pragma unroll
                for (int jj = 0; jj < 4; ++jj) acc[nn][jj] = ((16 * nn + 4 * fq + jj) == i ? gt : 0.f) - acc[nn][jj];
            store_perm(Xi, acc, w, fr, fq);
        }
        zero4(acc); mm64(TILE(6), TILE(4), acc, w, fr, fq); store_acc(Xi + 12288, acc, w, fr, fq);
    }
}

__device__ __forceinline__ void f_chunk_rwkv(const bf16_t* __restrict__ P, const bf16_t* __restrict__ kk_i, const float* __restrict__ lw_i, const bf16_t* __restrict__ kka_i,
                                             const bf16_t* __restrict__ kd_i, bf16_t* X, int chain, int n, char* lds) {
    const int TID = ltid();
    const int lane = TID & 63, w = TID >> 6, fr = lane & 15, fq = lane >> 4;
    const int dir = chain & 1, h = (chain >> 1) & 3, b = chain >> 3;
    const int c3 = lane >> 3, clow = (lane & 7) << 1;
    float* wc = SCAL;
    float* Am = (float*)TILE(7);
    __syncthreads();
    stage_tile(TILE(0), kk_i + h * 64, 256, b, dir, n * 64, TID);
    stage_tile(TILE(1), kka_i + dir * 256 + h * 64, 512, b, dir, n * 64, TID);
    stage_tile(TILE(2), kd_i + dir * 256 + h * 64, 512, b, dir, n * 64, TID);
    stage_tile(TILE(3), P + ORKV + h * 64, DINP, b, dir, n * 64, TID);
    stage_tile(TILE(4), P + ORKV + 512 + h * 64, DINP, b, dir, n * 64, TID);
#pragma unroll
    for (int k = 0; k < 4; ++k) {
        const int id = TID + 256 * k, row = id >> 4, chn = id & 15;
        const size_t r = scan_row(b, dir, n * 64 + row);
        *(f32x4*)(Am + row * 64 + chn * 4) = *(const f32x4*)(lw_i + r * 512 + dir * 256 + h * 64 + chn * 4);
    }
    __syncthreads();
    {
        float lc = 0.f;
        char* T = TILE(w);
#pragma unroll
        for (int i = 0; i < 64; ++i) {
            const float lprev = lc; lc += Am[i * 64 + lane];
            const float e = w == 0 ? lprev : (w == 3 ? lc : -lc);
            tile_put(T, i, c3, clow, tile_get(T, i, c3, clow) * __expf(e));
        }
        if (w == 0) wc[lane] = __expf(lc);
    }
    __syncthreads();
    if (w == 0) {
        float x[64];
#pragma unroll
        for (int i = 0; i < 64; ++i) x[i] = tile_get(TILE(4), i, c3, clow);
        tile_row_write(TILE(5), lane, x);
    }
    {
        const int i = 16 * w + fr;
        f32x4 acc[4];
        zero4(acc); mm64(TILE(0), TILE(1), acc, w, fr, fq);
#pragma unroll
        for (int nn = 0; nn < 4; ++nn)
#pragma unroll
            for (int jj = 0; jj < 4; ++jj) { const int j = 16 * nn + 4 * fq + jj; Am[i * 64 + j] = j < i ? acc[nn][jj] : 0.f; }
        zero4(acc); mm64(TILE(0), TILE(2), acc, w, fr, fq);
#pragma unroll
        for (int nn = 0; nn < 4; ++nn) {
            float v[4];
#pragma unroll
            for (int jj = 0; jj < 4; ++jj) { const int j = 16 * nn + 4 * fq + jj; v[jj] = j < i ? acc[nn][jj] : 0.f; }
            tile_put4(TILE(6), i, 16 * nn + 4 * fq, v[0], v[1], v[2], v[3]);
        }
    }
    __syncthreads();
    {
        const int i = 16 * w + fr;
        f32x4 acc[4]; zero4(acc); mm64(TILE(6), TILE(5), acc, w, fr, fq);
#pragma unroll
        for (int nn = 0; nn < 4; ++nn)
#pragma unroll
            for (int jj = 0; jj < 4; ++jj) { const int c = 16 * nn + 4 * fq + jj; *(bf16_t*)(TILE(4) + c * 128 + ((((i >> 3) ^ ((c >> 1) & 7)) << 4) | ((i & 7) << 1))) = f2bf(acc[nn][jj]); }
    }
    __syncthreads();
    if (w < 2) {
        float x[64];
        if (w == 0) {
#pragma unroll
            for (int ch = 0; ch < 8; ++ch) {
                const bf16x8 v = *(const bf16x8*)(TILE(4) + lane * 128 + ((ch ^ ((lane >> 1) & 7)) << 4));
#pragma unroll
                for (int e = 0; e < 8; ++e) x[8 * ch + e] = -bf2f((bf16_t)v[e]);
            }
        } else {
#pragma unroll
            for (int i = 0; i < 64; ++i) x[i] = tile_get(TILE(0), i, c3, clow);
        }
        tri_solve(Am, x);
        tile_row_write(w == 0 ? TILE(6) : TILE(0), lane, x);
    }
    __syncthreads();
    {
        const int i = 16 * w + fr;
#pragma unroll
        for (int q = 0; q < 2; ++q) {
            f32x4 acc[4]; zero4(acc); mm64(TILE(3), TILE(1 + q), acc, w, fr, fq);
#pragma unroll
            for (int nn = 0; nn < 4; ++nn) {
                float v[4];
#pragma unroll
                for (int jj = 0; jj < 4; ++jj) { const int j = 16 * nn + 4 * fq + jj; v[jj] = j <= i ? acc[nn][jj] : 0.f; }
                tile_put4(TILE(7 + q), i, 16 * nn + 4 * fq, v[0], v[1], v[2], v[3]);
            }
        }
    }
    if (w == 0) {
        float x[64]; const float wd = wc[lane];
#pragma unroll
        for (int i = 0; i < 64; ++i) x[i] = tile_get(TILE(1), i, c3, clow) * wd;
        tile_row_write(TILE(4), lane, x);
    }
    __syncthreads();
    bf16_t* Xi = X + ((size_t)((16 + chain) * 132 + n)) * 16384;
    f32x4 sa[4];
    {
        const int i = 16 * w + fr;
        f32x4 acc[4];
        zero4(acc); mm64(TILE(7), TILE(6), acc, w, fr, fq); mm64(TILE(8), TILE(5), acc, w, fr, fq); store_acc(Xi + 8192, acc, w, fr, fq);
        zero4(acc); mm64(TILE(7), TILE(0), acc, w, fr, fq);
#pragma unroll
        for (int nn = 0; nn < 4; ++nn) { const f32x4 rv = tile_get4(TILE(3), i, 16 * nn + 4 * fq); acc[nn] = rv - acc[nn]; }
        store_perm(Xi + 4096, acc, w, fr, fq);
        zero4(acc); mm64(TILE(4), TILE(0), acc, w, fr, fq);
        {
            const float wd = wc[i];
#pragma unroll
            for (int nn = 0; nn < 4; ++nn)
#pragma unroll
                for (int jj = 0; jj < 4; ++jj) acc[nn][jj] = ((16 * nn + 4 * fq + jj) == i ? wd : 0.f) - acc[nn][jj];
            store_perm(Xi, acc, w, fr, fq);
        }
        zero4(sa); mm64(TILE(4), TILE(6), sa, w, fr, fq);
    }
    __syncthreads();
    if (w == 0) {
        float x[64]; const float wd = wc[lane];
#pragma unroll
        for (int i = 0; i < 64; ++i) x[i] = tile_get(TILE(2), i, c3, clow) * wd;
        tile_row_write(TILE(4), lane, x);
    }
    __syncthreads();
    mm64(TILE(4), TILE(5), sa, w, fr, fq); store_acc(Xi + 12288, sa, w, fr, fq);
}

__device__ __forceinline__ void f_scan2(const bf16_t* __restrict__ X, bf16_t* so, int mc  , int slab) {
    const int lane = threadIdx.x & 63, c = lane & 15, q = lane >> 4;
    const int mixer = mc >> 4, chain = mc & 15, dir = chain & 1, h = (chain >> 1) & 3, b = chain >> 3;
    f32x4 S[4];
#pragma unroll
    for (int mb = 0; mb < 4; ++mb) S[mb] = (f32x4){0.f, 0.f, 0.f, 0.f};
#pragma unroll 1
    for (int n = 0; n < 132; ++n) {
        const bf16_t* Xi = X + ((size_t)(mc * 132 + n)) * 16384;
        bf16x8 bS[2];
#pragma unroll
        for (int s = 0; s < 2; ++s) {
            u32x4 o; o[0] = pk2bf(S[2 * s][0], S[2 * s][1]); o[1] = pk2bf(S[2 * s][2], S[2 * s][3]); o[2] = pk2bf(S[2 * s + 1][0], S[2 * s + 1][1]); o[3] = pk2bf(S[2 * s + 1][2], S[2 * s + 1][3]);
            bS[s] = __builtin_bit_cast(bf16x8, o);
        }
#pragma unroll
        for (int mb = 0; mb < 4; ++mb) {
            const u32x2 y0 = *(const u32x2*)(Xi + 8192 + ((slab * 4 + mb) * 64 + lane) * 4);
            f32x4 y = (f32x4){bf2f((bf16_t)(y0[0] & 0xffffu)), bf2f((bf16_t)(y0[0] >> 16)), bf2f((bf16_t)(y0[1] & 0xffffu)), bf2f((bf16_t)(y0[1] >> 16))};
            const u32x2 s0 = *(const u32x2*)(Xi + 12288 + ((slab * 4 + mb) * 64 + lane) * 4);
            f32x4 sn = (f32x4){bf2f((bf16_t)(s0[0] & 0xffffu)), bf2f((bf16_t)(s0[0] >> 16)), bf2f((bf16_t)(s0[1] & 0xffffu)), bf2f((bf16_t)(s0[1] >> 16))};
#pragma unroll
            for (int s = 0; s < 2; ++s) {
                const bf16x8 ar = *(const bf16x8*)(Xi + 4096 + (16 * mb + c) * 64 + 32 * s + 8 * q);
                const bf16x8 ag = *(const bf16x8*)(Xi + (16 * mb + c) * 64 + 32 * s + 8 * q);
                y = MFMA16(ar, bS[s], y);
                sn = MFMA16(ag, bS[s], sn);
            }
#pragma unroll
            for (int reg = 0; reg < 4; ++reg) {
                const int r = scan_row(b, dir, n * 64 + 16 * mb + 4 * q + reg);
                so[((size_t)dir * RR + r) * 512 + mixer * 256 + h * 64 + slab * 16 + c] = f2bf(y[reg]);
            }
            S[mb] = sn;
        }
    }
}

__device__ __forceinline__ void f_mix_out(const bf16_t* __restrict__ p, bf16_t* cat, const bf16_t* __restrict__ so, const float* __restrict__ gdn_norm,
                                                 const bf16_t* __restrict__ kd_i, const float* __restrict__ g_up, const float* __restrict__ r_k,
                                                 const float* __restrict__ gn_w, const float* __restrict__ gn_b, int vb, float* lds) {
    const int TID = ltid();
    float* xg = lds;
    __syncthreads();
    const int r = vb, c = TID;
    const bf16_t* pr = p + (size_t)r * DINP;
    if (c < 64) xg[c] = sigmf(bf2f(pr[OXG + c]));
    __syncthreads();
    float o = bf2f(so[(size_t)r * 512 + c]) + bf2f(so[((size_t)RR + r) * 512 + c]);
    float ss = wave_sum(o * o);
    float y = o * rsqrtf(ss * (1.f / 64.f) + 1e-6f) * gdn_norm[c & 63] * siluf(bf2f(pr[OGGATE + c]));
    float yv = bf2f(so[(size_t)r * 512 + 256 + c]) + bf2f(so[((size_t)RR + r) * 512 + 256 + c]);
    float mu = wave_sum(yv) * (1.f / 64.f);
    float dv = yv - mu;
    float var = wave_sum(dv * dv) * (1.f / 64.f);
    float yn = dv * rsqrtf(var + 64e-5f) * gn_w[c] + gn_b[c];
    float rr = bf2f(pr[ORKV + c]), vv = bf2f(pr[ORKV + 512 + c]);
    float kds = bf2f(kd_i[(size_t)r * 512 + c]) + bf2f(kd_i[(size_t)r * 512 + 256 + c]);
    float bs = wave_sum(rr * kds * r_k[c]);
    float g = 0.f;
    for (int j = 0; j < 64; ++j) g += xg[j] * g_up[j * 256 + c];
    float ro = (yn + bs * vv) * g;
    cat[(size_t)r * DM + 512 + c] = f2bf(y);
    cat[(size_t)r * DM + 768 + c] = f2bf(ro);
}

__device__ __forceinline__ void f_resid1(float* ctxs, float* out, const float* __restrict__ mix, const float* __restrict__ g_post, const float* __restrict__ g_pre2,
                         const float* __restrict__ modl, const float* __restrict__ router, bf16_t* h2, float* aff, int vb) {
    const int TID = ltid();
    int r = vb * 4 + (TID >> 6), lane = TID & 63;
    float* x = xrow_ptr(ctxs, out, r);
    const float* m = modl + modrow(r) * 6 * DM;
    float v[16], xv[16]; float ss = 0.f;
#pragma unroll
    for (int j = 0; j < 16; ++j) { v[j] = mix[(size_t)r * DM + lane + 64 * j]; ss += v[j] * v[j]; }
    ss = wave_sum(ss);
    float rstd = rsqrtf(ss * (1.f / DM) + 1e-6f);
    float s2 = 0.f;
#pragma unroll
    for (int j = 0; j < 16; ++j) { int cidx = lane + 64 * j; xv[j] = x[cidx] + m[2048 + cidx] * (v[j] * rstd * g_post[cidx]); x[cidx] = xv[j]; s2 += xv[j] * xv[j]; }
    s2 = wave_sum(s2);
    float rstd2 = rsqrtf(s2 * (1.f / DM) + 1e-6f);
    float lg[NE];
#pragma unroll
    for (int e = 0; e < NE; ++e) lg[e] = 0.f;
#pragma unroll
    for (int j = 0; j < 16; ++j) {
        int cidx = lane + 64 * j;
        float hv = xv[j] * rstd2 * g_pre2[cidx] * (1.f + m[4096 + cidx]) + m[3072 + cidx];
        h2[(size_t)r * DM + cidx] = f2bf(hv);
#pragma unroll
        for (int e = 0; e < NE; ++e) lg[e] += hv * router[cidx * NE + e];
    }
    float mxv = -1e30f;
#pragma unroll
    for (int e = 0; e < NE; ++e) { lg[e] = wave_sum(lg[e]); mxv = fmaxf(mxv, lg[e]); }
    float sum = 0.f;
#pragma unroll
    for (int e = 0; e < NE; ++e) { lg[e] = expf(lg[e] - mxv); sum += lg[e]; }
    if (lane < NE) {
        float val = 0.f;
#pragma unroll
        for (int e = 0; e < NE; ++e) if (e == lane) val = lg[e];
        aff[(size_t)r * NE + lane] = val / sum;
    }
}

__device__ __forceinline__ void f_topk(const float* __restrict__ aff, int* sel_lat, int* sel_ctx, int* slot, int vb, float* lds) {
    const int TID = ltid();
    unsigned* vals = (unsigned*)lds;
    unsigned* hist = (unsigned*)lds + 8192 + 256;
    unsigned* sc = hist + 256;
    unsigned* ctl = sc + 512;
    const int set = vb >> 5, b = (vb >> 4) & 1, e = vb & 15;
    const int n = set == 0 ? TL : CL, cap = set == 0 ? CAPL : CAPC;
    const int per = n >> 8;
    const int rbase = b * SS + (set == 0 ? CL : 0);
    __syncthreads();
    for (int t = TID; t < n; t += 256) vals[t + (t >> 5)] = __float_as_uint(aff[(size_t)(rbase + t) * NE + e]);
    if (TID == 0) { ctl[0] = 0u; ctl[1] = (unsigned)cap; }
    __syncthreads();
    for (int pass = 0; pass < 4; ++pass) {
        const int shift = 24 - 8 * pass;
        hist[TID] = 0u;
        __syncthreads();
        const unsigned prefix = ctl[0];
        const unsigned pmask = pass == 0 ? 0u : (0xffffffffu << (shift + 8));
        for (int j = 0; j < per; ++j) {
            const int t = TID * per + j;
            const unsigned v = vals[t + (t >> 5)];
            if ((v & pmask) == prefix) atomicAdd(&hist[(v >> shift) & 255u], 1u);
        }
        __syncthreads();
        if (TID == 0) {
            unsigned rem = ctl[1], d = 255u;
            for (;; --d) { const unsigned hc = hist[d]; if (hc >= rem || d == 0u) break; rem -= hc; }
            ctl[0] = prefix | (d << shift); ctl[1] = rem;
        }
        __syncthreads();
    }
    const unsigned thr = ctl[0], need_eq = ctl[1];
    unsigned cg = 0u, ce = 0u;
    for (int j = 0; j < per; ++j) { const int t = TID * per + j; const unsigned v = vals[t + (t >> 5)]; cg += v > thr ? 1u : 0u; ce += v == thr ? 1u : 0u; }
    sc[TID] = ce; __syncthreads();
    for (int o = 1; o < 256; o <<= 1) { const unsigned add = TID >= o ? sc[TID - o] : 0u; __syncthreads(); sc[TID] += add; __syncthreads(); }
    const unsigned eq_before = sc[TID] - ce;
    const unsigned eq_take = eq_before >= need_eq ? 0u : (need_eq - eq_before < ce ? need_eq - eq_before : ce);
    const unsigned csel = cg + eq_take;
    sc[256 + TID] = csel; __syncthreads();
    for (int o = 1; o < 256; o <<= 1) { const unsigned add = TID >= o ? sc[256 + TID - o] : 0u; __syncthreads(); sc[256 + TID] += add; __syncthreads(); }
    unsigned pos = sc[256 + TID] - csel;
    unsigned eq_seen = eq_before;
    for (int j = 0; j < per; ++j) {
        const int t = TID * per + j; const unsigned v = vals[t + (t >> 5)];
        bool take = v > thr;
        if (v == thr) { take = eq_seen < need_eq; ++eq_seen; }
        int sl = -1;
        if (take) { sl = (int)pos; ++pos; if (set == 0) sel_lat[(b * NE + e) * CAPL + sl] = rbase + t; else sel_ctx[(b * NE + e) * CAPC + sl] = rbase + t; }
        slot[(size_t)e * RR + rbase + t] = sl;
    }
}

__device__ __forceinline__ void f_resid2(float* ctxs, float* out, const bf16_t* __restrict__ ye_lat, const bf16_t* __restrict__ ye_ctx, const int* __restrict__ slot,
                         const float* __restrict__ g_post, const float* __restrict__ modl, int vb) {
    const int TID = ltid();
    int r = vb * 4 + (TID >> 6), lane = TID & 63;
    float* x = xrow_ptr(ctxs, out, r);
    const float* m = modl + modrow(r) * 6 * DM;
    int b = r / SS, s = r % SS;
    float y[16];
#pragma unroll
    for (int j = 0; j < 16; ++j) y[j] = 0.f;
    for (int e = 0; e < NE; ++e) {
        int sl = slot[(size_t)e * RR + r];
        if (sl < 0) continue;
        const bf16_t* src = s < CL ? ye_ctx + ((size_t)(b * NE + e) * CAPC + sl) * DM : ye_lat + ((size_t)(b * NE + e) * CAPL + sl) * DM;
#pragma unroll
        for (int j = 0; j < 16; ++j) y[j] += bf2f(src[lane + 64 * j]);
    }
    float ss = 0.f;
#pragma unroll
    for (int j = 0; j < 16; ++j) ss += y[j] * y[j];
    ss = wave_sum(ss);
    float rstd = rsqrtf(ss * (1.f / DM) + 1e-6f);
#pragma unroll
    for (int j = 0; j < 16; ++j) { int cidx = lane + 64 * j; x[cidx] += m[5120 + cidx] * (y[j] * rstd * g_post[cidx]); }
}

#ifndef REPMASK
#define REPMASK 0
#endif
#define REPS(k) for (int rep_ = 0; rep_ < (((REPMASK) >> (k)) & 1) + 1; ++rep_)
struct MP {
    const float *x, *c, *ctx, *c_ctx, *w_mod, *b_mod, *norm_pre, *norm_post, *w_in, *w_out, *da_lambda, *da_norm, *gdn_conv, *gdn_a_log, *gdn_dt_bias, *gdn_norm;
    const float *rwkv_w0, *rwkv_w_up, *rwkv_a0, *rwkv_a_up, *rwkv_g_up, *rwkv_k_k, *rwkv_k_a, *rwkv_r_k, *rwkv_gn_w, *rwkv_gn_b, *moe_router, *moe_w_gate, *moe_w_up, *moe_w_down;
    float *out, *mod, *ctxs, *aff;
    float2* tab;
    bf16_t *wt_in, *wt_out, *bufA, *so, *P, *R3, *VT, *XC;
    int *slot, *sel_lat, *sel_ctx, *cnt;
};

__global__ __launch_bounds__(256) void mega(MP a) {
    __shared__ __attribute__((aligned(16))) float lds[18432 + 256];
    cg::grid_group grid = cg::this_grid();
    const int nb = gridDim.x, bid = blockIdx.x;
    bf16_t* gq = a.R3; bf16_t* gk = gq + (size_t)RR * 256; bf16_t* gv = gk + (size_t)RR * 256;
    bf16_t* kk_b = gv + (size_t)RR * 256; bf16_t* kka_b = kk_b + (size_t)RR * 256; bf16_t* kd_b = kka_b + (size_t)RR * 512;
    float* w_b = (float*)(kd_b + (size_t)RR * 512); float* gab = w_b + (size_t)RR * 512;
    float* mix = (float*)a.R3;
    bf16_t* ye_lat = a.R3; bf16_t* ye_ctx = ye_lat + (size_t)32 * CAPL * DM;
    bf16_t* hid_lat = a.P; bf16_t* hid_ctx = a.P + (size_t)32 * CAPL * DM;
    bf16_t* h = a.bufA; bf16_t* cat = a.bufA; bf16_t* h2 = a.bufA;
    bf16_t* wt_gu = a.XC; bf16_t* wt_dn = a.XC + (size_t)NE * 2 * DM * DM;

    if (bid == 0 && threadIdx.x < 4) a.cnt[threadIdx.x] = 0;
    REPS(0) {
    f_init(a.x, a.ctx, a.out, a.ctxs, bid, nb);
    for (int vb = bid; vb < (2 * 6 * DM) / 256; vb += nb) f_mod(a.c, a.c_ctx, a.w_mod, a.b_mod, a.mod, vb, lds);
    for (int i = bid * 256 + threadIdx.x; i < 128 * 16; i += nb * 256) {
        int pos = i >> 4, f = i & 15;
        float ang = (float)pos * powf(10000.f, -(float)f / 16.f);
        a.tab[i] = make_float2(cosf(ang), sinf(ang));
    }
    {
        const int T_IN = 2 * 16 * 56, T_OUT = 2 * 16 * 16;
        for (int vb = bid; vb < T_IN + T_OUT; vb += nb) {
            int t = vb;
            if (t < T_IN) { int l = t / (16 * 56), q = t % (16 * 56); f_wconv(a.w_in + (size_t)l * DM * DIN, DIN, a.wt_in + (size_t)l * DINP * DM, 0, q / 56, q % 56, lds); continue; }
            t -= T_IN;
            { int l = t / 256, q = t % 256; f_wconv(a.w_out + (size_t)l * DM * DM, DM, a.wt_out + (size_t)l * DM * DM, 0, q / 16, q % 16, lds); }
        }
    }
    }
    grid.sync();

    for (int i = 0; i < 2; ++i) {
        const float* modl = a.mod + (size_t)i * 3 * 6 * DM;
        const float lam_init = 0.8f - 0.6f * expf(-0.3f * (float)i);
        REPS(1) for (int vb = bid; vb < RR / 4; vb += nb) f_normmod(a.ctxs, a.out, a.norm_pre + (size_t)(i * 2 + 0) * DM, modl, 0, 1024, h, vb);
        grid.sync();
        REPS(2) for (int vb = bid; vb < 132 * 28; vb += nb) {
            const int mt = vb / 28, nt = vb % 28;
            RowDense ap{h + (size_t)mt * 128 * DM, DM}; RowDense bp{a.wt_in + (size_t)i * DINP * DM + (size_t)nt * 128 * DM, DM};
            EpiInProj ep{a.P, a.VT, a.tab, mt * 128, nt * 128};
            gemm128(ap, bp, DM, ep, (char*)lds);
        }
        grid.sync();
        REPS(3) for (int vb = bid; vb < RR; vb += nb) f_gdn_prep(a.P, a.gdn_conv + (size_t)i * 5 * 768, a.gdn_a_log + i * 8, a.gdn_dt_bias + i * 8, gq, gk, gv, gab, vb);
        REPS(4) for (int vb = bid; vb < RR; vb += nb) f_rwkv_prep(a.P, a.rwkv_w0 + i * 512, a.rwkv_w_up + (size_t)i * 2 * 32 * 256, a.rwkv_a0 + i * 512, a.rwkv_a_up + (size_t)i * 2 * 32 * 256,
                                                           a.rwkv_k_k + i * 256, a.rwkv_k_a + i * 256, kk_b, w_b, kka_b, kd_b, vb, lds);
        grid.sync();
        REPS(5) for (int vb = bid; vb < 32 * 132; vb += nb) {
            const int mc = vb / 132, n = vb % 132;
            if (mc < 16) f_chunk_gdn(gq, gk, gv, gab, a.XC, mc, n, (char*)lds);
            else f_chunk_rwkv(a.P, kk_b, w_b, kka_b, kd_b, a.XC, mc - 16, n, (char*)lds);
        }
        grid.sync();
        REPS(6) if (bid < 32) f_scan2(a.XC, a.so, bid, threadIdx.x >> 6);
        REPS(7) {
            const int nunits = i == 0 ? 1056 : 1024;
            int* sidx = (int*)(lds + 18432 + 128);
            for (;;) {
                __syncthreads();
                if (threadIdx.x == 0) *sidx = atomicAdd(a.cnt + i + 2 * rep_, 1);
                __syncthreads();
                const int u = *sidx;
                if (u >= nunits) break;
                int ubh, uqb;
                if (u < 1024) { ubh = u >> 7; uqb = 4 + (u & 127); } else { ubh = (u - 1024) >> 2; uqb = (u - 1024) & 3; }
                f_attn(a.P, a.VT, a.da_lambda + (size_t)i * 256, a.da_norm + (size_t)i * 128, lam_init, cat, ubh, uqb, (char*)lds);
            }
        }
        grid.sync();
        REPS(8) for (int vb = bid; vb < RR; vb += nb) f_mix_out(a.P, cat, a.so, a.gdn_norm + i * 64, kd_b, a.rwkv_g_up + (size_t)i * 64 * 256, a.rwkv_r_k + i * 256, a.rwkv_gn_w + i * 256, a.rwkv_gn_b + i * 256, vb, lds);
        REPS(9) for (int vb = bid; vb < 3 * 4096; vb += nb) {
            const int which = vb / 4096, q = vb % 4096, e = q / 256, qq = q % 256;
            const size_t le = (size_t)(i * NE + e);
            if (which == 0) f_wconv(a.moe_w_gate + le * DM * DM, DM, wt_gu + (size_t)e * 2 * DM * DM, 1, qq / 16, qq % 16, lds);
            else if (which == 1) f_wconv(a.moe_w_up + le * DM * DM, DM, wt_gu + (size_t)e * 2 * DM * DM, 2, qq / 16, qq % 16, lds);
            else f_wconv(a.moe_w_down + le * DM * DM, DM, wt_dn + (size_t)e * DM * DM, 0, qq / 16, qq % 16, lds);
        }
        grid.sync();
        REPS(10) for (int vb = bid; vb < 132 * 8; vb += nb) {
            const int mt = vb / 8, nt = vb % 8;
            RowDense ap{cat + (size_t)mt * 128 * DM, DM}; RowDense bp{a.wt_out + (size_t)i * DM * DM + (size_t)nt * 128 * DM, DM};
            EpiF32 ep{mix, DM, mt * 128, nt * 128};
            gemm128(ap, bp, DM, ep, (char*)lds);
        }
        grid.sync();
        for (int vb = bid; vb < RR / 4; vb += nb) f_resid1(a.ctxs, a.out, mix, a.norm_post + (size_t)(i * 2 + 0) * DM, a.norm_pre + (size_t)(i * 2 + 1) * DM, modl, a.moe_router + (size_t)i * DM * NE, h2, a.aff, vb);
        grid.sync();
        REPS(11) for (int vb = bid; vb < 64; vb += nb) f_topk(a.aff, a.sel_lat, a.sel_ctx, a.slot, vb, lds);
        grid.sync();
        REPS(12) for (int vb = bid; vb < 32 * 8 * 16 + 32 * 16; vb += nb) {
            int g, mt, nt, cap; const int* sel; bf16_t* hid;
            if (vb < 32 * 8 * 16) { g = vb / 128; mt = (vb % 128) / 16; nt = vb % 16; cap = CAPL; sel = a.sel_lat + g * CAPL; hid = hid_lat + (size_t)g * CAPL * DM; }
            else { int t = vb - 32 * 8 * 16; g = t / 16; mt = 0; nt = t % 16; cap = CAPC; sel = a.sel_ctx + g * CAPC; hid = hid_ctx + (size_t)g * CAPC * DM; }
            const int e = g % NE;
            RowGather ap{h2, sel + mt * 128, cap - mt * 128}; RowDense bp{wt_gu + ((size_t)e * 2 * DM + (size_t)nt * 128) * DM, DM};
            EpiMoE1 ep{hid, mt * 128, nt * 128, cap};
            gemm128(ap, bp, DM, ep, (char*)lds);
        }
        grid.sync();
        REPS(13) for (int vb = bid; vb < 32 * 8 * 8 + 32 * 8; vb += nb) {
            int g, mt, nt, cap; const int* sel; const bf16_t* hid; bf16_t* ye;
            if (vb < 32 * 8 * 8) { g = vb / 64; mt = (vb % 64) / 8; nt = vb % 8; cap = CAPL; sel = a.sel_lat + g * CAPL; hid = hid_lat + (size_t)g * CAPL * DM; ye = ye_lat + (size_t)g * CAPL * DM; }
            else { int t = vb - 32 * 8 * 8; g = t / 8; mt = 0; nt = t % 8; cap = CAPC; sel = a.sel_ctx + g * CAPC; hid = hid_ctx + (size_t)g * CAPC * DM; ye = ye_ctx + (size_t)g * CAPC * DM; }
            const int e = g % NE;
            RowDense ap{hid + (size_t)mt * 128 * DM, DM}; RowDense bp{wt_dn + ((size_t)e * DM + (size_t)nt * 128) * DM, DM};
            EpiMoE2 ep{ye, a.aff, sel, e, mt * 128, nt * 128, cap};
            gemm128(ap, bp, DM, ep, (char*)lds);
        }
        grid.sync();
        for (int vb = bid; vb < RR / 4; vb += nb) f_resid2(a.ctxs, a.out, ye_lat, ye_ctx, a.slot, a.norm_post + (size_t)(i * 2 + 1) * DM, modl, vb);
        grid.sync();
    }
}

static inline size_t al256(size_t x) { return (x + 255) & ~(size_t)255; }

extern "C" void kernel_launch(void* const* d_in, const int* in_sizes, int n_in, void* d_out, int out_size, void* d_ws, size_t ws_size, hipStream_t stream) {
    static int grid_blocks = 0;
    if (!grid_blocks) {
        int dev = 0, cus = 0, per_cu = 0;
        (void)hipGetDevice(&dev);
        (void)hipDeviceGetAttribute(&cus, hipDeviceAttributeMultiprocessorCount, dev);
        (void)hipOccupancyMaxActiveBlocksPerMultiprocessor(&per_cu, mega, 256, 0);
        if (per_cu < 1) per_cu = 1;
        if (per_cu > 2) per_cu = 2;
        grid_blocks = cus * per_cu;
    }
    MP a{};
    const float** ins = (const float**)&a;
    for (int i = 0; i < 30; ++i) ins[i] = (const float*)d_in[i];
    a.out = (float*)d_out;
    char* w = (char*)d_ws; size_t off = 0;
    auto take = [&](size_t bytes) { char* q = w + off; off += al256(bytes); return q; };
    a.mod = (float*)take((size_t)2 * 3 * 6 * DM * 4);
    a.ctxs = (float*)take((size_t)NB * CL * DM * 4);
    a.aff = (float*)take((size_t)RR * NE * 4);
    a.tab = (float2*)take((size_t)128 * 16 * 8);
    a.slot = (int*)take((size_t)NE * RR * 4);
    a.sel_lat = (int*)take((size_t)32 * CAPL * 4);
    a.sel_ctx = (int*)take((size_t)32 * CAPC * 4);
    a.wt_in = (bf16_t*)take((size_t)2 * DINP * DM * 2);
    a.wt_out = (bf16_t*)take((size_t)2 * DM * DM * 2);
    a.bufA = (bf16_t*)take((size_t)RR * DM * 2);
    a.so = (bf16_t*)take((size_t)2 * RR * 512 * 2);
    a.P = (bf16_t*)take((size_t)RR * DINP * 2);
    a.R3 = (bf16_t*)take((size_t)RR * 6208);
    a.VT = (bf16_t*)take((size_t)NB * 4 * 128 * SS * 2);
    a.cnt = (int*)take(256);
    a.XC = (bf16_t*)take((size_t)32 * 132 * 16384 * 2);
    if (off > ws_size) { fprintf(stderr, "workspace too small: need %zu have %zu\n", off, ws_size); return; }
    void* args[] = {&a};
    hipError_t e = hipLaunchCooperativeKernel((void*)mega, dim3(grid_blocks), dim3(256), args, 0, stream);
    if (e != hipSuccess) fprintf(stderr, "cooperative launch failed: %s (grid %d)\n", hipGetErrorString(e), grid_blocks);
}
```

```cpp
#include <hip/hip_runtime.h>
#include <stdint.h>
#include <stdio.h>
#include <hip/hip_cooperative_groups.h>
namespace cg = cooperative_groups;

#define NB 2
#define TL 8192
#define CL 256
#define SS 8448
#define RR 16896
#define DM 1024
#define DIN 3472
#define DINP 3584
#define NE 16
#define CAPL 1024
#define CAPC 32
#define OQ 0
#define OKK 512
#define OV 1024
#define OGQKV 1536
#define OGGATE 2304
#define OGA 2560
#define OGB 2568
#define ORKV 2576
#define OXW 3344
#define OXA 3376
#define OXG 3408

typedef unsigned short bf16_t;
typedef short bf16x8 __attribute__((ext_vector_type(8)));
typedef float f32x4 __attribute__((ext_vector_type(4)));
typedef unsigned u32x4 __attribute__((ext_vector_type(4)));
typedef unsigned u32x2 __attribute__((ext_vector_type(2)));
typedef float f32x16 __attribute__((ext_vector_type(16)));
#define MFMA32(a, b, c) __builtin_amdgcn_mfma_f32_32x32x16_bf16((a), (b), (c), 0, 0, 0)
__device__ __forceinline__ int crow(int r, int h) { return (r & 3) + 8 * (r >> 2) + 4 * h; }

#define LAUNDER(x) asm volatile("" : "+v"(x))
__device__ __forceinline__ int lsgpr(int x) { asm volatile("" : "+s"(x)); return x; }
__device__ __forceinline__ int ltid() { int t = threadIdx.x; LAUNDER(t); return t; }
__device__ __forceinline__ float siluf(float x) { return x / (1.f + expf(-x)); }
__device__ __forceinline__ float sigmf(float x) { return 1.f / (1.f + expf(-x)); }
__device__ __forceinline__ float wave_sum(float v) {
#pragma unroll
    for (int o = 1; o < 64; o <<= 1) v += __shfl_xor(v, o);
    return v;
}
__device__ __forceinline__ unsigned pk2bf(float lo, float hi) {
    typedef float f2 __attribute__((ext_vector_type(2))); typedef __bf16 b2 __attribute__((ext_vector_type(2)));
    f2 v = {lo, hi}; b2 b = __builtin_convertvector(v, b2); return __builtin_bit_cast(unsigned, b);
}
__device__ __forceinline__ bf16_t f2bf(float f) { return (bf16_t)(pk2bf(f, 0.f) & 0xffffu); }
__device__ __forceinline__ float bf2f(bf16_t u) { return __uint_as_float(((unsigned)u) << 16); }
__device__ __forceinline__ float* xrow_ptr(float* ctxs, float* out, int r) {
    int b = r >= SS ? 1 : 0, s = r - b * SS;
    return s < CL ? ctxs + ((size_t)(b * CL + s)) * DM : out + ((size_t)(b * TL + (s - CL))) * DM;
}
__device__ __forceinline__ int modrow(int r) { int b = r >= SS ? 1 : 0, s = r - b * SS; return s < CL ? 2 : b; }

__device__ __forceinline__ void f_init(const float* __restrict__ x, const float* __restrict__ ctx, float* out, float* ctxs, int vb, int nvb) {
    const int TID = ltid();
    size_t i = (size_t)vb * 256 + TID;
    size_t n1 = (size_t)NB * TL * DM / 4, n2 = (size_t)NB * CL * DM / 4;
    for (size_t j = i; j < n1; j += (size_t)nvb * 256) ((float4*)out)[j] = ((const float4*)x)[j];
    for (size_t j = i; j < n2; j += (size_t)nvb * 256) ((float4*)ctxs)[j] = ((const float4*)ctx)[j];
}

__device__ __forceinline__ void f_mod(const float* __restrict__ c, const float* __restrict__ c_ctx, const float* __restrict__ w_mod,
                      const float* __restrict__ b_mod, float* mod, int vb, float* lds) {
    const int TID = ltid();
    float (*cs)[DM] = (float (*)[DM])lds;
    __syncthreads();
    for (int i = TID; i < DM; i += 256) {
        cs[0][i] = siluf(c[i]); cs[1][i] = siluf(c[DM + i]); cs[2][i] = siluf(c_ctx[i]);
    }
    __syncthreads();
    int idx = vb * 256 + TID;
    int l = idx / (6 * DM), n = idx % (6 * DM);
    const float* w = w_mod + (size_t)l * DM * 6 * DM + n;
    float a0 = 0.f, a1 = 0.f, a2 = 0.f;
    for (int k = 0; k < DM; ++k) { float wv = w[(size_t)k * 6 * DM]; a0 += cs[0][k] * wv; a1 += cs[1][k] * wv; a2 += cs[2][k] * wv; }
    float bb = b_mod[l * 6 * DM + n];
    mod[(l * 3 + 0) * 6 * DM + n] = a0 + bb;
    mod[(l * 3 + 1) * 6 * DM + n] = a1 + bb;
    mod[(l * 3 + 2) * 6 * DM + n] = a2 + bb;
}

__device__ __forceinline__ void f_wconv(const float* __restrict__ W, int N, bf16_t* Wt, int rowmap, int kt, int nt, float* lds) {
    const int TID = ltid();
    float (*T)[65] = (float (*)[65])lds;
    const int tid = TID;
    __syncthreads();
#pragma unroll
    for (int i = 0; i < 16; ++i) {
        int k = (tid >> 6) + 4 * i, n = tid & 63;
        int gn = nt * 64 + n;
        T[k][n] = gn < N ? W[(size_t)(kt * 64 + k) * N + gn] : 0.f;
    }
    __syncthreads();
#pragma unroll
    for (int i = 0; i < 2; ++i) {
        int n = (tid >> 3) + 32 * i, kc = tid & 7;
        int gn = nt * 64 + n;
        int drow = rowmap == 0 ? gn : (32 * (gn >> 4) + (gn & 15) + (rowmap == 2 ? 16 : 0));
        u32x4 o;
        o[0] = pk2bf(T[kc * 8 + 0][n], T[kc * 8 + 1][n]); o[1] = pk2bf(T[kc * 8 + 2][n], T[kc * 8 + 3][n]);
        o[2] = pk2bf(T[kc * 8 + 4][n], T[kc * 8 + 5][n]); o[3] = pk2bf(T[kc * 8 + 6][n], T[kc * 8 + 7][n]);
        *(u32x4*)(Wt + (size_t)drow * DM + kt * 64 + kc * 8) = o;
    }
}

__device__ __forceinline__ void f_normmod(float* ctxs, float* out, const float* __restrict__ g, const float* __restrict__ modl, int sh_off, int sc_off, bf16_t* h, int vb) {
    const int TID = ltid();
    int r = vb * 4 + (TID >> 6), lane = TID & 63;
    const float* x = xrow_ptr(ctxs, out, r);
    const float* m = modl + modrow(r) * 6 * DM;
    f32x4 v[4]; float ss = 0.f;
#pragma unroll
    for (int j = 0; j < 4; ++j) { v[j] = *(const f32x4*)(x + 4 * lane + 256 * j); ss += v[j][0] * v[j][0] + v[j][1] * v[j][1] + v[j][2] * v[j][2] + v[j][3] * v[j][3]; }
    ss = wave_sum(ss);
    float rstd = rsqrtf(ss * (1.f / DM) + 1e-6f);
#pragma unroll
    for (int j = 0; j < 4; ++j) {
        int c0 = 4 * lane + 256 * j;
        f32x4 gg = *(const f32x4*)(g + c0), sc = *(const f32x4*)(m + sc_off + c0), sh = *(const f32x4*)(m + sh_off + c0);
        f32x4 o4 = v[j] * rstd * gg * (1.f + sc) + sh;
        u32x2 o; o[0] = pk2bf(o4[0], o4[1]); o[1] = pk2bf(o4[2], o4[3]);
        *(u32x2*)(h + (size_t)r * DM + c0) = o;
    }
}

template <class AP, class BP, class Epi>
__device__ __forceinline__ void gemm128(const AP& aptr, const BP& bptr, int K, const Epi& epi, char* lds) {
    const int TID = ltid();
    const int tid = TID, lane = tid & 63, wid = tid >> 6, wr = wid >> 1, wc = wid & 1, fr = lane & 15, fq = lane >> 4;
    const bf16_t* ag[4]; const bf16_t* bg[4]; int lo[4];
#pragma unroll
    for (int i = 0; i < 4; ++i) {
        int row = (tid >> 3) + 32 * i, ch = tid & 7;
        ag[i] = aptr(row) + ch * 8; bg[i] = bptr(row) + ch * 8;
        lo[i] = row * 128 + ((ch ^ ((row >> 1) & 7)) << 4);
    }
    f32x4 acc[4][4];
#pragma unroll
    for (int m = 0; m < 4; ++m)
#pragma unroll
        for (int n = 0; n < 4; ++n) acc[m][n] = (f32x4){0.f, 0.f, 0.f, 0.f};
    u32x4 ra[4], rb[4];
#pragma unroll
    for (int i = 0; i < 4; ++i) { ra[i] = *(const u32x4*)(ag[i]); rb[i] = *(const u32x4*)(bg[i]); }
    __syncthreads();
#pragma unroll
    for (int i = 0; i < 4; ++i) { *(u32x4*)(lds + lo[i]) = ra[i]; *(u32x4*)(lds + 16384 + lo[i]) = rb[i]; }
    __syncthreads();
    const int nk = K / 64;
    const int swz = fr >> 1;
    for (int kt = 0; kt < nk; ++kt) {
        const int buf = kt & 1;
        if (kt + 1 < nk) {
#pragma unroll
            for (int i = 0; i < 4; ++i) { ra[i] = *(const u32x4*)(ag[i] + (kt + 1) * 64); rb[i] = *(const u32x4*)(bg[i] + (kt + 1) * 64); }
        }
        const char* la = lds + buf * 32768; const char* lb = la + 16384;
#pragma unroll
        for (int ks = 0; ks < 2; ++ks) {
            bf16x8 af[4], bfr[4];
            const int coff = ((ks * 4 + fq) ^ swz) << 4;
#pragma unroll
            for (int m = 0; m < 4; ++m) af[m] = *(const bf16x8*)(la + (wr * 64 + m * 16 + fr) * 128 + coff);
#pragma unroll
            for (int n = 0; n < 4; ++n) bfr[n] = *(const bf16x8*)(lb + (wc * 64 + n * 16 + fr) * 128 + coff);
#pragma unroll
            for (int m = 0; m < 4; ++m)
#pragma unroll
                for (int n = 0; n < 4; ++n) acc[m][n] = __builtin_amdgcn_mfma_f32_16x16x32_bf16(bfr[n], af[m], acc[m][n], 0, 0, 0);
        }
        if (kt + 1 < nk) {
            char* wa = lds + (buf ^ 1) * 32768;
#pragma unroll
            for (int i = 0; i < 4; ++i) { *(u32x4*)(wa + lo[i]) = ra[i]; *(u32x4*)(wa + 16384 + lo[i]) = rb[i]; }
        }
        __syncthreads();
    }
    epi(acc, wr, wc, fr, fq);
}

struct RowDense { const bf16_t* base; size_t ld; __device__ __forceinline__ const bf16_t* operator()(int row) const { return base + (size_t)row * ld; } };
struct RowGather { const bf16_t* base; const int* idx; int maxrow; __device__ __forceinline__ const bf16_t* operator()(int row) const { int r = row < maxrow ? row : maxrow - 1; return base + (size_t)idx[r] * DM; } };

struct EpiInProj {
    bf16_t* P; bf16_t* VT; const float2* tab; int m0, n0;
    __device__ __forceinline__ void operator()(f32x4 (&acc)[4][4], int wr, int wc, int fr, int fq) const {
        const bool rope = n0 < 1024;
        const bool isv = n0 >= OV && n0 < OGQKV;
#pragma unroll
        for (int m = 0; m < 4; ++m) {
            const int r = m0 + wr * 64 + m * 16 + fr;
            const int b = r / SS, s = r % SS;
            if (rope && s >= CL) {
                const int t = s - CL;
#pragma unroll
                for (int ax = 0; ax < 2; ++ax) {
                    const int pos = ax == 0 ? (t >> 6) : (t & 63);
#pragma unroll
                    for (int j = 0; j < 4; ++j) {
                        const float2 cs = tab[pos * 16 + 4 * fq + j];
                        const float x1 = acc[m][2 * ax][j], x2 = acc[m][2 * ax + 1][j];
                        acc[m][2 * ax][j] = x1 * cs.x - x2 * cs.y;
                        acc[m][2 * ax + 1][j] = x2 * cs.x + x1 * cs.y;
                    }
                }
            }
            if (isv) {
                const int u = s & 15;
                const int ps = (s & ~15) | (((u >> 2) & 1) << 3) | ((u >> 3) << 2) | (u & 3);
#pragma unroll
                for (int n = 0; n < 4; ++n)
#pragma unroll
                    for (int j = 0; j < 4; ++j) {
                        const int c = n0 - OV + wc * 64 + n * 16 + 4 * fq + j;
                        VT[((size_t)(b * 4 + (c >> 7)) * 128 + (c & 127)) * SS + ps] = f2bf(acc[m][n][j]);
                    }
            } else {
#pragma unroll
                for (int n = 0; n < 4; ++n) {
                    u32x2 o; o[0] = pk2bf(acc[m][n][0], acc[m][n][1]); o[1] = pk2bf(acc[m][n][2], acc[m][n][3]);
                    *(u32x2*)(P + (size_t)r * DINP + n0 + wc * 64 + n * 16 + 4 * fq) = o;
                }
            }
        }
    }
};
struct EpiF32 {
    float* C; int ldc; int m0, n0;
    __device__ __forceinline__ void operator()(f32x4 (&acc)[4][4], int wr, int wc, int fr, int fq) const {
#pragma unroll
        for (int m = 0; m < 4; ++m)
#pragma unroll
            for (int n = 0; n < 4; ++n) *(f32x4*)(C + (size_t)(m0 + wr * 64 + m * 16 + fr) * ldc + n0 + wc * 64 + n * 16 + 4 * fq) = acc[m][n];
    }
};
struct EpiMoE1 {
    bf16_t* hid; int m0, n0, cap;
    __device__ __forceinline__ void operator()(f32x4 (&acc)[4][4], int wr, int wc, int fr, int fq) const {
#pragma unroll
        for (int m = 0; m < 4; ++m) {
            const int r = m0 + wr * 64 + m * 16 + fr;
            if (r >= cap) continue;
#pragma unroll
            for (int q = 0; q < 2; ++q) {
                float v[4];
#pragma unroll
                for (int j = 0; j < 4; ++j) v[j] = siluf(acc[m][2 * q][j]) * acc[m][2 * q + 1][j];
                u32x2 o; o[0] = pk2bf(v[0], v[1]); o[1] = pk2bf(v[2], v[3]);
                *(u32x2*)(hid + (size_t)r * DM + (n0 >> 1) + wc * 32 + q * 16 + 4 * fq) = o;
            }
        }
    }
};
struct EpiMoE2 {
    bf16_t* ye; const float* aff; const int* sel; int e, m0, n0, cap;
    __device__ __forceinline__ void operator()(f32x4 (&acc)[4][4], int wr, int wc, int fr, int fq) const {
#pragma unroll
        for (int m = 0; m < 4; ++m) {
            const int r = m0 + wr * 64 + m * 16 + fr;
            if (r >= cap) continue;
            const float sc = aff[(size_t)sel[r] * NE + e];
#pragma unroll
            for (int n = 0; n < 4; ++n) {
                u32x2 o; o[0] = pk2bf(acc[m][n][0] * sc, acc[m][n][1] * sc); o[1] = pk2bf(acc[m][n][2] * sc, acc[m][n][3] * sc);
                *(u32x2*)(ye + (size_t)r * DM + n0 + wc * 64 + n * 16 + 4 * fq) = o;
            }
        }
    }
};

__device__ __forceinline__ void f_attn(const bf16_t* __restrict__ P, const bf16_t* __restrict__ VT, const float* __restrict__ da_lambda, const float* __restrict__ da_norm,
                                       float lam_init, bf16_t* cat, int bh, int qb, char* lds) {
    const int TID = ltid();
    const int lane = TID & 63, wid = TID >> 6, ql = lane & 31, hi = lane >> 5;
    const int map = wid >> 1, qsub = wid & 1;
    const int b = bh >> 2, h = bh & 3;
    const int row0 = b * SS + qb * 64;
    const int ntiles = (qb < 4 ? CL : SS) / 64;
    const float C = 0.125f * 1.4426950408889634f;
    float* wsf = (float*)(lds + 65536) + wid * 64;
    const bf16_t* kg[4]; const bf16_t* vg[4]; int klo[4], vlo[4];
#pragma unroll
    for (int i = 0; i < 4; ++i) {
        const int ch = TID & 7;
        const int krow = (TID >> 3) + 32 * (i & 1), km = i >> 1;
        kg[i] = P + (size_t)(b * SS + krow) * DINP + OKK + h * 128 + km * 64 + ch * 8;
        klo[i] = km * 8192 + krow * 128 + ((ch ^ ((krow >> 1) & 7)) << 4);
        const int vrow = (TID >> 3) + 32 * i;
        vg[i] = VT + (size_t)(bh * 128 + vrow) * SS + ch * 8;
        vlo[i] = 16384 + vrow * 128 + ((ch ^ ((vrow >> 1) & 7)) << 4);
    }
    bf16x8 qf[4];
    {
        const bf16_t* qp = P + (size_t)(row0 + qsub * 32 + ql) * DINP + OQ + h * 128 + map * 64 + 8 * hi;
#pragma unroll
        for (int d0 = 0; d0 < 4; ++d0) qf[d0] = *(const bf16x8*)(qp + 16 * d0);
    }
    f32x16 O[4];
#pragma unroll
    for (int cb = 0; cb < 4; ++cb)
#pragma unroll
        for (int r = 0; r < 16; ++r) O[cb][r] = 0.f;
    float mrun = -1e30f, lrun = 0.f;
    u32x4 rk[4], rv[4];
#pragma unroll
    for (int i = 0; i < 4; ++i) { rk[i] = *(const u32x4*)(kg[i]); rv[i] = *(const u32x4*)(vg[i]); }
    __syncthreads();
#pragma unroll
    for (int i = 0; i < 4; ++i) { *(u32x4*)(lds + klo[i]) = rk[i]; *(u32x4*)(lds + vlo[i]) = rv[i]; }
    __syncthreads();
    const int swz = (ql >> 1) & 7;
    for (int t = 0; t < ntiles; ++t) {
        const int buf = t & 1;
        if (t + 1 < ntiles) {
#pragma unroll
            for (int i = 0; i < 4; ++i) { rk[i] = *(const u32x4*)(kg[i] + (size_t)(t + 1) * 64 * DINP); rv[i] = *(const u32x4*)(vg[i] + (t + 1) * 64); }
        }
        const char* kb = lds + buf * 32768 + map * 8192;
        const char* vb = lds + buf * 32768 + 16384;
        f32x16 p0, p1;
#pragma unroll
        for (int r = 0; r < 16; ++r) { p0[r] = 0.f; p1[r] = 0.f; }
#pragma unroll
        for (int d0 = 0; d0 < 4; ++d0) {
            const int co = ((2 * d0 + hi) ^ swz) << 4;
            const bf16x8 k0f = *(const bf16x8*)(kb + ql * 128 + co);
            const bf16x8 k1f = *(const bf16x8*)(kb + (32 + ql) * 128 + co);
            p0 = MFMA32(k0f, qf[d0], p0);
            p1 = MFMA32(k1f, qf[d0], p1);
        }
        float tm = fmaxf(p0[0], p1[0]);
#pragma unroll
        for (int r = 1; r < 16; ++r) tm = fmaxf(tm, fmaxf(p0[r], p1[r]));
        tm = fmaxf(tm, __shfl_xor(tm, 32));
        const float mnew = fmaxf(mrun, tm);
        if (__any(mnew > mrun)) {
            const float alpha = __builtin_amdgcn_exp2f((mrun - mnew) * C);
            lrun *= alpha; mrun = mnew;
            if (hi == 0) wsf[ql] = alpha;
            __builtin_amdgcn_s_waitcnt(0xc07f);
#pragma unroll
            for (int r = 0; r < 16; ++r) {
                const float f = wsf[crow(r, hi)];
#pragma unroll
                for (int cb = 0; cb < 4; ++cb) O[cb][r] *= f;
            }
        }
        const float mc = mrun * C;
        float ls = 0.f;
#pragma unroll
        for (int r = 0; r < 16; ++r) {
            p0[r] = __builtin_amdgcn_exp2f(fmaf(p0[r], C, -mc)); p1[r] = __builtin_amdgcn_exp2f(fmaf(p1[r], C, -mc));
            ls += p0[r] + p1[r];
        }
        lrun += ls;
        bf16x8 pf[4];
#pragma unroll
        for (int s = 0; s < 4; ++s) {
            u32x4 w;
#pragma unroll
            for (int j = 0; j < 4; ++j) w[j] = (s < 2) ? pk2bf(p0[8 * (s & 1) + 2 * j], p0[8 * (s & 1) + 2 * j + 1]) : pk2bf(p1[8 * (s & 1) + 2 * j], p1[8 * (s & 1) + 2 * j + 1]);
            pf[s] = __builtin_bit_cast(bf16x8, w);
        }
#pragma unroll
        for (int cb = 0; cb < 4; ++cb)
#pragma unroll
            for (int s = 0; s < 4; ++s) {
                const bf16x8 vf = *(const bf16x8*)(vb + (cb * 32 + ql) * 128 + (((2 * s + hi) ^ swz) << 4));
                O[cb] = MFMA32(pf[s], vf, O[cb]);
            }
        if (t + 1 < ntiles) {
            char* wb = lds + (buf ^ 1) * 32768;
#pragma unroll
            for (int i = 0; i < 4; ++i) { *(u32x4*)(wb + klo[i]) = rk[i]; *(u32x4*)(wb + vlo[i]) = rv[i]; }
        }
        __syncthreads();
    }
    lrun += __shfl_xor(lrun, 32);
    if (hi == 0) wsf[ql] = 1.f / lrun;
    __builtin_amdgcn_s_waitcnt(0xc07f);
    float* ost = (float*)lds + wid * 4096;
#pragma unroll
    for (int r = 0; r < 16; ++r) {
        const int q = crow(r, hi);
        const float f = wsf[q];
#pragma unroll
        for (int cb = 0; cb < 4; ++cb) ost[q * 128 + cb * 32 + ql] = O[cb][r] * f;
    }
    __syncthreads();
    float s01 = 0.f, s23 = 0.f;
    for (int d = 0; d < 64; ++d) { s01 += da_lambda[d] * da_lambda[64 + d]; s23 += da_lambda[128 + d] * da_lambda[192 + d]; }
    const float lam = expf(s01) - expf(s23) + lam_init;
    const float g0 = da_norm[lane] * (1.f - lam_init), g1 = da_norm[lane + 64] * (1.f - lam_init);
    for (int qq = 0; qq < 16; ++qq) {
        const int q = wid * 16 + qq, qs = q >> 5, qlq = q & 31;
        const float* o0 = (const float*)lds + qs * 4096 + qlq * 128;
        const float* o1 = (const float*)lds + (2 + qs) * 4096 + qlq * 128;
        const float v0 = o0[lane] - lam * o1[lane], v1 = o0[lane + 64] - lam * o1[lane + 64];
        const float ssq = wave_sum(v0 * v0 + v1 * v1);
        const float rstd = rsqrtf(ssq * (1.f / 128.f) + 1e-6f);
        bf16_t* dst = cat + (size_t)(row0 + q) * DM + h * 128;
        dst[lane] = f2bf(v0 * rstd * g0); dst[lane + 64] = f2bf(v1 * rstd * g1);
    }
}

__device__ __forceinline__ void f_gdn_prep(const bf16_t* __restrict__ p, const float* __restrict__ conv_w, const float* __restrict__ a_log,
                                                  const float* __restrict__ dt_bias, bf16_t* gq, bf16_t* gk, bf16_t* gv, float* gab, int vb) {
    const int TID = ltid();
    const int r = vb, c = TID;
    const int b = r / SS, s = r % SS;
    int seg_lo = s < CL ? 0 : CL, seg_hi = s < CL ? CL : SS;
    float val[3];
#pragma unroll
    for (int j3 = 0; j3 < 3; ++j3) {
        int ch = j3 * 256 + c;
        float acc = 0.f;
#pragma unroll
        for (int j = 0; j < 5; ++j) {
            int s2 = s + j - 2;
            if (s2 >= seg_lo && s2 < seg_hi) acc += bf2f(p[(size_t)(b * SS + s2) * DINP + OGQKV + ch]) * conv_w[j * 768 + ch];
        }
        val[j3] = siluf(acc);
    }
    float sq = wave_sum(val[0] * val[0]);
    float sk = wave_sum(val[1] * val[1]);
    gq[(size_t)r * 256 + c] = f2bf(val[0] * rsqrtf(sq + 1e-12f) * 0.125f);
    gk[(size_t)r * 256 + c] = f2bf(val[1] * rsqrtf(sk + 1e-12f));
    gv[(size_t)r * 256 + c] = f2bf(val[2]);
    if (c < 8) {
        float a = bf2f(p[(size_t)r * DINP + OGA + c]);
        float xx = a + dt_bias[c];
        float sp = xx > 20.f ? xx : log1pf(expf(xx));
        float gg = -expf(a_log[c]) * sp;
        gab[(size_t)r * 16 + c] = gg;
    } else if (c < 16) {
        float bb = bf2f(p[(size_t)r * DINP + OGB + (c - 8)]);
        gab[(size_t)r * 16 + c] = sigmf(bb);
    }
}

__device__ __forceinline__ void f_rwkv_prep(const bf16_t* __restrict__ p, const float* __restrict__ w0, const float* __restrict__ w_up,
                                                   const float* __restrict__ a0, const float* __restrict__ a_up, const float* __restrict__ k_k,
                                                   const float* __restrict__ k_a, bf16_t* kk_o, float* w_o, bf16_t* kka_o, bf16_t* kd_o, int vb, float* lds) {
    const int TID = ltid();
    float* xw = lds; float* xa = lds + 32;
    __syncthreads();
    const int r = vb, c = TID;
    const bf16_t* pr = p + (size_t)r * DINP;
    if (c < 32) xw[c] = tanhf(bf2f(pr[OXW + c]));
    else if (c < 64) xa[c - 32] = bf2f(pr[OXA + (c - 32)]);
    __syncthreads();
    float k = bf2f(pr[ORKV + 256 + c]);
    float kq = k * k_k[c];
    float ss = wave_sum(kq * kq);
    float kk = kq * rsqrtf(ss + 1e-12f);
    kk_o[(size_t)r * 256 + c] = f2bf(kk);
#pragma unroll
    for (int d = 0; d < 2; ++d) {
        float aw = w0[d * 256 + c], aa = a0[d * 256 + c];
        for (int j = 0; j < 32; ++j) { aw += xw[j] * w_up[(d * 32 + j) * 256 + c]; aa += xa[j] * a_up[(d * 32 + j) * 256 + c]; }
        float logw = -0.6065306597126334f * sigmf(aw);
        float ad = sigmf(aa);
        w_o[(size_t)r * 512 + d * 256 + c] = logw;
        kka_o[(size_t)r * 512 + d * 256 + c] = f2bf(kk * ad);
        kd_o[(size_t)r * 512 + d * 256 + c] = f2bf(k * (1.f + (ad - 1.f) * k_a[c]));
    }
}

#define MFMA16(a, b, c) __builtin_amdgcn_mfma_f32_16x16x32_bf16((a), (b), (c), 0, 0, 0)
__device__ __forceinline__ int scan_row(int b, int dir, int p) {
    const int s = dir == 0 ? p : (p < CL ? (CL - 1 - p) : (CL + (TL - 1 - (p - CL))));
    return b * SS + s;
}
__device__ __forceinline__ void mm64(const char* A, const char* Bt, f32x4 (&acc)[4], int w, int fr, int fq) {
#pragma unroll
    for (int ks = 0; ks < 2; ++ks) {
        const int co = ((ks * 4 + fq) ^ (fr >> 1)) << 4;
        const bf16x8 af = *(const bf16x8*)(A + (16 * w + fr) * 128 + co);
#pragma unroll
        for (int n = 0; n < 4; ++n) { const bf16x8 bfr = *(const bf16x8*)(Bt + (16 * n + fr) * 128 + co); acc[n] = MFMA16(bfr, af, acc[n]); }
    }
}
__device__ __forceinline__ void zero4(f32x4 (&acc)[4]) {
#pragma unroll
    for (int n = 0; n < 4; ++n) acc[n] = (f32x4){0.f, 0.f, 0.f, 0.f};
}
__device__ __forceinline__ void tile_row_write(char* T, int c, const float (&x)[64]) {
#pragma unroll
    for (int ch = 0; ch < 8; ++ch) {
        u32x4 o; o[0] = pk2bf(x[8 * ch], x[8 * ch + 1]); o[1] = pk2bf(x[8 * ch + 2], x[8 * ch + 3]); o[2] = pk2bf(x[8 * ch + 4], x[8 * ch + 5]); o[3] = pk2bf(x[8 * ch + 6], x[8 * ch + 7]);
        *(u32x4*)(T + c * 128 + ((ch ^ ((c >> 1) & 7)) << 4)) = o;
    }
}
__device__ __forceinline__ void tri_solve(const float* Am, float (&x)[64]) {
#pragma unroll
    for (int i = 1; i < 64; ++i) {
        float acc = x[i];
#pragma unroll
        for (int j = 0; j < i; ++j) acc -= Am[i * 64 + j] * x[j];
        x[i] = acc;
    }
}
__device__ __forceinline__ void store_perm(bf16_t* dst, const f32x4 (&acc)[4], int w, int fr, int fq) {
#pragma unroll
    for (int n = 0; n < 4; ++n) {
        u32x2 o; o[0] = pk2bf(acc[n][0], acc[n][1]); o[1] = pk2bf(acc[n][2], acc[n][3]);
        *(u32x2*)(dst + (16 * w + fr) * 64 + 32 * (n >> 1) + 8 * fq + 4 * (n & 1)) = o;
    }
}
__device__ __forceinline__ void store_acc(bf16_t* dst, const f32x4 (&acc)[4], int w, int fr, int fq) {
#pragma unroll
    for (int n = 0; n < 4; ++n)
#pragma unroll
        for (int jj = 0; jj < 4; ++jj) dst[((n * 4 + w) * 64 + (4 * fq + jj) + 16 * (fr >> 2)) * 4 + (fr & 3)] = f2bf(acc[n][jj]);
}

#define TILE(k) (lds + (k) * 8192)
#define SCAL ((float*)(lds + 73728))
__device__ __forceinline__ float tile_get(const char* T, int i, int c3, int clow) { return bf2f(*(const bf16_t*)(T + i * 128 + (((c3 ^ ((i >> 1) & 7)) << 4) | clow))); }
__device__ __forceinline__ void tile_put(char* T, int i, int c3, int clow, float v) { *(bf16_t*)(T + i * 128 + (((c3 ^ ((i >> 1) & 7)) << 4) | clow)) = f2bf(v); }
__device__ __forceinline__ void stage_tile(char* T, const bf16_t* base, size_t ld, int b, int dir, int p0, int TID) {
#pragma unroll
    for (int k = 0; k < 2; ++k) {
        const int id = TID + 256 * k, row = id >> 3, chn = id & 7;
        const size_t r = scan_row(b, dir, p0 + row);
        *(u32x4*)(T + row * 128 + ((chn ^ ((row >> 1) & 7)) << 4)) = *(const u32x4*)(base + r * ld + chn * 8);
    }
}
__device__ __forceinline__ f32x4 tile_get4(const char* T, int i, int j0) {
    const u32x2 rv = *(const u32x2*)(T + i * 128 + (((j0 >> 3) ^ ((i >> 1) & 7)) << 4) + (j0 & 7) * 2);
    return (f32x4){bf2f((bf16_t)(rv[0] & 0xffffu)), bf2f((bf16_t)(rv[0] >> 16)), bf2f((bf16_t)(rv[1] & 0xffffu)), bf2f((bf16_t)(rv[1] >> 16))};
}
__device__ __forceinline__ void tile_put4(char* T, int i, int j0, float v0, float v1, float v2, float v3) {
    u32x2 o; o[0] = pk2bf(v0, v1); o[1] = pk2bf(v2, v3);
    *(u32x2*)(T + i * 128 + (((j0 >> 3) ^ ((i >> 1) & 7)) << 4) + (j0 & 7) * 2) = o;
}

__device__ __forceinline__ void f_chunk_gdn(const bf16_t* __restrict__ gq, const bf16_t* __restrict__ gk, const bf16_t* __restrict__ gv, const float* __restrict__ gab,
                                            bf16_t* X, int chain, int n, char* lds) {
    const int TID = ltid();
    const int lane = TID & 63, w = TID >> 6, fr = lane & 15, fq = lane >> 4;
    const int dir = chain & 1, h = (chain >> 1) & 3, b = chain >> 3;
    float* gcs = SCAL; float* bts = SCAL + 64;
    float* Am = (float*)TILE(7);
    __syncthreads();
    if (TID < 64) {
        const int r = scan_row(b, dir, n * 64 + TID);
        float g = gab[(size_t)r * 16 + dir * 4 + h];
#pragma unroll
        for (int o = 1; o < 64; o <<= 1) { const float t = __shfl_up(g, o); if (lane >= o) g += t; }
        gcs[TID] = g; bts[TID] = gab[(size_t)r * 16 + 8 + dir * 4 + h];
    }
    stage_tile(TILE(0), gq + h * 64, 256, b, dir, n * 64, TID);
    stage_tile(TILE(1), gk + h * 64, 256, b, dir, n * 64, TID);
    stage_tile(TILE(3), gv + h * 64, 256, b, dir, n * 64, TID);
    __syncthreads();
    {
        const int i = 16 * w + fr; const float gi = gcs[i], bi = bts[i];
        f32x4 acc[4]; zero4(acc); mm64(TILE(1), TILE(1), acc, w, fr, fq);
#pragma unroll
        for (int nn = 0; nn < 4; ++nn)
#pragma unroll
            for (int jj = 0; jj < 4; ++jj) { const int j = 16 * nn + 4 * fq + jj; Am[i * 64 + j] = j < i ? bi * acc[nn][jj] * __expf(gi - gcs[j]) : 0.f; }
        zero4(acc); mm64(TILE(0), TILE(1), acc, w, fr, fq);
#pragma unroll
        for (int nn = 0; nn < 4; ++nn) {
            float v[4];
#pragma unroll
            for (int jj = 0; jj < 4; ++jj) { const int j = 16 * nn + 4 * fq + jj; v[jj] = j <= i ? acc[nn][jj] * __expf(gi - gcs[j]) : 0.f; }
            tile_put4(TILE(2), i, 16 * nn + 4 * fq, v[0], v[1], v[2], v[3]);
        }
    }
    __syncthreads();
    if (TID < 192) {
        const int c = lane, c3 = c >> 3, clow = (c & 7) << 1;
        float x[64];
        if (w == 0) {
#pragma unroll
            for (int i = 0; i < 64; ++i) x[i] = tile_get(TILE(3), i, c3, clow) * bts[i];
            tri_solve(Am, x); tile_row_write(TILE(4), c, x);
        } else if (w == 1) {
#pragma unroll
            for (int i = 0; i < 64; ++i) x[i] = tile_get(TILE(1), i, c3, clow) * bts[i] * __expf(gcs[i]);
            tri_solve(Am, x); tile_row_write(TILE(5), c, x);
        } else {
            const float g63 = gcs[63];
#pragma unroll
            for (int i = 0; i < 64; ++i) x[i] = tile_get(TILE(1), i, c3, clow) * __expf(g63 - gcs[i]);
            tile_row_write(TILE(6), c, x);
        }
    }
    __syncthreads();
    {
        bf16_t* Xi = X + ((size_t)(chain * 132 + n)) * 16384;
        const int i = 16 * w + fr;
        f32x4 acc[4];
        zero4(acc); mm64(TILE(2), TILE(4), acc, w, fr, fq); store_acc(Xi + 8192, acc, w, fr, fq);
        zero4(acc); mm64(TILE(2), TILE(5), acc, w, fr, fq);
        {
            const float eg = __expf(gcs[i]);
#pragma unroll
            for (int nn = 0; nn < 4; ++nn) { const f32x4 qv = tile_get4(TILE(0), i, 16 * nn + 4 * fq); acc[nn] = qv * eg - acc[nn]; }
            store_perm(Xi + 4096, acc, w, fr, fq);
        }
        zero4(acc); mm64(TILE(6), TILE(5), acc, w, fr, fq);
        {
            const float gt = __expf(gcs[63]);
#pragma unroll
            for (int nn = 0; nn < 4; ++nn)
#pragma unroll
                for (int jj = 0; jj < 4; ++jj) acc[nn][jj] = ((16 * nn + 4 * fq + jj) == i ? gt : 0.f) - acc[nn][jj];
            store_perm(Xi, acc, w, fr, fq);
        }
        zero4(acc); mm64(TILE(6), TILE(4), acc, w, fr, fq); store_acc(Xi + 12288, acc, w, fr, fq);
    }
}

__device__ __forceinline__ void f_chunk_rwkv(const bf16_t* __restrict__ P, const bf16_t* __restrict__ kk_i, const float* __restrict__ lw_i, const bf16_t* __restrict__ kka_i,
                                             const bf16_t* __restrict__ kd_i, bf16_t* X, int chain, int n, char* lds) {
    const int TID = ltid();
    const int lane = TID & 63, w = TID >> 6, fr = lane & 15, fq = lane >> 4;
    const int dir = chain & 1, h = (chain >> 1) & 3, b = chain >> 3;
    const int c3 = lane >> 3, clow = (lane & 7) << 1;
    float* wc = SCAL;
    float* Am = (float*)TILE(7);
    __syncthreads();
    stage_tile(TILE(0), kk_i + h * 64, 256, b, dir, n * 64, TID);
    stage_tile(TILE(1), kka_i + dir * 256 + h * 64, 512, b, dir, n * 64, TID);
    stage_tile(TILE(2), kd_i + dir * 256 + h * 64, 512, b, dir, n * 64, TID);
    stage_tile(TILE(3), P + ORKV + h * 64, DINP, b, dir, n * 64, TID);
    stage_tile(TILE(4), P + ORKV + 512 + h * 64, DINP, b, dir, n * 64, TID);
#pragma unroll
    for (int k = 0; k < 4; ++k) {
        const int id = TID + 256 * k, row = id >> 4, chn = id & 15;
        const size_t r = scan_row(b, dir, n * 64 + row);
        *(f32x4*)(Am + row * 64 + chn * 4) = *(const f32x4*)(lw_i + r * 512 + dir * 256 + h * 64 + chn * 4);
    }
    __syncthreads();
    {
        float lc = 0.f;
        char* T = TILE(w);
#pragma unroll
        for (int i = 0; i < 64; ++i) {
            const float lprev = lc; lc += Am[i * 64 + lane];
            const float e = w == 0 ? lprev : (w == 3 ? lc : -lc);
            tile_put(T, i, c3, clow, tile_get(T, i, c3, clow) * __expf(e));
        }
        if (w == 0) wc[lane] = __expf(lc);
    }
    __syncthreads();
    if (w == 0) {
        float x[64];
#pragma unroll
        for (int i = 0; i < 64; ++i) x[i] = tile_get(TILE(4), i, c3, clow);
        tile_row_write(TILE(5), lane, x);
    }
    {
        const int i = 16 * w + fr;
        f32x4 acc[4];
        zero4(acc); mm64(TILE(0), TILE(1), acc, w, fr, fq);
#pragma unroll
        for (int nn = 0; nn < 4; ++nn)
#pragma unroll
            for (int jj = 0; jj < 4; ++jj) { const int j = 16 * nn + 4 * fq + jj; Am[i * 64 + j] = j < i ? acc[nn][jj] : 0.f; }
        zero4(acc); mm64(TILE(0), TILE(2), acc, w, fr, fq);
#pragma unroll
        for (int nn = 0; nn < 4; ++nn) {
            float v[4];
#pragma unroll
            for (int jj = 0; jj < 4; ++jj) { const int j = 16 * nn + 4 * fq + jj; v[jj] = j < i ? acc[nn][jj] : 0.f; }
            tile_put4(TILE(6), i, 16 * nn + 4 * fq, v[0], v[1], v[2], v[3]);
        }
    }
    __syncthreads();
    {
        const int i = 16 * w + fr;
        f32x4 acc[4]; zero4(acc); mm64(TILE(6), TILE(5), acc, w, fr, fq);
#pragma unroll
        for (int nn = 0; nn < 4; ++nn)
#pragma unroll
            for (int jj = 0; jj < 4; ++jj) { const int c = 16 * nn + 4 * fq + jj; *(bf16_t*)(TILE(4) + c * 128 + ((((i >> 3) ^ ((c >> 1) & 7)) << 4) | ((i & 7) << 1))) = f2bf(acc[nn][jj]); }
    }
    __syncthreads();
    if (w < 2) {
        float x[64];
        if (w == 0) {
#pragma unroll
            for (int ch = 0; ch < 8; ++ch) {
                const bf16x8 v = *(const bf16x8*)(TILE(4) + lane * 128 + ((ch ^ ((lane >> 1) & 7)) << 4));
#pragma unroll
                for (int e = 0; e < 8; ++e) x[8 * ch + e] = -bf2f((bf16_t)v[e]);
            }
        } else {
#pragma unroll
            for (int i = 0; i < 64; ++i) x[i] = tile_get(TILE(0), i, c3, clow);
        }
        tri_solve(Am, x);
        tile_row_write(w == 0 ? TILE(6) : TILE(0), lane, x);
    }
    __syncthreads();
    {
        const int i = 16 * w + fr;
#pragma unroll
        for (int q = 0; q < 2; ++q) {
            f32x4 acc[4]; zero4(acc); mm64(TILE(3), TILE(1 + q), acc, w, fr, fq);
#pragma unroll
            for (int nn = 0; nn < 4; ++nn) {
                float v[4];
#pragma unroll
                for (int jj = 0; jj < 4; ++jj) { const int j = 16 * nn + 4 * fq + jj; v[jj] = j <= i ? acc[nn][jj] : 0.f; }
                tile_put4(TILE(7 + q), i, 16 * nn + 4 * fq, v[0], v[1], v[2], v[3]);
            }
        }
    }
    if (w == 0) {
        float x[64]; const float wd = wc[lane];
#pragma unroll
        for (int i = 0; i < 64; ++i) x[i] = tile_get(TILE(1), i, c3, clow) * wd;
        tile_row_write(TILE(4), lane, x);
    }
    __syncthreads();
    bf16_t* Xi = X + ((size_t)((16 + chain) * 132 + n)) * 16384;
    f32x4 sa[4];
    {
        const int i = 16 * w + fr;
        f32x4 acc[4];
        zero4(acc); mm64(TILE(7), TILE(6), acc, w, fr, fq); mm64(TILE(8), TILE(5), acc, w, fr, fq); store_acc(Xi + 8192, acc, w, fr, fq);
        zero4(acc); mm64(TILE(7), TILE(0), acc, w, fr, fq);
#pragma unroll
        for (int nn = 0; nn < 4; ++nn) { const f32x4 rv = tile_get4(TILE(3), i, 16 * nn + 4 * fq); acc[nn] = rv - acc[nn]; }
        store_perm(Xi + 4096, acc, w, fr, fq);
        zero4(acc); mm64(TILE(4), TILE(0), acc, w, fr, fq);
        {
            const float wd = wc[i];
#pragma unroll
            for (int nn = 0; nn < 4; ++nn)
#pragma unroll
                for (int jj = 0; jj < 4; ++jj) acc[nn][jj] = ((16 * nn + 4 * fq + jj) == i ? wd : 0.f) - acc[nn][jj];
            store_perm(Xi, acc, w, fr, fq);
        }
        zero4(sa); mm64(TILE(4), TILE(6), sa, w, fr, fq);
    }
    __syncthreads();
    if (w == 0) {
        float x[64]; const float wd = wc[lane];
#pragma unroll
        for (int i = 0; i < 64; ++i) x[i] = tile_get(TILE(2), i, c3, clow) * wd;
        tile_row_write(TILE(4), lane, x);
    }
    __syncthreads();
    mm64(TILE(4), TILE(5), sa, w, fr, fq); store_acc(Xi + 12288, sa, w, fr, fq);
}

__device__ __forceinline__ void f_scan2(const bf16_t* __restrict__ X, bf16_t* so, int mc  ) {
    const int TID = ltid();
    const int lane = TID & 63, slab = TID >> 6, c = lane & 15, q = lane >> 4;
    const int mixer = mc >> 4, chain = mc & 15, dir = chain & 1, h = (chain >> 1) & 3, b = chain >> 3;
    f32x4 S[4];
#pragma unroll
    for (int mb = 0; mb < 4; ++mb) S[mb] = (f32x4){0.f, 0.f, 0.f, 0.f};
#pragma unroll 1
    for (int n = 0; n < 132; ++n) {
        const bf16_t* Xi = X + ((size_t)(mc * 132 + n)) * 16384;
        bf16x8 bS[2];
#pragma unroll
        for (int s = 0; s < 2; ++s) {
            u32x4 o; o[0] = pk2bf(S[2 * s][0], S[2 * s][1]); o[1] = pk2bf(S[2 * s][2], S[2 * s][3]); o[2] = pk2bf(S[2 * s + 1][0], S[2 * s + 1][1]); o[3] = pk2bf(S[2 * s + 1][2], S[2 * s + 1][3]);
            bS[s] = __builtin_bit_cast(bf16x8, o);
        }
#pragma unroll
        for (int mb = 0; mb < 4; ++mb) {
            const u32x2 y0 = *(const u32x2*)(Xi + 8192 + ((slab * 4 + mb) * 64 + lane) * 4);
            f32x4 y = (f32x4){bf2f((bf16_t)(y0[0] & 0xffffu)), bf2f((bf16_t)(y0[0] >> 16)), bf2f((bf16_t)(y0[1] & 0xffffu)), bf2f((bf16_t)(y0[1] >> 16))};
            const u32x2 s0 = *(const u32x2*)(Xi + 12288 + ((slab * 4 + mb) * 64 + lane) * 4);
            f32x4 sn = (f32x4){bf2f((bf16_t)(s0[0] & 0xffffu)), bf2f((bf16_t)(s0[0] >> 16)), bf2f((bf16_t)(s0[1] & 0xffffu)), bf2f((bf16_t)(s0[1] >> 16))};
#pragma unroll
            for (int s = 0; s < 2; ++s) {
                const bf16x8 ar = *(const bf16x8*)(Xi + 4096 + (16 * mb + c) * 64 + 32 * s + 8 * q);
                const bf16x8 ag = *(const bf16x8*)(Xi + (16 * mb + c) * 64 + 32 * s + 8 * q);
                y = MFMA16(ar, bS[s], y);
                sn = MFMA16(ag, bS[s], sn);
            }
#pragma unroll
            for (int reg = 0; reg < 4; ++reg) {
                const int r = scan_row(b, dir, n * 64 + 16 * mb + 4 * q + reg);
                so[((size_t)dir * RR + r) * 512 + mixer * 256 + h * 64 + slab * 16 + c] = f2bf(y[reg]);
            }
            S[mb] = sn;
        }
    }
}

__device__ __forceinline__ void f_mix_out(const bf16_t* __restrict__ p, bf16_t* cat, const bf16_t* __restrict__ so, const float* __restrict__ gdn_norm,
                                                 const bf16_t* __restrict__ kd_i, const float* __restrict__ g_up, const float* __restrict__ r_k,
                                                 const float* __restrict__ gn_w, const float* __restrict__ gn_b, int vb, float* lds) {
    const int TID = ltid();
    float* xg = lds;
    __syncthreads();
    const int r = vb, c = TID;
    const bf16_t* pr = p + (size_t)r * DINP;
    if (c < 64) xg[c] = sigmf(bf2f(pr[OXG + c]));
    __syncthreads();
    float o = bf2f(so[(size_t)r * 512 + c]) + bf2f(so[((size_t)RR + r) * 512 + c]);
    float ss = wave_sum(o * o);
    float y = o * rsqrtf(ss * (1.f / 64.f) + 1e-6f) * gdn_norm[c & 63] * siluf(bf2f(pr[OGGATE + c]));
    float yv = bf2f(so[(size_t)r * 512 + 256 + c]) + bf2f(so[((size_t)RR + r) * 512 + 256 + c]);
    float mu = wave_sum(yv) * (1.f / 64.f);
    float dv = yv - mu;
    float var = wave_sum(dv * dv) * (1.f / 64.f);
    float yn = dv * rsqrtf(var + 64e-5f) * gn_w[c] + gn_b[c];
    float rr = bf2f(pr[ORKV + c]), vv = bf2f(pr[ORKV + 512 + c]);
    float kds = bf2f(kd_i[(size_t)r * 512 + c]) + bf2f(kd_i[(size_t)r * 512 + 256 + c]);
    float bs = wave_sum(rr * kds * r_k[c]);
    float g = 0.f;
    for (int j = 0; j < 64; ++j) g += xg[j] * g_up[j * 256 + c];
    float ro = (yn + bs * vv) * g;
    cat[(size_t)r * DM + 512 + c] = f2bf(y);
    cat[(size_t)r * DM + 768 + c] = f2bf(ro);
}

__device__ __forceinline__ void f_resid1(float* ctxs, float* out, const float* __restrict__ mix, const float* __restrict__ g_post, const float* __restrict__ g_pre2,
                         const float* __restrict__ modl, const float* __restrict__ router, bf16_t* h2, float* aff, int vb) {
    const int TID = ltid();
    int r = vb * 4 + (TID >> 6), lane = TID & 63;
    float* x = xrow_ptr(ctxs, out, r);
    const float* m = modl + modrow(r) * 6 * DM;
    float v[16], xv[16]; float ss = 0.f;
#pragma unroll
    for (int j = 0; j < 16; ++j) { v[j] = mix[(size_t)r * DM + lane + 64 * j]; ss += v[j] * v[j]; }
    ss = wave_sum(ss);
    float rstd = rsqrtf(ss * (1.f / DM) + 1e-6f);
    float s2 = 0.f;
#pragma unroll
    for (int j = 0; j < 16; ++j) { int cidx = lane + 64 * j; xv[j] = x[cidx] + m[2048 + cidx] * (v[j] * rstd * g_post[cidx]); x[cidx] = xv[j]; s2 += xv[j] * xv[j]; }
    s2 = wave_sum(s2);
    float rstd2 = rsqrtf(s2 * (1.f / DM) + 1e-6f);
    float lg[NE];
#pragma unroll
    for (int e = 0; e < NE; ++e) lg[e] = 0.f;
#pragma unroll
    for (int j = 0; j < 16; ++j) {
        int cidx = lane + 64 * j;
        float hv = xv[j] * rstd2 * g_pre2[cidx] * (1.f + m[4096 + cidx]) + m[3072 + cidx];
        h2[(size_t)r * DM + cidx] = f2bf(hv);
#pragma unroll
        for (int e = 0; e < NE; ++e) lg[e] += hv * router[cidx * NE + e];
    }
    float mxv = -1e30f;
#pragma unroll
    for (int e = 0; e < NE; ++e) { lg[e] = wave_sum(lg[e]); mxv = fmaxf(mxv, lg[e]); }
    float sum = 0.f;
#pragma unroll
    for (int e = 0; e < NE; ++e) { lg[e] = expf(lg[e] - mxv); sum += lg[e]; }
    if (lane < NE) {
        float val = 0.f;
#pragma unroll
        for (int e = 0; e < NE; ++e) if (e == lane) val = lg[e];
        aff[(size_t)r * NE + lane] = val / sum;
    }
}

__device__ __forceinline__ void f_topk(const float* __restrict__ aff, int* sel_lat, int* sel_ctx, int* slot, int vb, float* lds) {
    const int TID = ltid();
    unsigned* vals = (unsigned*)lds;
    unsigned* hist = (unsigned*)lds + 8192 + 256;
    unsigned* sc = hist + 256;
    unsigned* ctl = sc + 512;
    const int set = vb >> 5, b = (vb >> 4) & 1, e = vb & 15;
    const int n = set == 0 ? TL : CL, cap = set == 0 ? CAPL : CAPC;
    const int per = n >> 8;
    const int rbase = b * SS + (set == 0 ? CL : 0);
    __syncthreads();
    for (int t = TID; t < n; t += 256) vals[t + (t >> 5)] = __float_as_uint(aff[(size_t)(rbase + t) * NE + e]);
    if (TID == 0) { ctl[0] = 0u; ctl[1] = (unsigned)cap; }
    __syncthreads();
    for (int pass = 0; pass < 4; ++pass) {
        const int shift = 24 - 8 * pass;
        hist[TID] = 0u;
        __syncthreads();
        const unsigned prefix = ctl[0];
        const unsigned pmask = pass == 0 ? 0u : (0xffffffffu << (shift + 8));
        for (int j = 0; j < per; ++j) {
            const int t = TID * per + j;
            const unsigned v = vals[t + (t >> 5)];
            if ((v & pmask) == prefix) atomicAdd(&hist[(v >> shift) & 255u], 1u);
        }
        __syncthreads();
        if (TID == 0) {
            unsigned rem = ctl[1], d = 255u;
            for (;; --d) { const unsigned hc = hist[d]; if (hc >= rem || d == 0u) break; rem -= hc; }
            ctl[0] = prefix | (d << shift); ctl[1] = rem;
        }
        __syncthreads();
    }
    const unsigned thr = ctl[0], need_eq = ctl[1];
    unsigned cg = 0u, ce = 0u;
    for (int j = 0; j < per; ++j) { const int t = TID * per + j; const unsigned v = vals[t + (t >> 5)]; cg += v > thr ? 1u : 0u; ce += v == thr ? 1u : 0u; }
    sc[TID] = ce; __syncthreads();
    for (int o = 1; o < 256; o <<= 1) { const unsigned add = TID >= o ? sc[TID - o] : 0u; __syncthreads(); sc[TID] += add; __syncthreads(); }
    const unsigned eq_before = sc[TID] - ce;
    const unsigned eq_take = eq_before >= need_eq ? 0u : (need_eq - eq_before < ce ? need_eq - eq_before : ce);
    const unsigned csel = cg + eq_take;
    sc[256 + TID] = csel; __syncthreads();
    for (int o = 1; o < 256; o <<= 1) { const unsigned add = TID >= o ? sc[256 + TID - o] : 0u; __syncthreads(); sc[256 + TID] += add; __syncthreads(); }
    unsigned pos = sc[256 + TID] - csel;
    unsigned eq_seen = eq_before;
    for (int j = 0; j < per; ++j) {
        const int t = TID * per + j; const unsigned v = vals[t + (t >> 5)];
        bool take = v > thr;
        if (v == thr) { take = eq_seen < need_eq; ++eq_seen; }
        int sl = -1;
        if (take) { sl = (int)pos; ++pos; if (set == 0) sel_lat[(b * NE + e) * CAPL + sl] = rbase + t; else sel_ctx[(b * NE + e) * CAPC + sl] = rbase + t; }
        slot[(size_t)e * RR + rbase + t] = sl;
    }
}

__device__ __forceinline__ void f_resid2(float* ctxs, float* out, const bf16_t* __restrict__ ye_lat, const bf16_t* __restrict__ ye_ctx, const int* __restrict__ slot,
                         const float* __restrict__ g_post, const float* __restrict__ modl, int vb) {
    const int TID = ltid();
    int r = vb * 4 + (TID >> 6), lane = TID & 63;
    float* x = xrow_ptr(ctxs, out, r);
    const float* m = modl + modrow(r) * 6 * DM;
    int b = r / SS, s = r % SS;
    float y[16];
#pragma unroll
    for (int j = 0; j < 16; ++j) y[j] = 0.f;
    for (int e = 0; e < NE; ++e) {
        int sl = slot[(size_t)e * RR + r];
        if (sl < 0) continue;
        const bf16_t* src = s < CL ? ye_ctx + ((size_t)(b * NE + e) * CAPC + sl) * DM : ye_lat + ((size_t)(b * NE + e) * CAPL + sl) * DM;
#pragma unroll
        for (int j = 0; j < 16; ++j) y[j] += bf2f(src[lane + 64 * j]);
    }
    float ss = 0.f;
#pragma unroll
    for (int j = 0; j < 16; ++j) ss += y[j] * y[j];
    ss = wave_sum(ss);
    float rstd = rsqrtf(ss * (1.f / DM) + 1e-6f);
#pragma unroll
    for (int j = 0; j < 16; ++j) { int cidx = lane + 64 * j; x[cidx] += m[5120 + cidx] * (y[j] * rstd * g_post[cidx]); }
}


__device__ __forceinline__ void gbar(unsigned* cnt, unsigned target) {
    asm volatile("s_waitcnt vmcnt(0)" ::: "memory");
    __syncthreads();
    if (threadIdx.x == 0) {
        __builtin_amdgcn_s_waitcnt(0);
        __builtin_amdgcn_fence(__ATOMIC_RELEASE, "agent");
        asm volatile("s_waitcnt vmcnt(0)" ::: "memory");
        __hip_atomic_fetch_add(cnt, 1u, __ATOMIC_RELAXED, __HIP_MEMORY_SCOPE_AGENT);
        while (__hip_atomic_load(cnt, __ATOMIC_RELAXED, __HIP_MEMORY_SCOPE_AGENT) < target) __builtin_amdgcn_s_sleep(2);
        __builtin_amdgcn_fence(__ATOMIC_ACQUIRE, "agent");
        asm volatile("s_waitcnt vmcnt(0)" ::: "memory");
    }
    __syncthreads();
}
#ifndef REPMASK
#define REPMASK 0
#endif
#define REPS(k) for (int rep_ = 0; rep_ < (((REPMASK) >> (k)) & 1) + 1; ++rep_)
struct MP { const float* in[30]; float* out; char* ws; };
enum { I_X = 0, I_C, I_CTX, I_CCTX, I_WMOD, I_BMOD, I_NPRE, I_NPOST, I_WIN, I_WOUT, I_LAM, I_DAN, I_GCONV, I_GALOG, I_GDT, I_GNORM,
       I_W0, I_WUP, I_A0, I_AUP, I_GUP, I_KK, I_KA, I_RK, I_GNW, I_GNB, I_ROUTER, I_MGATE, I_MUP, I_MDOWN };
constexpr int PB_NPRE = 0, PB_NPOST = PB_NPRE + 4096, PB_LAM = PB_NPOST + 4096, PB_DAN = PB_LAM + 512, PB_GCONV = PB_DAN + 256, PB_GALOG = PB_GCONV + 7680,
              PB_GDT = PB_GALOG + 16, PB_GNORM = PB_GDT + 16, PB_W0 = PB_GNORM + 128, PB_WUP = PB_W0 + 1024, PB_A0 = PB_WUP + 32768, PB_AUP = PB_A0 + 1024,
              PB_GUP = PB_AUP + 32768, PB_KK = PB_GUP + 32768, PB_KA = PB_KK + 512, PB_RK = PB_KA + 512, PB_GNW = PB_RK + 512, PB_GNB = PB_GNW + 512,
              PB_ROUTER = PB_GNB + 512, PB_END = PB_ROUTER + 32768;
constexpr size_t al256c(size_t x) { return (x + 255) & ~(size_t)255; }
constexpr size_t WS_BAR = 0, WS_CNT = 256, WS_PRM = 512, WS_MOD = al256c(WS_PRM + (size_t)PB_END * 4), WS_CTXS = al256c(WS_MOD + (size_t)2 * 3 * 6 * DM * 4),
                 WS_AFF = al256c(WS_CTXS + (size_t)NB * CL * DM * 4), WS_TAB = al256c(WS_AFF + (size_t)RR * NE * 4), WS_SLOT = al256c(WS_TAB + (size_t)128 * 16 * 8),
                 WS_SELL = al256c(WS_SLOT + (size_t)NE * RR * 4), WS_SELC = al256c(WS_SELL + (size_t)32 * CAPL * 4), WS_WTIN = al256c(WS_SELC + (size_t)32 * CAPC * 4),
                 WS_WTOUT = al256c(WS_WTIN + (size_t)2 * DINP * DM * 2), WS_BUFA = al256c(WS_WTOUT + (size_t)2 * DM * DM * 2), WS_SO = al256c(WS_BUFA + (size_t)RR * DM * 2),
                 WS_P = al256c(WS_SO + (size_t)2 * RR * 512 * 2), WS_R3 = al256c(WS_P + (size_t)RR * DINP * 2), WS_VT = al256c(WS_R3 + (size_t)RR * 6208),
                 WS_XC = al256c(WS_VT + (size_t)NB * 4 * 128 * SS * 2), WS_END = al256c(WS_XC + (size_t)32 * 132 * 16384 * 2);

__device__ __forceinline__ char* lptr(char* p) { asm volatile("" : "+s"(p)); return p; }
#define PHASE char* const W = lptr(a.ws); float* const out = (float*)lptr((char*)a.out); (void)W; (void)out;
#define bar ((unsigned*)(W + WS_BAR))
#define cnt ((int*)(W + WS_CNT))
#define prm ((float*)(W + WS_PRM))
#define mod ((float*)(W + WS_MOD))
#define ctxs ((float*)(W + WS_CTXS))
#define aff ((float*)(W + WS_AFF))
#define tab ((float2*)(W + WS_TAB))
#define slot ((int*)(W + WS_SLOT))
#define sel_lat ((int*)(W + WS_SELL))
#define sel_ctx ((int*)(W + WS_SELC))
#define wt_in ((bf16_t*)(W + WS_WTIN))
#define wt_out ((bf16_t*)(W + WS_WTOUT))
#define bufA ((bf16_t*)(W + WS_BUFA))
#define so ((bf16_t*)(W + WS_SO))
#define P ((bf16_t*)(W + WS_P))
#define R3 ((bf16_t*)(W + WS_R3))
#define VT ((bf16_t*)(W + WS_VT))
#define XC ((bf16_t*)(W + WS_XC))
#define gq R3
#define gk (R3 + (size_t)RR * 256)
#define gv (R3 + (size_t)RR * 512)
#define kk_b (R3 + (size_t)RR * 768)
#define kka_b (R3 + (size_t)RR * 1024)
#define kd_b (R3 + (size_t)RR * 1536)
#define w_b ((float*)(R3 + (size_t)RR * 2048))
#define gab (w_b + (size_t)RR * 512)
#define mix ((float*)R3)
#define ye_lat R3
#define ye_ctx (R3 + (size_t)32 * CAPL * DM)
#define hid_lat P
#define hid_ctx (P + (size_t)32 * CAPL * DM)
#define h bufA
#define cat bufA
#define h2 bufA
#define wt_gu XC
#define wt_dn (XC + (size_t)NE * 2 * DM * DM)
#define modl (mod + (size_t)i * 3 * 6 * DM)
#define GBAR { PHASE gbar(bar, (++epoch) * (unsigned)nb); }

__global__ __launch_bounds__(256, 2) void mega(MP a) {
    __shared__ __attribute__((aligned(16))) float lds[18432 + 256];
    cg::grid_group grid = cg::this_grid();
    const int nb = gridDim.x, bid = blockIdx.x;
    unsigned epoch = 0;

    {
    PHASE
    if (bid == 0 && threadIdx.x < 4) cnt[threadIdx.x] = 0;
    {
        const int gt = lsgpr(bid) * 256 + ltid(), gn = nb * 256;
#define CPY(idx, off, n) for (int q_ = gt; q_ < (n); q_ += gn) prm[(off) + q_] = a.in[idx][q_];
        CPY(I_NPRE, PB_NPRE, 4096) CPY(I_NPOST, PB_NPOST, 4096) CPY(I_LAM, PB_LAM, 512) CPY(I_DAN, PB_DAN, 256) CPY(I_GCONV, PB_GCONV, 7680) CPY(I_GALOG, PB_GALOG, 16)
        CPY(I_GDT, PB_GDT, 16) CPY(I_GNORM, PB_GNORM, 128) CPY(I_W0, PB_W0, 1024) CPY(I_WUP, PB_WUP, 32768) CPY(I_A0, PB_A0, 1024) CPY(I_AUP, PB_AUP, 32768)
        CPY(I_GUP, PB_GUP, 32768) CPY(I_KK, PB_KK, 512) CPY(I_KA, PB_KA, 512) CPY(I_RK, PB_RK, 512) CPY(I_GNW, PB_GNW, 512) CPY(I_GNB, PB_GNB, 512) CPY(I_ROUTER, PB_ROUTER, 32768)
#undef CPY
    }
    REPS(0) {
    f_init(a.in[I_X], a.in[I_CTX], out, ctxs, lsgpr(bid), nb);
    for (int vb = lsgpr(bid); vb < (2 * 6 * DM) / 256; vb += nb) f_mod(a.in[I_C], a.in[I_CCTX], a.in[I_WMOD], a.in[I_BMOD], mod, vb, lds);
    for (int i = lsgpr(bid) * 256 + ltid(); i < 128 * 16; i += nb * 256) {
        int pos = i >> 4, f = i & 15;
        float ang = (float)pos * powf(10000.f, -(float)f / 16.f);
        tab[i] = make_float2(cosf(ang), sinf(ang));
    }
    {
        const int T_IN = 2 * 16 * 56, T_OUT = 2 * 16 * 16;
        for (int vb = lsgpr(bid); vb < T_IN + T_OUT; vb += nb) {
            int t = vb;
            if (t < T_IN) { int l = t / (16 * 56), q = t % (16 * 56); f_wconv(a.in[I_WIN] + (size_t)l * DM * DIN, DIN, wt_in + (size_t)l * DINP * DM, 0, q / 56, q % 56, lds); continue; }
            t -= T_IN;
            { int l = t / 256, q = t % 256; f_wconv(a.in[I_WOUT] + (size_t)l * DM * DM, DM, wt_out + (size_t)l * DM * DM, 0, q / 16, q % 16, lds); }
        }
    }
    }
    }
    grid.sync();

    _Pragma("unroll") for (int i = 0; i < 2; ++i) {
        const float lam_init = 0.8f - 0.6f * expf(-0.3f * (float)i);
        { PHASE
        REPS(1) for (int vb = lsgpr(bid); vb < RR / 4; vb += nb) f_normmod(ctxs, out, (prm + PB_NPRE) + (size_t)(i * 2 + 0) * DM, modl, 0, 1024, h, vb);
        }
        GBAR
        { PHASE
        REPS(2) for (int vb = lsgpr(bid); vb < 132 * 28; vb += nb) {
            const int mt = vb / 28, nt = vb % 28;
            RowDense ap{h + (size_t)mt * 128 * DM, DM}; RowDense bp{wt_in + (size_t)i * DINP * DM + (size_t)nt * 128 * DM, DM};
            EpiInProj ep{P, VT, tab, mt * 128, nt * 128};
            gemm128(ap, bp, DM, ep, (char*)lds);
        }
        }
        GBAR
        { PHASE
        REPS(3) for (int vb = lsgpr(bid); vb < RR; vb += nb) f_gdn_prep(P, (prm + PB_GCONV) + (size_t)i * 5 * 768, (prm + PB_GALOG) + i * 8, (prm + PB_GDT) + i * 8, gq, gk, gv, gab, vb);
        REPS(4) for (int vb = lsgpr(bid); vb < RR; vb += nb) f_rwkv_prep(P, (prm + PB_W0) + i * 512, (prm + PB_WUP) + (size_t)i * 2 * 32 * 256, (prm + PB_A0) + i * 512, (prm + PB_AUP) + (size_t)i * 2 * 32 * 256,
                                                           (prm + PB_KK) + i * 256, (prm + PB_KA) + i * 256, kk_b, w_b, kka_b, kd_b, vb, lds);
        }
        GBAR
        { PHASE
        REPS(5) for (int vb = lsgpr(bid); vb < 32 * 132; vb += nb) {
            const int mc = vb / 132, n = vb % 132;
            if (mc < 16) f_chunk_gdn(gq, gk, gv, gab, XC, mc, n, (char*)lds);
            else f_chunk_rwkv(P, kk_b, w_b, kka_b, kd_b, XC, mc - 16, n, (char*)lds);
        }
        }
        GBAR
        { PHASE
        REPS(6) if (lsgpr(bid) < 32) f_scan2(XC, so, bid);
        REPS(7) {
            const int nunits = i == 0 ? 1056 : 1024;
            int* sidx = (int*)(lds + 18432 + 128);
            for (;;) {
                __syncthreads();
                if (threadIdx.x == 0) *sidx = atomicAdd(cnt + i + 2 * rep_, 1);
                __syncthreads();
                const int u = *sidx;
                if (u >= nunits) break;
                int ubh, uqb;
                if (u < 1024) { ubh = u >> 7; uqb = 4 + (u & 127); } else { ubh = (u - 1024) >> 2; uqb = (u - 1024) & 3; }
                f_attn(P, VT, (prm + PB_LAM) + (size_t)i * 256, (prm + PB_DAN) + (size_t)i * 128, lam_init, cat, ubh, uqb, (char*)lds);
            }
        }
        }
        GBAR
        { PHASE
        REPS(8) for (int vb = lsgpr(bid); vb < RR; vb += nb) f_mix_out(P, cat, so, (prm + PB_GNORM) + i * 64, kd_b, (prm + PB_GUP) + (size_t)i * 64 * 256, (prm + PB_RK) + i * 256, (prm + PB_GNW) + i * 256, (prm + PB_GNB) + i * 256, vb, lds);
        REPS(9) for (int vb = lsgpr(bid); vb < 3 * 4096; vb += nb) {
            const int which = vb / 4096, q = vb % 4096, e = q / 256, qq = q % 256;
            const size_t le = (size_t)(i * NE + e);
            if (which == 0) f_wconv(a.in[I_MGATE] + le * DM * DM, DM, wt_gu + (size_t)e * 2 * DM * DM, 1, qq / 16, qq % 16, lds);
            else if (which == 1) f_wconv(a.in[I_MUP] + le * DM * DM, DM, wt_gu + (size_t)e * 2 * DM * DM, 2, qq / 16, qq % 16, lds);
            else f_wconv(a.in[I_MDOWN] + le * DM * DM, DM, wt_dn + (size_t)e * DM * DM, 0, qq / 16, qq % 16, lds);
        }
        }
        GBAR
        { PHASE
        REPS(10) for (int vb = lsgpr(bid); vb < 132 * 8; vb += nb) {
            const int mt = vb / 8, nt = vb % 8;
            RowDense ap{cat + (size_t)mt * 128 * DM, DM}; RowDense bp{wt_out + (size_t)i * DM * DM + (size_t)nt * 128 * DM, DM};
            EpiF32 ep{mix, DM, mt * 128, nt * 128};
            gemm128(ap, bp, DM, ep, (char*)lds);
        }
        }
        GBAR
        { PHASE
        for (int vb = lsgpr(bid); vb < RR / 4; vb += nb) f_resid1(ctxs, out, mix, (prm + PB_NPOST) + (size_t)(i * 2 + 0) * DM, (prm + PB_NPRE) + (size_t)(i * 2 + 1) * DM, modl, (prm + PB_ROUTER) + (size_t)i * DM * NE, h2, aff, vb);
        }
        GBAR
        { PHASE
        REPS(11) for (int vb = lsgpr(bid); vb < 64; vb += nb) f_topk(aff, sel_lat, sel_ctx, slot, vb, lds);
        }
        GBAR
        { PHASE
        REPS(12) for (int vb = lsgpr(bid); vb < 32 * 8 * 16 + 32 * 16; vb += nb) {
            int g, mt, nt, cap; const int* sel; bf16_t* hid;
            if (vb < 32 * 8 * 16) { g = vb / 128; mt = (vb % 128) / 16; nt = vb % 16; cap = CAPL; sel = sel_lat + g * CAPL; hid = hid_lat + (size_t)g * CAPL * DM; }
            else { int t = vb - 32 * 8 * 16; g = t / 16; mt = 0; nt = t % 16; cap = CAPC; sel = sel_ctx + g * CAPC; hid = hid_ctx + (size_t)g * CAPC * DM; }
            const int e = g % NE;
            RowGather ap{h2, sel + mt * 128, cap - mt * 128}; RowDense bp{wt_gu + ((size_t)e * 2 * DM + (size_t)nt * 128) * DM, DM};
            EpiMoE1 ep{hid, mt * 128, nt * 128, cap};
            gemm128(ap, bp, DM, ep, (char*)lds);
        }
        }
        GBAR
        { PHASE
        REPS(13) for (int vb = lsgpr(bid); vb < 32 * 8 * 8 + 32 * 8; vb += nb) {
            int g, mt, nt, cap; const int* sel; const bf16_t* hid; bf16_t* ye;
            if (vb < 32 * 8 * 8) { g = vb / 64; mt = (vb % 64) / 8; nt = vb % 8; cap = CAPL; sel = sel_lat + g * CAPL; hid = hid_lat + (size_t)g * CAPL * DM; ye = ye_lat + (size_t)g * CAPL * DM; }
            else { int t = vb - 32 * 8 * 8; g = t / 8; mt = 0; nt = t % 8; cap = CAPC; sel = sel_ctx + g * CAPC; hid = hid_ctx + (size_t)g * CAPC * DM; ye = ye_ctx + (size_t)g * CAPC * DM; }
            const int e = g % NE;
            RowDense ap{hid + (size_t)mt * 128 * DM, DM}; RowDense bp{wt_dn + ((size_t)e * DM + (size_t)nt * 128) * DM, DM};
            EpiMoE2 ep{ye, aff, sel, e, mt * 128, nt * 128, cap};
            gemm128(ap, bp, DM, ep, (char*)lds);
        }
        }
        GBAR
        { PHASE
        for (int vb = lsgpr(bid); vb < RR / 4; vb += nb) f_resid2(ctxs, out, ye_lat, ye_ctx, slot, (prm + PB_NPOST) + (size_t)(i * 2 + 1) * DM, modl, vb);
        }
        GBAR
    }
}

#undef bar
#undef cnt
#undef prm
#undef mod
#undef ctxs
#undef aff
#undef tab
#undef slot
#undef sel_lat
#undef sel_ctx
#undef wt_in
#undef wt_out
#undef bufA
#undef so
#undef P
#undef R3
#undef VT
#undef XC
#undef gq
#undef gk
#undef gv
#undef kk_b
#undef kka_b
#undef kd_b
#undef w_b
#undef gab
#undef mix
#undef ye_lat
#undef ye_ctx
#undef hid_lat
#undef hid_ctx
#undef h
#undef cat
#undef h2
#undef wt_gu
#undef wt_dn
#undef modl
extern "C" void kernel_launch(void* const* d_in, const int* in_sizes, int n_in, void* d_out, int out_size, void* d_ws, size_t ws_size, hipStream_t stream) {
    static int grid_blocks = 0;
    if (!grid_blocks) {
        int dev = 0, cus = 0, per_cu = 0;
        (void)hipGetDevice(&dev);
        (void)hipDeviceGetAttribute(&cus, hipDeviceAttributeMultiprocessorCount, dev);
        (void)hipOccupancyMaxActiveBlocksPerMultiprocessor(&per_cu, mega, 256, 0);
        if (per_cu < 1) per_cu = 1;
        if (per_cu > 2) per_cu = 2;
        grid_blocks = cus * per_cu;
    }
    if (WS_END > ws_size) { fprintf(stderr, "workspace too small: need %zu have %zu\n", (size_t)WS_END, ws_size); return; }
    MP a{};
    for (int i = 0; i < 30; ++i) a.in[i] = (const float*)d_in[i];
    a.out = (float*)d_out; a.ws = (char*)d_ws;
    (void)hipMemsetAsync((char*)d_ws + WS_BAR, 0, 512, stream);
    void* args[] = {&a};
    hipError_t e = hipLaunchCooperativeKernel((void*)mega, dim3(grid_blocks), dim3(256), args, 0, stream);
    if (e != hipSuccess) fprintf(stderr, "cooperative launch failed: %s (grid %d)\n", hipGetErrorString(e), grid_blocks);
}
```

```cpp
#include <hip/hip_runtime.h>
#include <stdint.h>
#include <stdio.h>
#include <hip/hip_cooperative_groups.h>
namespace cg = cooperative_groups;

#define NB 2
#define TL 8192
#define CL 256
#define SS 8448
#define RR 16896
#define DM 1024
#define DIN 3472
#define DINP 3584
#define NE 16
#define CAPL 1024
#define CAPC 32
#define OQ 0
#define OKK 512
#define OV 1024
#define OGQKV 1536
#define OGGATE 2304
#define OGA 2560
#define OGB 2568
#define ORKV 2576
#define OXW 3344
#define OXA 3376
#define OXG 3408

typedef unsigned short bf16_t;
typedef short bf16x8 __attribute__((ext_vector_type(8)));
typedef float f32x4 __attribute__((ext_vector_type(4)));
typedef unsigned u32x4 __attribute__((ext_vector_type(4)));
typedef unsigned u32x2 __attribute__((ext_vector_type(2)));
typedef float f32x16 __attribute__((ext_vector_type(16)));
#define MFMA32(a, b, c) __builtin_amdgcn_mfma_f32_32x32x16_bf16((a), (b), (c), 0, 0, 0)
__device__ __forceinline__ int crow(int r, int h) { return (r & 3) + 8 * (r >> 2) + 4 * h; }

#define LAUNDER(x) asm volatile("" : "+v"(x))
__device__ __forceinline__ int lsgpr(int x) { asm volatile("" : "+s"(x)); return x; }
__device__ __forceinline__ int ltid() { int t = threadIdx.x; LAUNDER(t); return t; }
__device__ __forceinline__ float siluf(float x) { return x / (1.f + expf(-x)); }
__device__ __forceinline__ float sigmf(float x) { return 1.f / (1.f + expf(-x)); }
__device__ __forceinline__ float wave_sum(float v) {
#pragma unroll
    for (int o = 1; o < 64; o <<= 1) v += __shfl_xor(v, o);
    return v;
}
__device__ __forceinline__ unsigned pk2bf(float lo, float hi) {
    typedef float f2 __attribute__((ext_vector_type(2))); typedef __bf16 b2 __attribute__((ext_vector_type(2)));
    f2 v = {lo, hi}; b2 b = __builtin_convertvector(v, b2); return __builtin_bit_cast(unsigned, b);
}
__device__ __forceinline__ bf16_t f2bf(float f) { return (bf16_t)(pk2bf(f, 0.f) & 0xffffu); }
__device__ __forceinline__ float bf2f(bf16_t u) { return __uint_as_float(((unsigned)u) << 16); }
__device__ __forceinline__ float* xrow_ptr(float* ctxs, float* out, int r) {
    int b = r >= SS ? 1 : 0, s = r - b * SS;
    return s < CL ? ctxs + ((size_t)(b * CL + s)) * DM : out + ((size_t)(b * TL + (s - CL))) * DM;
}
__device__ __forceinline__ int modrow(int r) { int b = r >= SS ? 1 : 0, s = r - b * SS; return s < CL ? 2 : b; }

__device__ __forceinline__ void f_init(const float* __restrict__ x, const float* __restrict__ ctx, float* out, float* ctxs, int vb, int nvb) {
    const int TID = ltid();
    size_t i = (size_t)vb * 256 + TID;
    size_t n1 = (size_t)NB * TL * DM / 4, n2 = (size_t)NB * CL * DM / 4;
    for (size_t j = i; j < n1; j += (size_t)nvb * 256) ((float4*)out)[j] = ((const float4*)x)[j];
    for (size_t j = i; j < n2; j += (size_t)nvb * 256) ((float4*)ctxs)[j] = ((const float4*)ctx)[j];
}

__device__ __forceinline__ void f_mod1(const float* __restrict__ c, const float* __restrict__ c_ctx, const float* __restrict__ w_mod, float* modp, int item, float* lds) {
    const int TID = ltid();
    float* cs = lds;
    const int kc = item & 31, cb = (item >> 5) % 6, l = item / 192;
    __syncthreads();
    if (TID < 96) { const int k = TID & 31, j = TID >> 5; const float v = j == 0 ? c[kc * 32 + k] : (j == 1 ? c[DM + kc * 32 + k] : c_ctx[kc * 32 + k]); cs[k * 4 + j] = siluf(v); }
    __syncthreads();
    const float* w = w_mod + ((size_t)l * DM + kc * 32) * 6 * DM + cb * 1024 + 4 * TID;
    f32x4 a0 = (f32x4){0.f, 0.f, 0.f, 0.f}, a1 = a0, a2 = a0;
#pragma unroll 8
    for (int k = 0; k < 32; ++k) {
        const f32x4 wv = *(const f32x4*)(w + (size_t)k * 6 * DM);
        const f32x4 cv = *(const f32x4*)(cs + k * 4);
        a0 += wv * cv[0]; a1 += wv * cv[1]; a2 += wv * cv[2];
    }
    float* dst = modp + ((size_t)(kc * 2 + l) * 3) * 6 * DM + cb * 1024 + 4 * TID;
    *(f32x4*)(dst) = a0; *(f32x4*)(dst + 6 * DM) = a1; *(f32x4*)(dst + 2 * 6 * DM) = a2;
}
__device__ __forceinline__ void f_mod2(const float* __restrict__ modp, const float* __restrict__ b_mod, float* mod, int vb) {
    const int idx = vb * 256 + ltid();
    const int l = idx / (3 * 6 * DM), n = idx % (6 * DM);
    float acc = b_mod[l * 6 * DM + n];
    const int j = (idx / (6 * DM)) % 3;
#pragma unroll 8
    for (int kc = 0; kc < 32; ++kc) acc += modp[((size_t)(kc * 2 + l) * 3 + j) * 6 * DM + n];
    mod[idx] = acc;
}

__device__ __forceinline__ void f_wconv(const float* __restrict__ W, int N, bf16_t* Wt, int rowmap, int kt, int nt, float* lds) {
    const int TID = ltid();
    float (*T)[65] = (float (*)[65])lds;
    const int tid = TID;
    __syncthreads();
#pragma unroll
    for (int i = 0; i < 16; ++i) {
        int k = (tid >> 6) + 4 * i, n = tid & 63;
        int gn = nt * 64 + n;
        T[k][n] = gn < N ? W[(size_t)(kt * 64 + k) * N + gn] : 0.f;
    }
    __syncthreads();
#pragma unroll
    for (int i = 0; i < 2; ++i) {
        int n = (tid >> 3) + 32 * i, kc = tid & 7;
        int gn = nt * 64 + n;
        int drow = rowmap == 0 ? gn : (32 * (gn >> 4) + (gn & 15) + (rowmap == 2 ? 16 : 0));
        u32x4 o;
        o[0] = pk2bf(T[kc * 8 + 0][n], T[kc * 8 + 1][n]); o[1] = pk2bf(T[kc * 8 + 2][n], T[kc * 8 + 3][n]);
        o[2] = pk2bf(T[kc * 8 + 4][n], T[kc * 8 + 5][n]); o[3] = pk2bf(T[kc * 8 + 6][n], T[kc * 8 + 7][n]);
        *(u32x4*)(Wt + (size_t)drow * DM + kt * 64 + kc * 8) = o;
    }
}

__device__ __forceinline__ void f_normmod(float* ctxs, float* out, const float* __restrict__ g, const float* __restrict__ modl, int sh_off, int sc_off, bf16_t* h, int vb) {
    const int TID = ltid();
    int r = vb * 4 + (TID >> 6), lane = TID & 63;
    const float* x = xrow_ptr(ctxs, out, r);
    const float* m = modl + modrow(r) * 6 * DM;
    f32x4 v[4]; float ss = 0.f;
#pragma unroll
    for (int j = 0; j < 4; ++j) { v[j] = *(const f32x4*)(x + 4 * lane + 256 * j); ss += v[j][0] * v[j][0] + v[j][1] * v[j][1] + v[j][2] * v[j][2] + v[j][3] * v[j][3]; }
    ss = wave_sum(ss);
    float rstd = rsqrtf(ss * (1.f / DM) + 1e-6f);
#pragma unroll
    for (int j = 0; j < 4; ++j) {
        int c0 = 4 * lane + 256 * j;
        f32x4 gg = *(const f32x4*)(g + c0), sc = *(const f32x4*)(m + sc_off + c0), sh = *(const f32x4*)(m + sh_off + c0);
        f32x4 o4 = v[j] * rstd * gg * (1.f + sc) + sh;
        u32x2 o; o[0] = pk2bf(o4[0], o4[1]); o[1] = pk2bf(o4[2], o4[3]);
        *(u32x2*)(h + (size_t)r * DM + c0) = o;
    }
}

template <class AP, class BP, class Epi>
__device__ __forceinline__ void gemm128(const AP& aptr, const BP& bptr, int K, const Epi& epi, char* lds) {
    const int TID = ltid();
    const int tid = TID, lane = tid & 63, wid = tid >> 6, wr = wid >> 1, wc = wid & 1, fr = lane & 15, fq = lane >> 4;
    const bf16_t* ag[4]; const bf16_t* bg[4]; int lo[4];
#pragma unroll
    for (int i = 0; i < 4; ++i) {
        int row = (tid >> 3) + 32 * i, ch = tid & 7;
        ag[i] = aptr(row) + ch * 8; bg[i] = bptr(row) + ch * 8;
        lo[i] = row * 128 + ((ch ^ ((row >> 1) & 7)) << 4);
    }
    f32x4 acc[4][4];
#pragma unroll
    for (int m = 0; m < 4; ++m)
#pragma unroll
        for (int n = 0; n < 4; ++n) acc[m][n] = (f32x4){0.f, 0.f, 0.f, 0.f};
    u32x4 ra[4], rb[4];
#pragma unroll
    for (int i = 0; i < 4; ++i) { ra[i] = *(const u32x4*)(ag[i]); rb[i] = *(const u32x4*)(bg[i]); }
    __syncthreads();
#pragma unroll
    for (int i = 0; i < 4; ++i) { *(u32x4*)(lds + lo[i]) = ra[i]; *(u32x4*)(lds + 16384 + lo[i]) = rb[i]; }
    __syncthreads();
    const int nk = K / 64;
    const int swz = fr >> 1;
    for (int kt = 0; kt < nk; ++kt) {
        const int buf = kt & 1;
        if (kt + 1 < nk) {
#pragma unroll
            for (int i = 0; i < 4; ++i) { ra[i] = *(const u32x4*)(ag[i] + (kt + 1) * 64); rb[i] = *(const u32x4*)(bg[i] + (kt + 1) * 64); }
        }
        const char* la = lds + buf * 32768; const char* lb = la + 16384;
#pragma unroll
        for (int ks = 0; ks < 2; ++ks) {
            bf16x8 af[4], bfr[4];
            const int coff = ((ks * 4 + fq) ^ swz) << 4;
#pragma unroll
            for (int m = 0; m < 4; ++m) af[m] = *(const bf16x8*)(la + (wr * 64 + m * 16 + fr) * 128 + coff);
#pragma unroll
            for (int n = 0; n < 4; ++n) bfr[n] = *(const bf16x8*)(lb + (wc * 64 + n * 16 + fr) * 128 + coff);
#pragma unroll
            for (int m = 0; m < 4; ++m)
#pragma unroll
                for (int n = 0; n < 4; ++n) acc[m][n] = __builtin_amdgcn_mfma_f32_16x16x32_bf16(bfr[n], af[m], acc[m][n], 0, 0, 0);
        }
        if (kt + 1 < nk) {
            char* wa = lds + (buf ^ 1) * 32768;
#pragma unroll
            for (int i = 0; i < 4; ++i) { *(u32x4*)(wa + lo[i]) = ra[i]; *(u32x4*)(wa + 16384 + lo[i]) = rb[i]; }
        }
        __syncthreads();
    }
    epi(acc, wr, wc, fr, fq);
}

struct RowDense { const bf16_t* base; size_t ld; __device__ __forceinline__ const bf16_t* operator()(int row) const { return base + (size_t)row * ld; } };
struct RowGather { const bf16_t* base; const int* idx; int maxrow; __device__ __forceinline__ const bf16_t* operator()(int row) const { int r = row < maxrow ? row : maxrow - 1; return base + (size_t)idx[r] * DM; } };

struct EpiInProj {
    bf16_t* P; bf16_t* VT; const float2* tab; int m0, n0;
    __device__ __forceinline__ void operator()(f32x4 (&acc)[4][4], int wr, int wc, int fr, int fq) const {
        const bool rope = n0 < 1024;
        const bool isv = n0 >= OV && n0 < OGQKV;
#pragma unroll
        for (int m = 0; m < 4; ++m) {
            const int r = m0 + wr * 64 + m * 16 + fr;
            const int b = r / SS, s = r % SS;
            if (rope && s >= CL) {
                const int t = s - CL;
#pragma unroll
                for (int ax = 0; ax < 2; ++ax) {
                    const int pos = ax == 0 ? (t >> 6) : (t & 63);
#pragma unroll
                    for (int j = 0; j < 4; ++j) {
                        const float2 cs = tab[pos * 16 + 4 * fq + j];
                        const float x1 = acc[m][2 * ax][j], x2 = acc[m][2 * ax + 1][j];
                        acc[m][2 * ax][j] = x1 * cs.x - x2 * cs.y;
                        acc[m][2 * ax + 1][j] = x2 * cs.x + x1 * cs.y;
                    }
                }
            }
            if (isv) {
                const int u = s & 15;
                const int ps = (s & ~15) | (((u >> 2) & 1) << 3) | ((u >> 3) << 2) | (u & 3);
#pragma unroll
                for (int n = 0; n < 4; ++n)
#pragma unroll
                    for (int j = 0; j < 4; ++j) {
                        const int c = n0 - OV + wc * 64 + n * 16 + 4 * fq + j;
                        VT[((size_t)(b * 4 + (c >> 7)) * 128 + (c & 127)) * SS + ps] = f2bf(acc[m][n][j]);
                    }
            } else {
#pragma unroll
                for (int n = 0; n < 4; ++n) {
                    u32x2 o; o[0] = pk2bf(acc[m][n][0], acc[m][n][1]); o[1] = pk2bf(acc[m][n][2], acc[m][n][3]);
                    *(u32x2*)(P + (size_t)r * DINP + n0 + wc * 64 + n * 16 + 4 * fq) = o;
                }
            }
        }
    }
};
struct EpiF32 {
    float* C; int ldc; int m0, n0;
    __device__ __forceinline__ void operator()(f32x4 (&acc)[4][4], int wr, int wc, int fr, int fq) const {
#pragma unroll
        for (int m = 0; m < 4; ++m)
#pragma unroll
            for (int n = 0; n < 4; ++n) *(f32x4*)(C + (size_t)(m0 + wr * 64 + m * 16 + fr) * ldc + n0 + wc * 64 + n * 16 + 4 * fq) = acc[m][n];
    }
};
struct EpiMoE1 {
    bf16_t* hid; int m0, n0, cap;
    __device__ __forceinline__ void operator()(f32x4 (&acc)[4][4], int wr, int wc, int fr, int fq) const {
#pragma unroll
        for (int m = 0; m < 4; ++m) {
            const int r = m0 + wr * 64 + m * 16 + fr;
            if (r >= cap) continue;
#pragma unroll
            for (int q = 0; q < 2; ++q) {
                float v[4];
#pragma unroll
                for (int j = 0; j < 4; ++j) v[j] = siluf(acc[m][2 * q][j]) * acc[m][2 * q + 1][j];
                u32x2 o; o[0] = pk2bf(v[0], v[1]); o[1] = pk2bf(v[2], v[3]);
                *(u32x2*)(hid + (size_t)r * DM + (n0 >> 1) + wc * 32 + q * 16 + 4 * fq) = o;
            }
        }
    }
};
struct EpiMoE2 {
    bf16_t* ye; const float* aff; const int* sel; int e, m0, n0, cap;
    __device__ __forceinline__ void operator()(f32x4 (&acc)[4][4], int wr, int wc, int fr, int fq) const {
#pragma unroll
        for (int m = 0; m < 4; ++m) {
            const int r = m0 + wr * 64 + m * 16 + fr;
            if (r >= cap) continue;
            const float sc = aff[(size_t)sel[r] * NE + e];
#pragma unroll
            for (int n = 0; n < 4; ++n) {
                u32x2 o; o[0] = pk2bf(acc[m][n][0] * sc, acc[m][n][1] * sc); o[1] = pk2bf(acc[m][n][2] * sc, acc[m][n][3] * sc);
                *(u32x2*)(ye + (size_t)r * DM + n0 + wc * 64 + n * 16 + 4 * fq) = o;
            }
        }
    }
};

__device__ __forceinline__ void f_attn(const bf16_t* __restrict__ P, const bf16_t* __restrict__ VT, const float* __restrict__ da_lambda, const float* __restrict__ da_norm,
                                       float lam_init, bf16_t* cat, int bh, int qb, char* lds) {
    const int TID = ltid();
    const int lane = TID & 63, wid = TID >> 6, ql = lane & 31, hi = lane >> 5;
    const int map = wid >> 1, qsub = wid & 1;
    const int b = bh >> 2, h = bh & 3;
    const int row0 = b * SS + qb * 64;
    const int ntiles = (qb < 4 ? CL : SS) / 64;
    const float C = 0.125f * 1.4426950408889634f;
    float* wsf = (float*)(lds + 65536) + wid * 64;
    const bf16_t* kg[4]; const bf16_t* vg[4]; int klo[4], vlo[4];
#pragma unroll
    for (int i = 0; i < 4; ++i) {
        const int ch = TID & 7;
        const int krow = (TID >> 3) + 32 * (i & 1), km = i >> 1;
        kg[i] = P + (size_t)(b * SS + krow) * DINP + OKK + h * 128 + km * 64 + ch * 8;
        klo[i] = km * 8192 + krow * 128 + ((ch ^ ((krow >> 1) & 7)) << 4);
        const int vrow = (TID >> 3) + 32 * i;
        vg[i] = VT + (size_t)(bh * 128 + vrow) * SS + ch * 8;
        vlo[i] = 16384 + vrow * 128 + ((ch ^ ((vrow >> 1) & 7)) << 4);
    }
    bf16x8 qf[4];
    {
        const bf16_t* qp = P + (size_t)(row0 + qsub * 32 + ql) * DINP + OQ + h * 128 + map * 64 + 8 * hi;
#pragma unroll
        for (int d0 = 0; d0 < 4; ++d0) qf[d0] = *(const bf16x8*)(qp + 16 * d0);
    }
    f32x16 O[4];
#pragma unroll
    for (int cb = 0; cb < 4; ++cb)
#pragma unroll
        for (int r = 0; r < 16; ++r) O[cb][r] = 0.f;
    float mrun = -1e30f, lrun = 0.f;
    u32x4 rk[4], rv[4];
#pragma unroll
    for (int i = 0; i < 4; ++i) { rk[i] = *(const u32x4*)(kg[i]); rv[i] = *(const u32x4*)(vg[i]); }
    __syncthreads();
#pragma unroll
    for (int i = 0; i < 4; ++i) { *(u32x4*)(lds + klo[i]) = rk[i]; *(u32x4*)(lds + vlo[i]) = rv[i]; }
    __syncthreads();
    const int swz = (ql >> 1) & 7;
    for (int t = 0; t < ntiles; ++t) {
        const int buf = t & 1;
        if (t + 1 < ntiles) {
#pragma unroll
            for (int i = 0; i < 4; ++i) { rk[i] = *(const u32x4*)(kg[i] + (size_t)(t + 1) * 64 * DINP); rv[i] = *(const u32x4*)(vg[i] + (t + 1) * 64); }
        }
        const char* kb = lds + buf * 32768 + map * 8192;
        const char* vb = lds + buf * 32768 + 16384;
        f32x16 p0, p1;
#pragma unroll
        for (int r = 0; r < 16; ++r) { p0[r] = 0.f; p1[r] = 0.f; }
#pragma unroll
        for (int d0 = 0; d0 < 4; ++d0) {
            const int co = ((2 * d0 + hi) ^ swz) << 4;
            const bf16x8 k0f = *(const bf16x8*)(kb + ql * 128 + co);
            const bf16x8 k1f = *(const bf16x8*)(kb + (32 + ql) * 128 + co);
            p0 = MFMA32(k0f, qf[d0], p0);
            p1 = MFMA32(k1f, qf[d0], p1);
        }
        float tm = fmaxf(p0[0], p1[0]);
#pragma unroll
        for (int r = 1; r < 16; ++r) tm = fmaxf(tm, fmaxf(p0[r], p1[r]));
        tm = fmaxf(tm, __shfl_xor(tm, 32));
        const float mnew = fmaxf(mrun, tm);
        if (__any(mnew > mrun)) {
            const float alpha = __builtin_amdgcn_exp2f((mrun - mnew) * C);
            lrun *= alpha; mrun = mnew;
            if (hi == 0) wsf[ql] = alpha;
            __builtin_amdgcn_s_waitcnt(0xc07f);
#pragma unroll
            for (int r = 0; r < 16; ++r) {
                const float f = wsf[crow(r, hi)];
#pragma unroll
                for (int cb = 0; cb < 4; ++cb) O[cb][r] *= f;
            }
        }
        const float mc = mrun * C;
        float ls = 0.f;
#pragma unroll
        for (int r = 0; r < 16; ++r) {
            p0[r] = __builtin_amdgcn_exp2f(fmaf(p0[r], C, -mc)); p1[r] = __builtin_amdgcn_exp2f(fmaf(p1[r], C, -mc));
            ls += p0[r] + p1[r];
        }
        lrun += ls;
        bf16x8 pf[4];
#pragma unroll
        for (int s = 0; s < 4; ++s) {
            u32x4 w;
#pragma unroll
            for (int j = 0; j < 4; ++j) w[j] = (s < 2) ? pk2bf(p0[8 * (s & 1) + 2 * j], p0[8 * (s & 1) + 2 * j + 1]) : pk2bf(p1[8 * (s & 1) + 2 * j], p1[8 * (s & 1) + 2 * j + 1]);
            pf[s] = __builtin_bit_cast(bf16x8, w);
        }
#pragma unroll
        for (int cb = 0; cb < 4; ++cb)
#pragma unroll
            for (int s = 0; s < 4; ++s) {
                const bf16x8 vf = *(const bf16x8*)(vb + (cb * 32 + ql) * 128 + (((2 * s + hi) ^ swz) << 4));
                O[cb] = MFMA32(pf[s], vf, O[cb]);
            }
        if (t + 1 < ntiles) {
            char* wb = lds + (buf ^ 1) * 32768;
#pragma unroll
            for (int i = 0; i < 4; ++i) { *(u32x4*)(wb + klo[i]) = rk[i]; *(u32x4*)(wb + vlo[i]) = rv[i]; }
        }
        __syncthreads();
    }
    lrun += __shfl_xor(lrun, 32);
    if (hi == 0) wsf[ql] = 1.f / lrun;
    __builtin_amdgcn_s_waitcnt(0xc07f);
    float* ost = (float*)lds + wid * 4096;
#pragma unroll
    for (int r = 0; r < 16; ++r) {
        const int q = crow(r, hi);
        const float f = wsf[q];
#pragma unroll
        for (int cb = 0; cb < 4; ++cb) ost[q * 128 + cb * 32 + ql] = O[cb][r] * f;
    }
    __syncthreads();
    float s01 = 0.f, s23 = 0.f;
    for (int d = 0; d < 64; ++d) { s01 += da_lambda[d] * da_lambda[64 + d]; s23 += da_lambda[128 + d] * da_lambda[192 + d]; }
    const float lam = expf(s01) - expf(s23) + lam_init;
    const float g0 = da_norm[lane] * (1.f - lam_init), g1 = da_norm[lane + 64] * (1.f - lam_init);
    for (int qq = 0; qq < 16; ++qq) {
        const int q = wid * 16 + qq, qs = q >> 5, qlq = q & 31;
        const float* o0 = (const float*)lds + qs * 4096 + qlq * 128;
        const float* o1 = (const float*)lds + (2 + qs) * 4096 + qlq * 128;
        const float v0 = o0[lane] - lam * o1[lane], v1 = o0[lane + 64] - lam * o1[lane + 64];
        const float ssq = wave_sum(v0 * v0 + v1 * v1);
        const float rstd = rsqrtf(ssq * (1.f / 128.f) + 1e-6f);
        bf16_t* dst = cat + (size_t)(row0 + q) * DM + h * 128;
        dst[lane] = f2bf(v0 * rstd * g0); dst[lane + 64] = f2bf(v1 * rstd * g1);
    }
}

__device__ __forceinline__ void f_gdn_prep(const bf16_t* __restrict__ p, const float* __restrict__ conv_w, const float* __restrict__ a_log,
                                                  const float* __restrict__ dt_bias, bf16_t* gq, bf16_t* gk, bf16_t* gv, float* gab, int vb) {
    const int TID = ltid();
    const int r0 = vb * 8, c = TID;
    const int b = r0 >= SS ? 1 : 0, s0 = r0 - b * SS;
    const int seg_lo = s0 < CL ? 0 : CL, seg_hi = s0 < CL ? CL : SS;
    float xin[3][12];
#pragma unroll
    for (int t = 0; t < 12; ++t) {
        const int s2 = s0 + t - 2;
        const bool ok = s2 >= seg_lo && s2 < seg_hi;
        const bf16_t* rp = p + (size_t)(b * SS + (ok ? s2 : s0)) * DINP + OGQKV + c;
#pragma unroll
        for (int j3 = 0; j3 < 3; ++j3) { const float v = bf2f(rp[j3 * 256]); xin[j3][t] = ok ? v : 0.f; }
    }
    float cw[3][5];
#pragma unroll
    for (int j3 = 0; j3 < 3; ++j3)
#pragma unroll
        for (int j = 0; j < 5; ++j) cw[j3][j] = conv_w[j * 768 + j3 * 256 + c];
#pragma unroll
    for (int i = 0; i < 8; ++i) {
        float val[3];
#pragma unroll
        for (int j3 = 0; j3 < 3; ++j3) {
            float acc = 0.f;
#pragma unroll
            for (int j = 0; j < 5; ++j) acc += xin[j3][i + j] * cw[j3][j];
            val[j3] = siluf(acc);
        }
        const float sq = wave_sum(val[0] * val[0]);
        const float sk = wave_sum(val[1] * val[1]);
        const size_t r = r0 + i;
        gq[r * 256 + c] = f2bf(val[0] * rsqrtf(sq + 1e-12f) * 0.125f);
        gk[r * 256 + c] = f2bf(val[1] * rsqrtf(sk + 1e-12f));
        gv[r * 256 + c] = f2bf(val[2]);
    }
    if (c < 128) {
        const size_t r = r0 + (c >> 4); const int q = c & 15;
        if (q < 8) {
            const float av = bf2f(p[r * DINP + OGA + q]);
            const float xx = av + dt_bias[q];
            const float sp = xx > 20.f ? xx : log1pf(expf(xx));
            gab[r * 16 + q] = -expf(a_log[q]) * sp;
        } else {
            gab[r * 16 + q] = sigmf(bf2f(p[r * DINP + OGB + (q - 8)]));
        }
    }
}

__device__ __forceinline__ void f_rwkv_prep(const bf16_t* __restrict__ p, const float* __restrict__ w0, const float* __restrict__ w_up,
                                                   const float* __restrict__ a0, const float* __restrict__ a_up, const float* __restrict__ k_k,
                                                   const float* __restrict__ k_a, bf16_t* kk_o, float* w_o, bf16_t* kka_o, bf16_t* kd_o, int vb, float* lds) {
    const int TID = ltid();
    float* xwT = lds;
    float* xaT = lds + 256;
    __syncthreads();
    const int r0 = vb * 8, c = TID;
    {
        const int i = TID >> 5, j = TID & 31;
        const bf16_t* pr = p + (size_t)(r0 + i) * DINP;
        xwT[j * 8 + i] = tanhf(bf2f(pr[OXW + j]));
        xaT[j * 8 + i] = bf2f(pr[OXA + j]);
    }
    float k[8], kk[8];
    const float kkc = k_k[c], kac = k_a[c];
#pragma unroll
    for (int i = 0; i < 8; ++i) k[i] = bf2f(p[(size_t)(r0 + i) * DINP + ORKV + 256 + c]);
#pragma unroll
    for (int i = 0; i < 8; ++i) {
        const float kq = k[i] * kkc;
        const float ss = wave_sum(kq * kq);
        kk[i] = kq * rsqrtf(ss + 1e-12f);
        kk_o[(size_t)(r0 + i) * 256 + c] = f2bf(kk[i]);
    }
    __syncthreads();
#pragma unroll
    for (int d = 0; d < 2; ++d) {
        float aw[8], aa[8];
        const float w0c = w0[d * 256 + c], a0c = a0[d * 256 + c];
#pragma unroll
        for (int i = 0; i < 8; ++i) { aw[i] = w0c; aa[i] = a0c; }
#pragma unroll 4
        for (int j = 0; j < 32; ++j) {
            const float wv = w_up[(d * 32 + j) * 256 + c], av = a_up[(d * 32 + j) * 256 + c];
            const f32x4 x0 = *(const f32x4*)(xwT + j * 8), x1 = *(const f32x4*)(xwT + j * 8 + 4);
            const f32x4 y0 = *(const f32x4*)(xaT + j * 8), y1 = *(const f32x4*)(xaT + j * 8 + 4);
#pragma unroll
            for (int i = 0; i < 4; ++i) { aw[i] += x0[i] * wv; aw[4 + i] += x1[i] * wv; aa[i] += y0[i] * av; aa[4 + i] += y1[i] * av; }
        }
#pragma unroll
        for (int i = 0; i < 8; ++i) {
            const float logw = -0.6065306597126334f * sigmf(aw[i]);
            const float ad = sigmf(aa[i]);
            const size_t r = r0 + i;
            w_o[r * 512 + d * 256 + c] = logw;
            kka_o[r * 512 + d * 256 + c] = f2bf(kk[i] * ad);
            kd_o[r * 512 + d * 256 + c] = f2bf(k[i] * (1.f + (ad - 1.f) * kac));
        }
    }
}

#define MFMA16(a, b, c) __builtin_amdgcn_mfma_f32_16x16x32_bf16((a), (b), (c), 0, 0, 0)
__device__ __forceinline__ int scan_row(int b, int dir, int p) {
    const int s = dir == 0 ? p : (p < CL ? (CL - 1 - p) : (CL + (TL - 1 - (p - CL))));
    return b * SS + s;
}
__device__ __forceinline__ void mm64(const char* A, const char* Bt, f32x4 (&acc)[4], int w, int fr, int fq) {
#pragma unroll
    for (int ks = 0; ks < 2; ++ks) {
        const int co = ((ks * 4 + fq) ^ (fr >> 1)) << 4;
        const bf16x8 af = *(const bf16x8*)(A + (16 * w + fr) * 128 + co);
#pragma unroll
        for (int n = 0; n < 4; ++n) { const bf16x8 bfr = *(const bf16x8*)(Bt + (16 * n + fr) * 128 + co); acc[n] = MFMA16(bfr, af, acc[n]); }
    }
}
__device__ __forceinline__ void zero4(f32x4 (&acc)[4]) {
#pragma unroll
    for (int n = 0; n < 4; ++n) acc[n] = (f32x4){0.f, 0.f, 0.f, 0.f};
}
__device__ __forceinline__ void tile_row_write(char* T, int c, const float (&x)[64]) {
#pragma unroll
    for (int ch = 0; ch < 8; ++ch) {
        u32x4 o; o[0] = pk2bf(x[8 * ch], x[8 * ch + 1]); o[1] = pk2bf(x[8 * ch + 2], x[8 * ch + 3]); o[2] = pk2bf(x[8 * ch + 4], x[8 * ch + 5]); o[3] = pk2bf(x[8 * ch + 6], x[8 * ch + 7]);
        *(u32x4*)(T + c * 128 + ((ch ^ ((c >> 1) & 7)) << 4)) = o;
    }
}
__device__ __forceinline__ void tri_solve(const float* Am, float (&x)[64]) {
#pragma unroll
    for (int i = 1; i < 64; ++i) {
        float acc = x[i];
#pragma unroll
        for (int j = 0; j < i; ++j) acc -= Am[i * 64 + j] * x[j];
        x[i] = acc;
    }
}
__device__ __forceinline__ void store_perm(bf16_t* dst, const f32x4 (&acc)[4], int w, int fr, int fq) {
#pragma unroll
    for (int n = 0; n < 4; ++n) {
        u32x2 o; o[0] = pk2bf(acc[n][0], acc[n][1]); o[1] = pk2bf(acc[n][2], acc[n][3]);
        *(u32x2*)(dst + (16 * w + fr) * 64 + 32 * (n >> 1) + 8 * fq + 4 * (n & 1)) = o;
    }
}
__device__ __forceinline__ void store_acc(bf16_t* dst, const f32x4 (&acc)[4], int w, int fr, int fq) {
#pragma unroll
    for (int n = 0; n < 4; ++n)
#pragma unroll
        for (int jj = 0; jj < 4; ++jj) dst[((n * 4 + w) * 64 + (4 * fq + jj) + 16 * (fr >> 2)) * 4 + (fr & 3)] = f2bf(acc[n][jj]);
}

#define TILE(k) (lds + (k) * 8192)
#define SCAL ((float*)(lds + 73728))
__device__ __forceinline__ float tile_get(const char* T, int i, int c3, int clow) { return bf2f(*(const bf16_t*)(T + i * 128 + (((c3 ^ ((i >> 1) & 7)) << 4) | clow))); }
__device__ __forceinline__ void tile_put(char* T, int i, int c3, int clow, float v) { *(bf16_t*)(T + i * 128 + (((c3 ^ ((i >> 1) & 7)) << 4) | clow)) = f2bf(v); }
__device__ __forceinline__ void stage_tile(char* T, const bf16_t* base, size_t ld, int b, int dir, int p0, int TID) {
#pragma unroll
    for (int k = 0; k < 2; ++k) {
        const int id = TID + 256 * k, row = id >> 3, chn = id & 7;
        const size_t r = scan_row(b, dir, p0 + row);
        *(u32x4*)(T + row * 128 + ((chn ^ ((row >> 1) & 7)) << 4)) = *(const u32x4*)(base + r * ld + chn * 8);
    }
}
__device__ __forceinline__ f32x4 tile_get4(const char* T, int i, int j0) {
    const u32x2 rv = *(const u32x2*)(T + i * 128 + (((j0 >> 3) ^ ((i >> 1) & 7)) << 4) + (j0 & 7) * 2);
    return (f32x4){bf2f((bf16_t)(rv[0] & 0xffffu)), bf2f((bf16_t)(rv[0] >> 16)), bf2f((bf16_t)(rv[1] & 0xffffu)), bf2f((bf16_t)(rv[1] >> 16))};
}
__device__ __forceinline__ void tile_put4(char* T, int i, int j0, float v0, float v1, float v2, float v3) {
    u32x2 o; o[0] = pk2bf(v0, v1); o[1] = pk2bf(v2, v3);
    *(u32x2*)(T + i * 128 + (((j0 >> 3) ^ ((i >> 1) & 7)) << 4) + (j0 & 7) * 2) = o;
}

__device__ __forceinline__ void f_chunk_gdn(const bf16_t* __restrict__ gq, const bf16_t* __restrict__ gk, const bf16_t* __restrict__ gv, const float* __restrict__ gab,
                                            bf16_t* X, int chain, int n, char* lds) {
    const int TID = ltid();
    const int lane = TID & 63, w = TID >> 6, fr = lane & 15, fq = lane >> 4;
    const int dir = chain & 1, h = (chain >> 1) & 3, b = chain >> 3;
    float* gcs = SCAL; float* bts = SCAL + 64;
    float* Am = (float*)TILE(7);
    __syncthreads();
    if (TID < 64) {
        const int r = scan_row(b, dir, n * 64 + TID);
        float g = gab[(size_t)r * 16 + dir * 4 + h];
#pragma unroll
        for (int o = 1; o < 64; o <<= 1) { const float t = __shfl_up(g, o); if (lane >= o) g += t; }
        gcs[TID] = g; bts[TID] = gab[(size_t)r * 16 + 8 + dir * 4 + h];
    }
    stage_tile(TILE(0), gq + h * 64, 256, b, dir, n * 64, TID);
    stage_tile(TILE(1), gk + h * 64, 256, b, dir, n * 64, TID);
    stage_tile(TILE(3), gv + h * 64, 256, b, dir, n * 64, TID);
    __syncthreads();
    {
        const int i = 16 * w + fr; const float gi = gcs[i], bi = bts[i];
        f32x4 acc[4]; zero4(acc); mm64(TILE(1), TILE(1), acc, w, fr, fq);
#pragma unroll
        for (int nn = 0; nn < 4; ++nn)
#pragma unroll
            for (int jj = 0; jj < 4; ++jj) { const int j = 16 * nn + 4 * fq + jj; Am[i * 64 + j] = j < i ? bi * acc[nn][jj] * __expf(gi - gcs[j]) : 0.f; }
        zero4(acc); mm64(TILE(0), TILE(1), acc, w, fr, fq);
#pragma unroll
        for (int nn = 0; nn < 4; ++nn) {
            float v[4];
#pragma unroll
            for (int jj = 0; jj < 4; ++jj) { const int j = 16 * nn + 4 * fq + jj; v[jj] = j <= i ? acc[nn][jj] * __expf(gi - gcs[j]) : 0.f; }
            tile_put4(TILE(2), i, 16 * nn + 4 * fq, v[0], v[1], v[2], v[3]);
        }
    }
    __syncthreads();
    if (TID < 192) {
        const int c = lane, c3 = c >> 3, clow = (c & 7) << 1;
        float x[64];
        if (w == 0) {
#pragma unroll
            for (int i = 0; i < 64; ++i) x[i] = tile_get(TILE(3), i, c3, clow) * bts[i];
            tri_solve(Am, x); tile_row_write(TILE(4), c, x);
        } else if (w == 1) {
#pragma unroll
            for (int i = 0; i < 64; ++i) x[i] = tile_get(TILE(1), i, c3, clow) * bts[i] * __expf(gcs[i]);
            tri_solve(Am, x); tile_row_write(TILE(5), c, x);
        } else {
            const float g63 = gcs[63];
#pragma unroll
            for (int i = 0; i < 64; ++i) x[i] = tile_get(TILE(1), i, c3, clow) * __expf(g63 - gcs[i]);
            tile_row_write(TILE(6), c, x);
        }
    }
    __syncthreads();
    {
        bf16_t* Xi = X + ((size_t)(chain * 132 + n)) * 16384;
        const int i = 16 * w + fr;
        f32x4 acc[4];
        zero4(acc); mm64(TILE(2), TILE(4), acc, w, fr, fq); store_acc(Xi + 8192, acc, w, fr, fq);
        zero4(acc); mm64(TILE(2), TILE(5), acc, w, fr, fq);
        {
            const float eg = __expf(gcs[i]);
#pragma unroll
            for (int nn = 0; nn < 4; ++nn) { const f32x4 qv = tile_get4(TILE(0), i, 16 * nn + 4 * fq); acc[nn] = qv * eg - acc[nn]; }
            store_perm(Xi + 4096, acc, w, fr, fq);
        }
        zero4(acc); mm64(TILE(6), TILE(5), acc, w, fr, fq);
        {
            const float gt = __expf(gcs[63]);
#pragma unroll
            for (int nn = 0; nn < 4; ++nn)
#pragma unroll
                for (int jj = 0; jj < 4; ++jj) acc[nn][jj] = ((16 * nn + 4 * fq + jj) == i ? gt : 0.f) - acc[nn][jj];
            store_perm(Xi, acc, w, fr, fq);
        }
        zero4(acc); mm64(TILE(6), TILE(4), acc, w, fr, fq); store_acc(Xi + 12288, acc, w, fr, fq);
    }
}

__device__ __forceinline__ void f_chunk_rwkv(const bf16_t* __restrict__ P, const bf16_t* __restrict__ kk_i, const float* __restrict__ lw_i, const bf16_t* __restrict__ kka_i,
                                             const bf16_t* __restrict__ kd_i, bf16_t* X, int chain, int n, char* lds) {
    const int TID = ltid();
    const int lane = TID & 63, w = TID >> 6, fr = lane & 15, fq = lane >> 4;
    const int dir = chain & 1, h = (chain >> 1) & 3, b = chain >> 3;
    const int c3 = lane >> 3, clow = (lane & 7) << 1;
    float* wc = SCAL;
    float* Am = (float*)TILE(7);
    __syncthreads();
    stage_tile(TILE(0), kk_i + h * 64, 256, b, dir, n * 64, TID);
    stage_tile(TILE(1), kka_i + dir * 256 + h * 64, 512, b, dir, n * 64, TID);
    stage_tile(TILE(2), kd_i + dir * 256 + h * 64, 512, b, dir, n * 64, TID);
    stage_tile(TILE(3), P + ORKV + h * 64, DINP, b, dir, n * 64, TID);
    stage_tile(TILE(4), P + ORKV + 512 + h * 64, DINP, b, dir, n * 64, TID);
#pragma unroll
    for (int k = 0; k < 4; ++k) {
        const int id = TID + 256 * k, row = id >> 4, chn = id & 15;
        const size_t r = scan_row(b, dir, n * 64 + row);
        *(f32x4*)(Am + row * 64 + chn * 4) = *(const f32x4*)(lw_i + r * 512 + dir * 256 + h * 64 + chn * 4);
    }
    __syncthreads();
    {
        float lc = 0.f;
        char* T = TILE(w);
#pragma unroll
        for (int i = 0; i < 64; ++i) {
            const float lprev = lc; lc += Am[i * 64 + lane];
            const float e = w == 0 ? lprev : (w == 3 ? lc : -lc);
            tile_put(T, i, c3, clow, tile_get(T, i, c3, clow) * __expf(e));
        }
        if (w == 0) wc[lane] = __expf(lc);
    }
    __syncthreads();
    if (w == 0) {
        float x[64];
#pragma unroll
        for (int i = 0; i < 64; ++i) x[i] = tile_get(TILE(4), i, c3, clow);
        tile_row_write(TILE(5), lane, x);
    }
    {
        const int i = 16 * w + fr;
        f32x4 acc[4];
        zero4(acc); mm64(TILE(0), TILE(1), acc, w, fr, fq);
#pragma unroll
        for (int nn = 0; nn < 4; ++nn)
#pragma unroll
            for (int jj = 0; jj < 4; ++jj) { const int j = 16 * nn + 4 * fq + jj; Am[i * 64 + j] = j < i ? acc[nn][jj] : 0.f; }
        zero4(acc); mm64(TILE(0), TILE(2), acc, w, fr, fq);
#pragma unroll
        for (int nn = 0; nn < 4; ++nn) {
            float v[4];
#pragma unroll
            for (int jj = 0; jj < 4; ++jj) { const int j = 16 * nn + 4 * fq + jj; v[jj] = j < i ? acc[nn][jj] : 0.f; }
            tile_put4(TILE(6), i, 16 * nn + 4 * fq, v[0], v[1], v[2], v[3]);
        }
    }
    __syncthreads();
    {
        const int i = 16 * w + fr;
        f32x4 acc[4]; zero4(acc); mm64(TILE(6), TILE(5), acc, w, fr, fq);
#pragma unroll
        for (int nn = 0; nn < 4; ++nn)
#pragma unroll
            for (int jj = 0; jj < 4; ++jj) { const int c = 16 * nn + 4 * fq + jj; *(bf16_t*)(TILE(4) + c * 128 + ((((i >> 3) ^ ((c >> 1) & 7)) << 4) | ((i & 7) << 1))) = f2bf(acc[nn][jj]); }
    }
    __syncthreads();
    if (w < 2) {
        float x[64];
        if (w == 0) {
#pragma unroll
            for (int ch = 0; ch < 8; ++ch) {
                const bf16x8 v = *(const bf16x8*)(TILE(4) + lane * 128 + ((ch ^ ((lane >> 1) & 7)) << 4));
#pragma unroll
                for (int e = 0; e < 8; ++e) x[8 * ch + e] = -bf2f((bf16_t)v[e]);
            }
        } else {
#pragma unroll
            for (int i = 0; i < 64; ++i) x[i] = tile_get(TILE(0), i, c3, clow);
        }
        tri_solve(Am, x);
        tile_row_write(w == 0 ? TILE(6) : TILE(0), lane, x);
    }
    __syncthreads();
    {
        const int i = 16 * w + fr;
#pragma unroll
        for (int q = 0; q < 2; ++q) {
            f32x4 acc[4]; zero4(acc); mm64(TILE(3), TILE(1 + q), acc, w, fr, fq);
#pragma unroll
            for (int nn = 0; nn < 4; ++nn) {
                float v[4];
#pragma unroll
                for (int jj = 0; jj < 4; ++jj) { const int j = 16 * nn + 4 * fq + jj; v[jj] = j <= i ? acc[nn][jj] : 0.f; }
                tile_put4(TILE(7 + q), i, 16 * nn + 4 * fq, v[0], v[1], v[2], v[3]);
            }
        }
    }
    if (w == 0) {
        float x[64]; const float wd = wc[lane];
#pragma unroll
        for (int i = 0; i < 64; ++i) x[i] = tile_get(TILE(1), i, c3, clow) * wd;
        tile_row_write(TILE(4), lane, x);
    }
    __syncthreads();
    bf16_t* Xi = X + ((size_t)((16 + chain) * 132 + n)) * 16384;
    f32x4 sa[4];
    {
        const int i = 16 * w + fr;
        f32x4 acc[4];
        zero4(acc); mm64(TILE(7), TILE(6), acc, w, fr, fq); mm64(TILE(8), TILE(5), acc, w, fr, fq); store_acc(Xi + 8192, acc, w, fr, fq);
        zero4(acc); mm64(TILE(7), TILE(0), acc, w, fr, fq);
#pragma unroll
        for (int nn = 0; nn < 4; ++nn) { const f32x4 rv = tile_get4(TILE(3), i, 16 * nn + 4 * fq); acc[nn] = rv - acc[nn]; }
        store_perm(Xi + 4096, acc, w, fr, fq);
        zero4(acc); mm64(TILE(4), TILE(0), acc, w, fr, fq);
        {
            const float wd = wc[i];
#pragma unroll
            for (int nn = 0; nn < 4; ++nn)
#pragma unroll
                for (int jj = 0; jj < 4; ++jj) acc[nn][jj] = ((16 * nn + 4 * fq + jj) == i ? wd : 0.f) - acc[nn][jj];
            store_perm(Xi, acc, w, fr, fq);
        }
        zero4(sa); mm64(TILE(4), TILE(6), sa, w, fr, fq);
    }
    __syncthreads();
    if (w == 0) {
        float x[64]; const float wd = wc[lane];
#pragma unroll
        for (int i = 0; i < 64; ++i) x[i] = tile_get(TILE(2), i, c3, clow) * wd;
        tile_row_write(TILE(4), lane, x);
    }
    __syncthreads();
    mm64(TILE(4), TILE(5), sa, w, fr, fq); store_acc(Xi + 12288, sa, w, fr, fq);
}

struct ScanOps { bf16x8 ar[4][2], ag[4][2]; u32x2 y0[4], s0[4]; };
__device__ __forceinline__ void scan_load(ScanOps& o, const bf16_t* Xi, int slab, int lane, int c, int q) {
#pragma unroll
    for (int mb = 0; mb < 4; ++mb) {
        o.y0[mb] = *(const u32x2*)(Xi + 8192 + ((slab * 4 + mb) * 64 + lane) * 4);
        o.s0[mb] = *(const u32x2*)(Xi + 12288 + ((slab * 4 + mb) * 64 + lane) * 4);
#pragma unroll
        for (int s = 0; s < 2; ++s) {
            o.ar[mb][s] = *(const bf16x8*)(Xi + 4096 + (16 * mb + c) * 64 + 32 * s + 8 * q);
            o.ag[mb][s] = *(const bf16x8*)(Xi + (16 * mb + c) * 64 + 32 * s + 8 * q);
        }
    }
}
__device__ __forceinline__ void scan_step(const ScanOps& o, f32x4 (&S)[4], bf16_t* so, int b, int dir, int colbase, int n, int c, int q) {
    bf16x8 bS[2];
#pragma unroll
    for (int s = 0; s < 2; ++s) {
        u32x4 w; w[0] = pk2bf(S[2 * s][0], S[2 * s][1]); w[1] = pk2bf(S[2 * s][2], S[2 * s][3]); w[2] = pk2bf(S[2 * s + 1][0], S[2 * s + 1][1]); w[3] = pk2bf(S[2 * s + 1][2], S[2 * s + 1][3]);
        bS[s] = __builtin_bit_cast(bf16x8, w);
    }
#pragma unroll
    for (int mb = 0; mb < 4; ++mb) {
        f32x4 y = (f32x4){bf2f((bf16_t)(o.y0[mb][0] & 0xffffu)), bf2f((bf16_t)(o.y0[mb][0] >> 16)), bf2f((bf16_t)(o.y0[mb][1] & 0xffffu)), bf2f((bf16_t)(o.y0[mb][1] >> 16))};
        f32x4 sn = (f32x4){bf2f((bf16_t)(o.s0[mb][0] & 0xffffu)), bf2f((bf16_t)(o.s0[mb][0] >> 16)), bf2f((bf16_t)(o.s0[mb][1] & 0xffffu)), bf2f((bf16_t)(o.s0[mb][1] >> 16))};
#pragma unroll
        for (int s = 0; s < 2; ++s) { y = MFMA16(o.ar[mb][s], bS[s], y); sn = MFMA16(o.ag[mb][s], bS[s], sn); }
#pragma unroll
        for (int reg = 0; reg < 4; ++reg) {
            const int r = scan_row(b, dir, n * 64 + 16 * mb + 4 * q + reg);
            so[((size_t)dir * RR + r) * 512 + colbase + c] = f2bf(y[reg]);
        }
        S[mb] = sn;
    }
}
__device__ __forceinline__ void f_scan2(const bf16_t* __restrict__ X, bf16_t* so, int mc  ) {
    const int TID = ltid();
    const int lane = TID & 63, slab = TID >> 6, c = lane & 15, q = lane >> 4;
    const int mixer = mc >> 4, chain = mc & 15, dir = chain & 1, h = (chain >> 1) & 3, b = chain >> 3;
    const int colbase = mixer * 256 + h * 64 + slab * 16;
    f32x4 S[4];
#pragma unroll
    for (int mb = 0; mb < 4; ++mb) S[mb] = (f32x4){0.f, 0.f, 0.f, 0.f};
    const bf16_t* X0 = X + (size_t)(mc * 132) * 16384;
    ScanOps A, B;
    scan_load(A, X0, slab, lane, c, q);
#pragma unroll 1
    for (int n = 0; n < 132; n += 2) {
        scan_load(B, X0 + (size_t)(n + 1) * 16384, slab, lane, c, q);
        scan_step(A, S, so, b, dir, colbase, n, c, q);
        if (n + 2 < 132) scan_load(A, X0 + (size_t)(n + 2) * 16384, slab, lane, c, q);
        scan_step(B, S, so, b, dir, colbase, n + 1, c, q);
    }
}

__device__ __forceinline__ void f_mix_out(const bf16_t* __restrict__ p, bf16_t* cat, const bf16_t* __restrict__ so, const float* __restrict__ gdn_norm,
                                                 const bf16_t* __restrict__ kd_i, const float* __restrict__ g_up, const float* __restrict__ r_k,
                                                 const float* __restrict__ gn_w, const float* __restrict__ gn_b, int vb, float* lds) {
    const int TID = ltid();
    float* xgT = lds;
    __syncthreads();
    const int r0 = vb * 8, c = TID;
#pragma unroll
    for (int t = 0; t < 2; ++t) { const int id = TID + 256 * t, i = id >> 6, j = id & 63; xgT[j * 8 + i] = sigmf(bf2f(p[(size_t)(r0 + i) * DINP + OXG + j])); }
    __syncthreads();
    float g[8];
#pragma unroll
    for (int i = 0; i < 8; ++i) g[i] = 0.f;
#pragma unroll 4
    for (int j = 0; j < 64; ++j) {
        const float gu = g_up[j * 256 + c];
        const f32x4 x0 = *(const f32x4*)(xgT + j * 8), x1 = *(const f32x4*)(xgT + j * 8 + 4);
#pragma unroll
        for (int i = 0; i < 4; ++i) { g[i] += x0[i] * gu; g[4 + i] += x1[i] * gu; }
    }
    const float gnc = gdn_norm[c & 63], rkc = r_k[c], gw = gn_w[c], gb = gn_b[c];
#pragma unroll
    for (int i = 0; i < 8; ++i) {
        const size_t r = r0 + i;
        const bf16_t* pr = p + r * DINP;
        const float o = bf2f(so[r * 512 + c]) + bf2f(so[((size_t)RR + r) * 512 + c]);
        const float ss = wave_sum(o * o);
        const float y = o * rsqrtf(ss * (1.f / 64.f) + 1e-6f) * gnc * siluf(bf2f(pr[OGGATE + c]));
        const float yv = bf2f(so[r * 512 + 256 + c]) + bf2f(so[((size_t)RR + r) * 512 + 256 + c]);
        const float mu = wave_sum(yv) * (1.f / 64.f);
        const float dv = yv - mu;
        const float var = wave_sum(dv * dv) * (1.f / 64.f);
        const float yn = dv * rsqrtf(var + 64e-5f) * gw + gb;
        const float rr = bf2f(pr[ORKV + c]), vv = bf2f(pr[ORKV + 512 + c]);
        const float kds = bf2f(kd_i[r * 512 + c]) + bf2f(kd_i[r * 512 + 256 + c]);
        const float bs = wave_sum(rr * kds * rkc);
        cat[r * DM + 512 + c] = f2bf(y);
        cat[r * DM + 768 + c] = f2bf((yn + bs * vv) * g[i]);
    }
}

__device__ __forceinline__ void f_resid1(float* ctxs, float* out, const float* __restrict__ mix, const float* __restrict__ g_post, const float* __restrict__ g_pre2,
                         const float* __restrict__ modl, const float* __restrict__ router, bf16_t* h2, float* aff, int vb) {
    const int TID = ltid();
    int r = vb * 4 + (TID >> 6), lane = TID & 63;
    float* x = xrow_ptr(ctxs, out, r);
    const float* m = modl + modrow(r) * 6 * DM;
    float v[16], xv[16]; float ss = 0.f;
#pragma unroll
    for (int j = 0; j < 16; ++j) { v[j] = mix[(size_t)r * DM + lane + 64 * j]; ss += v[j] * v[j]; }
    ss = wave_sum(ss);
    float rstd = rsqrtf(ss * (1.f / DM) + 1e-6f);
    float s2 = 0.f;
#pragma unroll
    for (int j = 0; j < 16; ++j) { int cidx = lane + 64 * j; xv[j] = x[cidx] + m[2048 + cidx] * (v[j] * rstd * g_post[cidx]); x[cidx] = xv[j]; s2 += xv[j] * xv[j]; }
    s2 = wave_sum(s2);
    float rstd2 = rsqrtf(s2 * (1.f / DM) + 1e-6f);
    float lg[NE];
#pragma unroll
    for (int e = 0; e < NE; ++e) lg[e] = 0.f;
#pragma unroll
    for (int j = 0; j < 16; ++j) {
        int cidx = lane + 64 * j;
        float hv = xv[j] * rstd2 * g_pre2[cidx] * (1.f + m[4096 + cidx]) + m[3072 + cidx];
        h2[(size_t)r * DM + cidx] = f2bf(hv);
#pragma unroll
        for (int e = 0; e < NE; ++e) lg[e] += hv * router[cidx * NE + e];
    }
    float mxv = -1e30f;
#pragma unroll
    for (int e = 0; e < NE; ++e) { lg[e] = wave_sum(lg[e]); mxv = fmaxf(mxv, lg[e]); }
    float sum = 0.f;
#pragma unroll
    for (int e = 0; e < NE; ++e) { lg[e] = expf(lg[e] - mxv); sum += lg[e]; }
    if (lane < NE) {
        float val = 0.f;
#pragma unroll
        for (int e = 0; e < NE; ++e) if (e == lane) val = lg[e];
        aff[(size_t)r * NE + lane] = val / sum;
    }
}

__device__ __forceinline__ void f_topk(const float* __restrict__ aff, int* sel_lat, int* sel_ctx, int* slot, int vb, float* lds) {
    const int TID = ltid();
    unsigned* vals = (unsigned*)lds;
    unsigned* hist = (unsigned*)lds + 8192 + 256;
    unsigned* sc = hist + 256;
    unsigned* ctl = sc + 512;
    const int set = vb >> 5, b = (vb >> 4) & 1, e = vb & 15;
    const int n = set == 0 ? TL : CL, cap = set == 0 ? CAPL : CAPC;
    const int per = n >> 8;
    const int rbase = b * SS + (set == 0 ? CL : 0);
    __syncthreads();
    for (int t = TID; t < n; t += 256) vals[t + (t >> 5)] = __float_as_uint(aff[(size_t)(rbase + t) * NE + e]);
    if (TID == 0) { ctl[0] = 0u; ctl[1] = (unsigned)cap; }
    __syncthreads();
    for (int pass = 0; pass < 4; ++pass) {
        const int shift = 24 - 8 * pass;
        hist[TID] = 0u;
        __syncthreads();
        const unsigned prefix = ctl[0];
        const unsigned pmask = pass == 0 ? 0u : (0xffffffffu << (shift + 8));
        for (int j = 0; j < per; ++j) {
            const int t = TID * per + j;
            const unsigned v = vals[t + (t >> 5)];
            if ((v & pmask) == prefix) atomicAdd(&hist[(v >> shift) & 255u], 1u);
        }
        __syncthreads();
        if (TID == 0) {
            unsigned rem = ctl[1], d = 255u;
            for (;; --d) { const unsigned hc = hist[d]; if (hc >= rem || d == 0u) break; rem -= hc; }
            ctl[0] = prefix | (d << shift); ctl[1] = rem;
        }
        __syncthreads();
    }
    const unsigned thr = ctl[0], need_eq = ctl[1];
    unsigned cg = 0u, ce = 0u;
    for (int j = 0; j < per; ++j) { const int t = TID * per + j; const unsigned v = vals[t + (t >> 5)]; cg += v > thr ? 1u : 0u; ce += v == thr ? 1u : 0u; }
    sc[TID] = ce; __syncthreads();
    for (int o = 1; o < 256; o <<= 1) { const unsigned add = TID >= o ? sc[TID - o] : 0u; __syncthreads(); sc[TID] += add; __syncthreads(); }
    const unsigned eq_before = sc[TID] - ce;
    const unsigned eq_take = eq_before >= need_eq ? 0u : (need_eq - eq_before < ce ? need_eq - eq_before : ce);
    const unsigned csel = cg + eq_take;
    sc[256 + TID] = csel; __syncthreads();
    for (int o = 1; o < 256; o <<= 1) { const unsigned add = TID >= o ? sc[256 + TID - o] : 0u; __syncthreads(); sc[256 + TID] += add; __syncthreads(); }
    unsigned pos = sc[256 + TID] - csel;
    unsigned eq_seen = eq_before;
    for (int j = 0; j < per; ++j) {
        const int t = TID * per + j; const unsigned v = vals[t + (t >> 5)];
        bool take = v > thr;
        if (v == thr) { take = eq_seen < need_eq; ++eq_seen; }
        int sl = -1;
        if (take) { sl = (int)pos; ++pos; if (set == 0) sel_lat[(b * NE + e) * CAPL + sl] = rbase + t; else sel_ctx[(b * NE + e) * CAPC + sl] = rbase + t; }
        slot[(size_t)e * RR + rbase + t] = sl;
    }
}

__device__ __forceinline__ void f_resid2(float* ctxs, float* out, const bf16_t* __restrict__ ye_lat, const bf16_t* __restrict__ ye_ctx, const int* __restrict__ slot,
                         const float* __restrict__ g_post, const float* __restrict__ modl, int vb) {
    const int TID = ltid();
    int r = vb * 4 + (TID >> 6), lane = TID & 63;
    float* x = xrow_ptr(ctxs, out, r);
    const float* m = modl + modrow(r) * 6 * DM;
    int b = r / SS, s = r % SS;
    float y[16];
#pragma unroll
    for (int j = 0; j < 16; ++j) y[j] = 0.f;
    for (int e = 0; e < NE; ++e) {
        int sl = slot[(size_t)e * RR + r];
        if (sl < 0) continue;
        const bf16_t* src = s < CL ? ye_ctx + ((size_t)(b * NE + e) * CAPC + sl) * DM : ye_lat + ((size_t)(b * NE + e) * CAPL + sl) * DM;
#pragma unroll
        for (int j = 0; j < 16; ++j) y[j] += bf2f(src[lane + 64 * j]);
    }
    float ss = 0.f;
#pragma unroll
    for (int j = 0; j < 16; ++j) ss += y[j] * y[j];
    ss = wave_sum(ss);
    float rstd = rsqrtf(ss * (1.f / DM) + 1e-6f);
#pragma unroll
    for (int j = 0; j < 16; ++j) { int cidx = lane + 64 * j; x[cidx] += m[5120 + cidx] * (y[j] * rstd * g_post[cidx]); }
}


#define XB_TMO      128
#define XB_XCNT(j)  (256  + 64 * (j))
#define XB_XSUB(j)  (1280 + 64 * (j))
#define XB_XGEN(j)  (2304 + 64 * (j))
#define XB_TOP      3328
#define XB_TOPGEN   3392
#define XCD_BAR_WORDS 3456
#define XB_SPIN_CAP (1u << 18)
__device__ __forceinline__ unsigned xb_ld(unsigned* p)              { return __hip_atomic_load(p, __ATOMIC_RELAXED, __HIP_MEMORY_SCOPE_AGENT); }
__device__ __forceinline__ unsigned xb_add(unsigned* p, unsigned v) { return __hip_atomic_fetch_add(p, v, __ATOMIC_RELAXED, __HIP_MEMORY_SCOPE_AGENT); }
__device__ __forceinline__ unsigned xb_xcc_id() { return (unsigned)__builtin_amdgcn_s_getreg((3 << 11) | 20) & 0xFu; }
#define XB_SPIN(cond, bar) do { unsigned _sp = 0; while (cond) { __builtin_amdgcn_s_sleep(1); \
    if ((++_sp & 255u) == 0u) { if (xb_ld(&(bar)[XB_TMO])) break; if (_sp > XB_SPIN_CAP) { atomicAdd(&(bar)[XB_TMO], 1u); break; } } } } while (0)
__device__ __forceinline__ void xcd_barrier_complete(unsigned* bar, unsigned x, unsigned& nloc, unsigned& nx) {
    const unsigned G = gridDim.x * gridDim.y * gridDim.z;
    unsigned sum, cntx, mine, sp = 0u;
    for (;;) {
        sum = 0u; cntx = 0u; mine = 0u;
#pragma unroll
        for (unsigned j = 0; j < 16; ++j) { const unsigned c = xb_ld(&bar[XB_XCNT(j)]); sum += c; cntx += (c > 0u) ? 1u : 0u; mine = (j == x) ? c : mine; }
        if (sum == G) break;
        __builtin_amdgcn_s_sleep(1);
        if ((++sp & 255u) == 0u) { if (xb_ld(&bar[XB_TMO])) break; if (sp > XB_SPIN_CAP) { atomicAdd(&bar[XB_TMO], 1u); break; } }
    }
    nloc = mine > 0u ? mine : 1u; nx = cntx > 0u ? cntx : 1u;
}
__device__ __forceinline__ void xcd_barrier(unsigned* bar, volatile unsigned* st) {
    asm volatile("s_waitcnt vmcnt(0)" ::: "memory");
    __syncthreads();
    if (threadIdx.x == 0) {
        __builtin_amdgcn_s_waitcnt(0);
        const unsigned x = st[2];
        unsigned nloc = st[0], nx = st[1];
        if (nloc == 0u) { xcd_barrier_complete(bar, x, nloc, nx); st[0] = nloc; st[1] = nx; }
        const unsigned old = xb_add(&bar[XB_XSUB(x)], 1u);
        const unsigned gen = old / nloc;
        if (old + 1u == (gen + 1u) * nloc) {
            __builtin_amdgcn_fence(__ATOMIC_RELEASE, "agent");
            asm volatile("s_waitcnt vmcnt(0)" ::: "memory");
            const unsigned og = xb_add(&bar[XB_TOP], 1u);
            const unsigned tg = og / nx;
            if (og + 1u == (tg + 1u) * nx) xb_add(&bar[XB_TOPGEN], 1u);
            else XB_SPIN(xb_ld(&bar[XB_TOPGEN]) == tg, bar);
            __builtin_amdgcn_fence(__ATOMIC_ACQUIRE, "agent");
            xb_add(&bar[XB_XGEN(x)], 1u);
            asm volatile("s_waitcnt vmcnt(0)" ::: "memory");
        } else {
            XB_SPIN(xb_ld(&bar[XB_XGEN(x)]) == gen, bar);
            __builtin_amdgcn_fence(__ATOMIC_ACQUIRE, "agent");
            asm volatile("s_waitcnt vmcnt(0)" ::: "memory");
        }
    }
    __syncthreads();
}
#ifndef CHUNKREP
#define CHUNKREP 1
#endif
#ifndef REPMASK
#define REPMASK 0
#endif
#define REPS(k) for (int rep_ = 0; rep_ < (((REPMASK) >> (k)) & 1) + 1; ++rep_)
struct MP { const float* in[30]; float* out; char* ws; };
enum { I_X = 0, I_C, I_CTX, I_CCTX, I_WMOD, I_BMOD, I_NPRE, I_NPOST, I_WIN, I_WOUT, I_LAM, I_DAN, I_GCONV, I_GALOG, I_GDT, I_GNORM,
       I_W0, I_WUP, I_A0, I_AUP, I_GUP, I_KK, I_KA, I_RK, I_GNW, I_GNB, I_ROUTER, I_MGATE, I_MUP, I_MDOWN };
constexpr int PB_NPRE = 0, PB_NPOST = PB_NPRE + 4096, PB_LAM = PB_NPOST + 4096, PB_DAN = PB_LAM + 512, PB_GCONV = PB_DAN + 256, PB_GALOG = PB_GCONV + 7680,
              PB_GDT = PB_GALOG + 16, PB_GNORM = PB_GDT + 16, PB_W0 = PB_GNORM + 128, PB_WUP = PB_W0 + 1024, PB_A0 = PB_WUP + 32768, PB_AUP = PB_A0 + 1024,
              PB_GUP = PB_AUP + 32768, PB_KK = PB_GUP + 32768, PB_KA = PB_KK + 512, PB_RK = PB_KA + 512, PB_GNW = PB_RK + 512, PB_GNB = PB_GNW + 512,
              PB_ROUTER = PB_GNB + 512, PB_END = PB_ROUTER + 32768;
constexpr size_t al256c(size_t x) { return (x + 255) & ~(size_t)255; }
constexpr size_t WS_BAR = 0, WS_CNT = 16384, WS_PRM = 16384 + 256, WS_MOD = al256c(WS_PRM + (size_t)PB_END * 4), WS_CTXS = al256c(WS_MOD + (size_t)2 * 3 * 6 * DM * 4),
                 WS_AFF = al256c(WS_CTXS + (size_t)NB * CL * DM * 4), WS_TAB = al256c(WS_AFF + (size_t)RR * NE * 4), WS_SLOT = al256c(WS_TAB + (size_t)128 * 16 * 8),
                 WS_SELL = al256c(WS_SLOT + (size_t)NE * RR * 4), WS_SELC = al256c(WS_SELL + (size_t)32 * CAPL * 4), WS_WTIN = al256c(WS_SELC + (size_t)32 * CAPC * 4),
                 WS_WTOUT = al256c(WS_WTIN + (size_t)2 * DINP * DM * 2), WS_BUFA = al256c(WS_WTOUT + (size_t)2 * DM * DM * 2), WS_SO = al256c(WS_BUFA + (size_t)RR * DM * 2),
                 WS_P = al256c(WS_SO + (size_t)2 * RR * 512 * 2), WS_R3 = al256c(WS_P + (size_t)RR * DINP * 2), WS_VT = al256c(WS_R3 + (size_t)RR * 6208),
                 WS_XC = al256c(WS_VT + (size_t)NB * 4 * 128 * SS * 2), WS_END = al256c(WS_XC + (size_t)32 * 132 * 16384 * 2);

__device__ __forceinline__ char* lptr(char* p) { asm volatile("" : "+s"(p)); return p; }
#define PHASE char* const W = lptr(a.ws); float* const out = (float*)lptr((char*)a.out); (void)W; (void)out;
#define bar ((unsigned*)(W + WS_BAR))
#define cnt ((int*)(W + WS_CNT))
#define prm ((float*)(W + WS_PRM))
#define mod ((float*)(W + WS_MOD))
#define ctxs ((float*)(W + WS_CTXS))
#define aff ((float*)(W + WS_AFF))
#define tab ((float2*)(W + WS_TAB))
#define slot ((int*)(W + WS_SLOT))
#define sel_lat ((int*)(W + WS_SELL))
#define sel_ctx ((int*)(W + WS_SELC))
#define wt_in ((bf16_t*)(W + WS_WTIN))
#define wt_out ((bf16_t*)(W + WS_WTOUT))
#define bufA ((bf16_t*)(W + WS_BUFA))
#define so ((bf16_t*)(W + WS_SO))
#define P ((bf16_t*)(W + WS_P))
#define R3 ((bf16_t*)(W + WS_R3))
#define VT ((bf16_t*)(W + WS_VT))
#define XC ((bf16_t*)(W + WS_XC))
#define gq R3
#define gk (R3 + (size_t)RR * 256)
#define gv (R3 + (size_t)RR * 512)
#define kk_b (R3 + (size_t)RR * 768)
#define kka_b (R3 + (size_t)RR * 1024)
#define kd_b (R3 + (size_t)RR * 1536)
#define w_b ((float*)(R3 + (size_t)RR * 2048))
#define gab (w_b + (size_t)RR * 512)
#define mix ((float*)R3)
#define ye_lat R3
#define ye_ctx (R3 + (size_t)32 * CAPL * DM)
#define hid_lat P
#define hid_ctx (P + (size_t)32 * CAPL * DM)
#define h bufA
#define cat bufA
#define h2 bufA
#define wt_gu XC
#define wt_dn (XC + (size_t)NE * 2 * DM * DM)
#define modl (mod + (size_t)i * 3 * 6 * DM)
#define GBAR { PHASE xcd_barrier(bar, (volatile unsigned*)(lds + 18432 + 132)); }

__global__ __launch_bounds__(256, 2) void mega(MP a) {
    __shared__ __attribute__((aligned(16))) float lds[18432 + 256];
    cg::grid_group grid = cg::this_grid();
    const int nb = gridDim.x, bid = blockIdx.x;
    if (threadIdx.x == 0) {
        volatile unsigned* st = (volatile unsigned*)(lds + 18432 + 132);
        st[0] = 0u; st[1] = 0u; st[2] = xb_xcc_id();
        (void)xb_add(&((unsigned*)(a.ws + WS_BAR))[XB_XCNT(st[2])], 1u);
    }
    __syncthreads();

    {
    PHASE
    if (bid == 0 && threadIdx.x < 4) cnt[threadIdx.x] = 0;
    {
        const int gt = lsgpr(bid) * 256 + ltid(), gn = nb * 256;
#define CPY(idx, off, n) for (int q_ = gt; q_ < (n); q_ += gn) prm[(off) + q_] = a.in[idx][q_];
        CPY(I_NPRE, PB_NPRE, 4096) CPY(I_NPOST, PB_NPOST, 4096) CPY(I_LAM, PB_LAM, 512) CPY(I_DAN, PB_DAN, 256) CPY(I_GCONV, PB_GCONV, 7680) CPY(I_GALOG, PB_GALOG, 16)
        CPY(I_GDT, PB_GDT, 16) CPY(I_GNORM, PB_GNORM, 128) CPY(I_W0, PB_W0, 1024) CPY(I_WUP, PB_WUP, 32768) CPY(I_A0, PB_A0, 1024) CPY(I_AUP, PB_AUP, 32768)
        CPY(I_GUP, PB_GUP, 32768) CPY(I_KK, PB_KK, 512) CPY(I_KA, PB_KA, 512) CPY(I_RK, PB_RK, 512) CPY(I_GNW, PB_GNW, 512) CPY(I_GNB, PB_GNB, 512) CPY(I_ROUTER, PB_ROUTER, 32768)
#undef CPY
    }
    REPS(0) {
    f_init(a.in[I_X], a.in[I_CTX], out, ctxs, lsgpr(bid), nb);
    for (int vb = lsgpr(bid); vb < 384; vb += nb) f_mod1(a.in[I_C], a.in[I_CCTX], a.in[I_WMOD], (float*)XC, vb, lds);
    for (int i = lsgpr(bid) * 256 + ltid(); i < 128 * 16; i += nb * 256) {
        int pos = i >> 4, f = i & 15;
        float ang = (float)pos * powf(10000.f, -(float)f / 16.f);
        tab[i] = make_float2(cosf(ang), sinf(ang));
    }
    {
        const int T_IN = 2 * 16 * 56, T_OUT = 2 * 16 * 16;
        for (int vb = lsgpr(bid); vb < T_IN + T_OUT; vb += nb) {
            int t = vb;
            if (t < T_IN) { int l = t / (16 * 56), q = t % (16 * 56); f_wconv(a.in[I_WIN] + (size_t)l * DM * DIN, DIN, wt_in + (size_t)l * DINP * DM, 0, q / 56, q % 56, lds); continue; }
            t -= T_IN;
            { int l = t / 256, q = t % 256; f_wconv(a.in[I_WOUT] + (size_t)l * DM * DM, DM, wt_out + (size_t)l * DM * DM, 0, q / 16, q % 16, lds); }
        }
    }
    }
    }
    grid.sync();
    { PHASE for (int vb = lsgpr(bid); vb < (2 * 3 * 6 * DM) / 256; vb += nb) f_mod2((const float*)XC, a.in[I_BMOD], mod, vb); }
    GBAR

    _Pragma("unroll") for (int i = 0; i < 2; ++i) {
        const float lam_init = 0.8f - 0.6f * expf(-0.3f * (float)i);
        { PHASE
        REPS(1) for (int vb = lsgpr(bid); vb < RR / 4; vb += nb) f_normmod(ctxs, out, (prm + PB_NPRE) + (size_t)(i * 2 + 0) * DM, modl, 0, 1024, h, vb);
        }
        GBAR
        { PHASE
        REPS(2) for (int vb = lsgpr(bid); vb < 132 * 28; vb += nb) {
            const int mt = vb / 28, nt = vb % 28;
            RowDense ap{h + (size_t)mt * 128 * DM, DM}; RowDense bp{wt_in + (size_t)i * DINP * DM + (size_t)nt * 128 * DM, DM};
            EpiInProj ep{P, VT, tab, mt * 128, nt * 128};
            gemm128(ap, bp, DM, ep, (char*)lds);
        }
        }
        GBAR
        { PHASE
        REPS(3) for (int vb = lsgpr(bid); vb < RR / 8; vb += nb) f_gdn_prep(P, (prm + PB_GCONV) + (size_t)i * 5 * 768, (prm + PB_GALOG) + i * 8, (prm + PB_GDT) + i * 8, gq, gk, gv, gab, vb);
        REPS(4) for (int vb = lsgpr(bid); vb < RR / 8; vb += nb) f_rwkv_prep(P, (prm + PB_W0) + i * 512, (prm + PB_WUP) + (size_t)i * 2 * 32 * 256, (prm + PB_A0) + i * 512, (prm + PB_AUP) + (size_t)i * 2 * 32 * 256,
                                                           (prm + PB_KK) + i * 256, (prm + PB_KA) + i * 256, kk_b, w_b, kka_b, kd_b, vb, lds);
        }
        GBAR
        { PHASE
        for (int vb_ = lsgpr(bid); vb_ < 32 * 132 * CHUNKREP; vb_ += nb) {
            const int vb = vb_ % (32 * 132);
            const int mc = vb / 132, n = vb % 132;
            if (mc < 16) f_chunk_gdn(gq, gk, gv, gab, XC, mc, n, (char*)lds);
            else f_chunk_rwkv(P, kk_b, w_b, kka_b, kd_b, XC, mc - 16, n, (char*)lds);
        }
        }
        GBAR
        { PHASE
        REPS(6) if (lsgpr(bid) < 32) f_scan2(XC, so, bid);
        REPS(7) {
            const int nunits = i == 0 ? 1056 : 1024;
            int* sidx = (int*)(lds + 18432 + 128);
            for (;;) {
                __syncthreads();
                if (threadIdx.x == 0) *sidx = atomicAdd(cnt + i + 2 * rep_, 1);
                __syncthreads();
                const int u = *sidx;
                if (u >= nunits) break;
                int ubh, uqb;
                if (u < 1024) { ubh = u >> 7; uqb = 4 + (u & 127); } else { ubh = (u - 1024) >> 2; uqb = (u - 1024) & 3; }
                f_attn(P, VT, (prm + PB_LAM) + (size_t)i * 256, (prm + PB_DAN) + (size_t)i * 128, lam_init, cat, ubh, uqb, (char*)lds);
            }
        }
        }
        GBAR
        { PHASE
        REPS(8) for (int vb = lsgpr(bid); vb < RR / 8; vb += nb) f_mix_out(P, cat, so, (prm + PB_GNORM) + i * 64, kd_b, (prm + PB_GUP) + (size_t)i * 64 * 256, (prm + PB_RK) + i * 256, (prm + PB_GNW) + i * 256, (prm + PB_GNB) + i * 256, vb, lds);
        REPS(9) for (int vb = lsgpr(bid); vb < 3 * 4096; vb += nb) {
            const int which = vb / 4096, q = vb % 4096, e = q / 256, qq = q % 256;
            const size_t le = (size_t)(i * NE + e);
            if (which == 0) f_wconv(a.in[I_MGATE] + le * DM * DM, DM, wt_gu + (size_t)e * 2 * DM * DM, 1, qq / 16, qq % 16, lds);
            else if (which == 1) f_wconv(a.in[I_MUP] + le * DM * DM, DM, wt_gu + (size_t)e * 2 * DM * DM, 2, qq / 16, qq % 16, lds);
            else f_wconv(a.in[I_MDOWN] + le * DM * DM, DM, wt_dn + (size_t)e * DM * DM, 0, qq / 16, qq % 16, lds);
        }
        }
        GBAR
        { PHASE
        REPS(10) for (int vb = lsgpr(bid); vb < 132 * 8; vb += nb) {
            const int mt = vb / 8, nt = vb % 8;
            RowDense ap{cat + (size_t)mt * 128 * DM, DM}; RowDense bp{wt_out + (size_t)i * DM * DM + (size_t)nt * 128 * DM, DM};
            EpiF32 ep{mix, DM, mt * 128, nt * 128};
            gemm128(ap, bp, DM, ep, (char*)lds);
        }
        }
        GBAR
        { PHASE
        for (int vb = lsgpr(bid); vb < RR / 4; vb += nb) f_resid1(ctxs, out, mix, (prm + PB_NPOST) + (size_t)(i * 2 + 0) * DM, (prm + PB_NPRE) + (size_t)(i * 2 + 1) * DM, modl, (prm + PB_ROUTER) + (size_t)i * DM * NE, h2, aff, vb);
        }
        GBAR
        { PHASE
        REPS(11) for (int vb = lsgpr(bid); vb < 64; vb += nb) f_topk(aff, sel_lat, sel_ctx, slot, vb, lds);
        }
        GBAR
        { PHASE
        REPS(12) for (int vb = lsgpr(bid); vb < 32 * 8 * 16 + 32 * 16; vb += nb) {
            int g, mt, nt, cap; const int* sel; bf16_t* hid;
            if (vb < 32 * 8 * 16) { g = vb / 128; mt = (vb % 128) / 16; nt = vb % 16; cap = CAPL; sel = sel_lat + g * CAPL; hid = hid_lat + (size_t)g * CAPL * DM; }
            else { int t = vb - 32 * 8 * 16; g = t / 16; mt = 0; nt = t % 16; cap = CAPC; sel = sel_ctx + g * CAPC; hid = hid_ctx + (size_t)g * CAPC * DM; }
            const int e = g % NE;
            RowGather ap{h2, sel + mt * 128, cap - mt * 128}; RowDense bp{wt_gu + ((size_t)e * 2 * DM + (size_t)nt * 128) * DM, DM};
            EpiMoE1 ep{hid, mt * 128, nt * 128, cap};
            gemm128(ap, bp, DM, ep, (char*)lds);
        }
        }
        GBAR
        { PHASE
        REPS(13) for (int vb = lsgpr(bid); vb < 32 * 8 * 8 + 32 * 8; vb += nb) {
            int g, mt, nt, cap; const int* sel; const bf16_t* hid; bf16_t* ye;
            if (vb < 32 * 8 * 8) { g = vb / 64; mt = (vb % 64) / 8; nt = vb % 8; cap = CAPL; sel = sel_lat + g * CAPL; hid = hid_lat + (size_t)g * CAPL * DM; ye = ye_lat + (size_t)g * CAPL * DM; }
            else { int t = vb - 32 * 8 * 8; g = t / 8; mt = 0; nt = t % 8; cap = CAPC; sel = sel_ctx + g * CAPC; hid = hid_ctx + (size_t)g * CAPC * DM; ye = ye_ctx + (size_t)g * CAPC * DM; }
            const int e = g % NE;
            RowDense ap{hid + (size_t)mt * 128 * DM, DM}; RowDense bp{wt_dn + ((size_t)e * DM + (size_t)nt * 128) * DM, DM};
            EpiMoE2 ep{ye, aff, sel, e, mt * 128, nt * 128, cap};
            gemm128(ap, bp, DM, ep, (char*)lds);
        }
        }
        GBAR
        { PHASE
        for (int vb = lsgpr(bid); vb < RR / 4; vb += nb) f_resid2(ctxs, out, ye_lat, ye_ctx, slot, (prm + PB_NPOST) + (size_t)(i * 2 + 1) * DM, modl, vb);
        }
        GBAR
    }
}

#undef bar
#undef cnt
#undef prm
#undef mod
#undef ctxs
#undef aff
#undef tab
#undef slot
#undef sel_lat
#undef sel_ctx
#undef wt_in
#undef wt_out
#undef bufA
#undef so
#undef P
#undef R3
#undef VT
#undef XC
#undef gq
#undef gk
#undef gv
#undef kk_b
#undef kka_b
#undef kd_b
#undef w_b
#undef gab
#undef mix
#undef ye_lat
#undef ye_ctx
#undef hid_lat
#undef hid_ctx
#undef h
#undef cat
#undef h2
#undef wt_gu
#undef wt_dn
#undef modl
extern "C" void kernel_launch(void* const* d_in, const int* in_sizes, int n_in, void* d_out, int out_size, void* d_ws, size_t ws_size, hipStream_t stream) {
    static int grid_blocks = 0;
    if (!grid_blocks) {
        int dev = 0, cus = 0, per_cu = 0;
        (void)hipGetDevice(&dev);
        (void)hipDeviceGetAttribute(&cus, hipDeviceAttributeMultiprocessorCount, dev);
        (void)hipOccupancyMaxActiveBlocksPerMultiprocessor(&per_cu, mega, 256, 0);
        if (per_cu < 1) per_cu = 1;
        if (per_cu > 2) per_cu = 2;
        grid_blocks = cus * per_cu;
    }
    if (WS_END > ws_size) { fprintf(stderr, "workspace too small: need %zu have %zu\n", (size_t)WS_END, ws_size); return; }
    MP a{};
    for (int i = 0; i < 30; ++i) a.in[i] = (const float*)d_in[i];
    a.out = (float*)d_out; a.ws = (char*)d_ws;
    (void)hipMemsetAsync((char*)d_ws + WS_BAR, 0, 16384 + 256, stream);
    void* args[] = {&a};
    hipError_t e = hipLaunchCooperativeKernel((void*)mega, dim3(grid_blocks), dim3(256), args, 0, stream);
    if (e != hipSuccess) fprintf(stderr, "cooperative launch failed: %s (grid %d)\n", hipGetErrorString(e), grid_blocks);
}
```

```cpp
#include <hip/hip_runtime.h>
#include <stdint.h>
#include <stdio.h>
#include <hip/hip_cooperative_groups.h>
namespace cg = cooperative_groups;

#define NB 2
#define TL 8192
#define CL 256
#define SS 8448
#define RR 16896
#define DM 1024
#define DIN 3472
#define DINP 3584
#define NE 16
#define CAPL 1024
#define CAPC 32
#define OQ 0
#define OKK 512
#define OV 1024
#define OGQKV 1536
#define OGGATE 2304
#define OGA 2560
#define OGB 2568
#define ORKV 2576
#define OXW 3344
#define OXA 3376
#define OXG 3408

typedef unsigned short bf16_t;
typedef short bf16x8 __attribute__((ext_vector_type(8)));
typedef float f32x4 __attribute__((ext_vector_type(4)));
typedef unsigned u32x4 __attribute__((ext_vector_type(4)));
typedef unsigned u32x2 __attribute__((ext_vector_type(2)));
typedef float f32x16 __attribute__((ext_vector_type(16)));
#define MFMA32(a, b, c) __builtin_amdgcn_mfma_f32_32x32x16_bf16((a), (b), (c), 0, 0, 0)
__device__ __forceinline__ int crow(int r, int h) { return (r & 3) + 8 * (r >> 2) + 4 * h; }

#define LAUNDER(x) asm volatile("" : "+v"(x))
__device__ __forceinline__ int lsgpr(int x) { asm volatile("" : "+s"(x)); return x; }
__device__ __forceinline__ int ltid() { int t = threadIdx.x; LAUNDER(t); return t; }
__device__ __forceinline__ float siluf(float x) { return x / (1.f + expf(-x)); }
__device__ __forceinline__ float sigmf(float x) { return 1.f / (1.f + expf(-x)); }
__device__ __forceinline__ float wave_sum(float v) {
#pragma unroll
    for (int o = 1; o < 64; o <<= 1) v += __shfl_xor(v, o);
    return v;
}
__device__ __forceinline__ unsigned pk2bf(float lo, float hi) {
    typedef float f2 __attribute__((ext_vector_type(2))); typedef __bf16 b2 __attribute__((ext_vector_type(2)));
    f2 v = {lo, hi}; b2 b = __builtin_convertvector(v, b2); return __builtin_bit_cast(unsigned, b);
}
__device__ __forceinline__ bf16_t f2bf(float f) { return (bf16_t)(pk2bf(f, 0.f) & 0xffffu); }
__device__ __forceinline__ float bf2f(bf16_t u) { return __uint_as_float(((unsigned)u) << 16); }
__device__ __forceinline__ float* xrow_ptr(float* ctxs, float* out, int r) {
    int b = r >= SS ? 1 : 0, s = r - b * SS;
    return s < CL ? ctxs + ((size_t)(b * CL + s)) * DM : out + ((size_t)(b * TL + (s - CL))) * DM;
}
__device__ __forceinline__ int modrow(int r) { int b = r >= SS ? 1 : 0, s = r - b * SS; return s < CL ? 2 : b; }

__device__ __forceinline__ void f_init(const float* __restrict__ x, const float* __restrict__ ctx, float* out, float* ctxs, int vb, int nvb) {
    const int TID = ltid();
    size_t i = (size_t)vb * 256 + TID;
    size_t n1 = (size_t)NB * TL * DM / 4, n2 = (size_t)NB * CL * DM / 4;
    for (size_t j = i; j < n1; j += (size_t)nvb * 256) ((float4*)out)[j] = ((const float4*)x)[j];
    for (size_t j = i; j < n2; j += (size_t)nvb * 256) ((float4*)ctxs)[j] = ((const float4*)ctx)[j];
}

__device__ __forceinline__ void f_mod1(const float* __restrict__ c, const float* __restrict__ c_ctx, const float* __restrict__ w_mod, float* modp, int item, float* lds) {
    const int TID = ltid();
    float* cs = lds;
    const int kc = item & 31, cb = (item >> 5) % 6, l = item / 192;
    __syncthreads();
    if (TID < 96) { const int k = TID & 31, j = TID >> 5; const float v = j == 0 ? c[kc * 32 + k] : (j == 1 ? c[DM + kc * 32 + k] : c_ctx[kc * 32 + k]); cs[k * 4 + j] = siluf(v); }
    __syncthreads();
    const float* w = w_mod + ((size_t)l * DM + kc * 32) * 6 * DM + cb * 1024 + 4 * TID;
    f32x4 a0 = (f32x4){0.f, 0.f, 0.f, 0.f}, a1 = a0, a2 = a0;
#pragma unroll 8
    for (int k = 0; k < 32; ++k) {
        const f32x4 wv = *(const f32x4*)(w + (size_t)k * 6 * DM);
        const f32x4 cv = *(const f32x4*)(cs + k * 4);
        a0 += wv * cv[0]; a1 += wv * cv[1]; a2 += wv * cv[2];
    }
    float* dst = modp + ((size_t)(kc * 2 + l) * 3) * 6 * DM + cb * 1024 + 4 * TID;
    *(f32x4*)(dst) = a0; *(f32x4*)(dst + 6 * DM) = a1; *(f32x4*)(dst + 2 * 6 * DM) = a2;
}
__device__ __forceinline__ void f_mod2(const float* __restrict__ modp, const float* __restrict__ b_mod, float* mod, int vb) {
    const int idx = vb * 256 + ltid();
    const int l = idx / (3 * 6 * DM), n = idx % (6 * DM);
    float acc = b_mod[l * 6 * DM + n];
    const int j = (idx / (6 * DM)) % 3;
#pragma unroll 8
    for (int kc = 0; kc < 32; ++kc) acc += modp[((size_t)(kc * 2 + l) * 3 + j) * 6 * DM + n];
    mod[idx] = acc;
}

__device__ __forceinline__ void f_wconv(const float* __restrict__ W, int N, bf16_t* Wt, int rowmap, int kt, int nt, float* lds) {
    const int TID = ltid();
    float (*T)[129] = (float (*)[129])lds;
    const int tid = TID;
    __syncthreads();
    f32x4 v[8];
#pragma unroll
    for (int i = 0; i < 8; ++i) {
        const int k = (tid >> 5) + 8 * i, n4 = (tid & 31) * 4;
        const int gn = nt * 128 + n4;
        v[i] = gn < N ? *(const f32x4*)(W + (size_t)(kt * 64 + k) * N + gn) : (f32x4){0.f, 0.f, 0.f, 0.f};
    }
#pragma unroll
    for (int i = 0; i < 8; ++i) {
        const int k = (tid >> 5) + 8 * i, n4 = (tid & 31) * 4;
        T[k][n4] = v[i][0]; T[k][n4 + 1] = v[i][1]; T[k][n4 + 2] = v[i][2]; T[k][n4 + 3] = v[i][3];
    }
    __syncthreads();
#pragma unroll
    for (int i = 0; i < 4; ++i) {
        const int n = (tid >> 3) + 32 * i, kc = tid & 7;
        const int gn = nt * 128 + n;
        const int drow = rowmap == 0 ? gn : (32 * (gn >> 4) + (gn & 15) + (rowmap == 2 ? 16 : 0));
        u32x4 o;
        o[0] = pk2bf(T[kc * 8 + 0][n], T[kc * 8 + 1][n]); o[1] = pk2bf(T[kc * 8 + 2][n], T[kc * 8 + 3][n]);
        o[2] = pk2bf(T[kc * 8 + 4][n], T[kc * 8 + 5][n]); o[3] = pk2bf(T[kc * 8 + 6][n], T[kc * 8 + 7][n]);
        *(u32x4*)(Wt + (size_t)drow * DM + kt * 64 + kc * 8) = o;
    }
}

__device__ __forceinline__ void f_normmod(float* ctxs, float* out, const float* __restrict__ g, const float* __restrict__ modl, int sh_off, int sc_off, bf16_t* h, int vb) {
    const int TID = ltid();
    int r = vb * 4 + (TID >> 6), lane = TID & 63;
    const float* x = xrow_ptr(ctxs, out, r);
    const float* m = modl + modrow(r) * 6 * DM;
    f32x4 v[4]; float ss = 0.f;
#pragma unroll
    for (int j = 0; j < 4; ++j) { v[j] = *(const f32x4*)(x + 4 * lane + 256 * j); ss += v[j][0] * v[j][0] + v[j][1] * v[j][1] + v[j][2] * v[j][2] + v[j][3] * v[j][3]; }
    ss = wave_sum(ss);
    float rstd = rsqrtf(ss * (1.f / DM) + 1e-6f);
#pragma unroll
    for (int j = 0; j < 4; ++j) {
        int c0 = 4 * lane + 256 * j;
        f32x4 gg = *(const f32x4*)(g + c0), sc = *(const f32x4*)(m + sc_off + c0), sh = *(const f32x4*)(m + sh_off + c0);
        f32x4 o4 = v[j] * rstd * gg * (1.f + sc) + sh;
        u32x2 o; o[0] = pk2bf(o4[0], o4[1]); o[1] = pk2bf(o4[2], o4[3]);
        *(u32x2*)(h + (size_t)r * DM + c0) = o;
    }
}

#define LDS_AS __attribute__((address_space(3)))
template <class AP, class BP, class Epi>
__device__ __forceinline__ void gemm128(const AP& aptr, const BP& bptr, int K, const Epi& epi, char* lds) {
    const int TID = ltid();
    const int tid = TID, lane = tid & 63, wid = __builtin_amdgcn_readfirstlane(tid >> 6), wr = wid >> 1, wc = wid & 1, fr = lane & 15, fq = lane >> 4;
    const bf16_t* ag[4]; const bf16_t* bg[4];
#pragma unroll
    for (int i = 0; i < 4; ++i) {
        const int row = 8 * (4 * i + wid) + (lane >> 3), ch = (lane & 7) ^ ((row >> 1) & 7);
        ag[i] = aptr(row) + ch * 8; bg[i] = bptr(row) + ch * 8;
    }
    f32x4 acc[4][4];
#pragma unroll
    for (int m = 0; m < 4; ++m)
#pragma unroll
        for (int n = 0; n < 4; ++n) acc[m][n] = (f32x4){0.f, 0.f, 0.f, 0.f};
    LDS_AS char* l3 = (LDS_AS char*)lds;
    __syncthreads();
#pragma unroll
    for (int i = 0; i < 4; ++i) {
        __builtin_amdgcn_global_load_lds((const unsigned*)ag[i], (LDS_AS unsigned*)(l3 + (4 * i + wid) * 1024), 16, 0, 0);
        __builtin_amdgcn_global_load_lds((const unsigned*)bg[i], (LDS_AS unsigned*)(l3 + 16384 + (4 * i + wid) * 1024), 16, 0, 0);
    }
    __syncthreads();
    const int nk = K / 64;
    const int swz = fr >> 1;
    for (int kt = 0; kt < nk; ++kt) {
        const int buf = kt & 1;
        if (kt + 1 < nk) {
#pragma unroll
            for (int i = 0; i < 4; ++i) {
                __builtin_amdgcn_global_load_lds((const unsigned*)(ag[i] + (kt + 1) * 64), (LDS_AS unsigned*)(l3 + (buf ^ 1) * 32768 + (4 * i + wid) * 1024), 16, 0, 0);
                __builtin_amdgcn_global_load_lds((const unsigned*)(bg[i] + (kt + 1) * 64), (LDS_AS unsigned*)(l3 + (buf ^ 1) * 32768 + 16384 + (4 * i + wid) * 1024), 16, 0, 0);
            }
        }
        const char* la = lds + buf * 32768; const char* lb = la + 16384;
#pragma unroll
        for (int ks = 0; ks < 2; ++ks) {
            bf16x8 af[4], bfr[4];
            const int coff = ((ks * 4 + fq) ^ swz) << 4;
#pragma unroll
            for (int m = 0; m < 4; ++m) af[m] = *(const bf16x8*)(la + (wr * 64 + m * 16 + fr) * 128 + coff);
#pragma unroll
            for (int n = 0; n < 4; ++n) bfr[n] = *(const bf16x8*)(lb + (wc * 64 + n * 16 + fr) * 128 + coff);
#pragma unroll
            for (int m = 0; m < 4; ++m)
#pragma unroll
                for (int n = 0; n < 4; ++n) acc[m][n] = __builtin_amdgcn_mfma_f32_16x16x32_bf16(bfr[n], af[m], acc[m][n], 0, 0, 0);
        }
        __syncthreads();
    }
    epi(acc, wr, wc, fr, fq);
}

struct RowDense { const bf16_t* base; size_t ld; __device__ __forceinline__ const bf16_t* operator()(int row) const { return base + (size_t)row * ld; } };
struct RowGather { const bf16_t* base; const int* idx; int maxrow; __device__ __forceinline__ const bf16_t* operator()(int row) const { int r = row < maxrow ? row : maxrow - 1; return base + (size_t)idx[r] * DM; } };

struct EpiInProj {
    bf16_t* P; bf16_t* VT; const float2* tab; int m0, n0;
    __device__ __forceinline__ void operator()(f32x4 (&acc)[4][4], int wr, int wc, int fr, int fq) const {
        const bool rope = n0 < 1024;
        const bool isv = n0 >= OV && n0 < OGQKV;
#pragma unroll
        for (int m = 0; m < 4; ++m) {
            const int r = m0 + wr * 64 + m * 16 + fr;
            const int b = r / SS, s = r % SS;
            if (rope && s >= CL) {
                const int t = s - CL;
#pragma unroll
                for (int ax = 0; ax < 2; ++ax) {
                    const int pos = ax == 0 ? (t >> 6) : (t & 63);
#pragma unroll
                    for (int j = 0; j < 4; ++j) {
                        const float2 cs = tab[pos * 16 + 4 * fq + j];
                        const float x1 = acc[m][2 * ax][j], x2 = acc[m][2 * ax + 1][j];
                        acc[m][2 * ax][j] = x1 * cs.x - x2 * cs.y;
                        acc[m][2 * ax + 1][j] = x2 * cs.x + x1 * cs.y;
                    }
                }
            }
            if (isv) {
                const int u = s & 15;
                const int ps = (s & ~15) | (((u >> 2) & 1) << 3) | ((u >> 3) << 2) | (u & 3);
#pragma unroll
                for (int n = 0; n < 4; ++n)
#pragma unroll
                    for (int j = 0; j < 4; ++j) {
                        const int c = n0 - OV + wc * 64 + n * 16 + 4 * fq + j;
                        VT[((size_t)(b * 4 + (c >> 7)) * 128 + (c & 127)) * SS + ps] = f2bf(acc[m][n][j]);
                    }
            } else {
#pragma unroll
                for (int n = 0; n < 4; ++n) {
                    u32x2 o; o[0] = pk2bf(acc[m][n][0], acc[m][n][1]); o[1] = pk2bf(acc[m][n][2], acc[m][n][3]);
                    *(u32x2*)(P + (size_t)r * DINP + n0 + wc * 64 + n * 16 + 4 * fq) = o;
                }
            }
        }
    }
};
struct EpiF32 {
    float* C; int ldc; int m0, n0;
    __device__ __forceinline__ void operator()(f32x4 (&acc)[4][4], int wr, int wc, int fr, int fq) const {
#pragma unroll
        for (int m = 0; m < 4; ++m)
#pragma unroll
            for (int n = 0; n < 4; ++n) *(f32x4*)(C + (size_t)(m0 + wr * 64 + m * 16 + fr) * ldc + n0 + wc * 64 + n * 16 + 4 * fq) = acc[m][n];
    }
};
struct EpiMoE1 {
    bf16_t* hid; int m0, n0, cap;
    __device__ __forceinline__ void operator()(f32x4 (&acc)[4][4], int wr, int wc, int fr, int fq) const {
#pragma unroll
        for (int m = 0; m < 4; ++m) {
            const int r = m0 + wr * 64 + m * 16 + fr;
            if (r >= cap) continue;
#pragma unroll
            for (int q = 0; q < 2; ++q) {
                float v[4];
#pragma unroll
                for (int j = 0; j < 4; ++j) v[j] = siluf(acc[m][2 * q][j]) * acc[m][2 * q + 1][j];
                u32x2 o; o[0] = pk2bf(v[0], v[1]); o[1] = pk2bf(v[2], v[3]);
                *(u32x2*)(hid + (size_t)r * DM + (n0 >> 1) + wc * 32 + q * 16 + 4 * fq) = o;
            }
        }
    }
};
struct EpiMoE2 {
    bf16_t* ye; const float* aff; const int* sel; int e, m0, n0, cap;
    __device__ __forceinline__ void operator()(f32x4 (&acc)[4][4], int wr, int wc, int fr, int fq) const {
#pragma unroll
        for (int m = 0; m < 4; ++m) {
            const int r = m0 + wr * 64 + m * 16 + fr;
            if (r >= cap) continue;
            const float sc = aff[(size_t)sel[r] * NE + e];
#pragma unroll
            for (int n = 0; n < 4; ++n) {
                u32x2 o; o[0] = pk2bf(acc[m][n][0] * sc, acc[m][n][1] * sc); o[1] = pk2bf(acc[m][n][2] * sc, acc[m][n][3] * sc);
                *(u32x2*)(ye + (size_t)r * DM + n0 + wc * 64 + n * 16 + 4 * fq) = o;
            }
        }
    }
};

#define ATT_WAIT_V(n) asm volatile("s_waitcnt vmcnt(" #n ")" ::: "memory")
#define ATT_WAIT_L0() asm volatile("s_waitcnt lgkmcnt(0)" ::: "memory")
__device__ __forceinline__ void f_attn(const bf16_t* __restrict__ P, const bf16_t* __restrict__ VT, bf16_t* OM, int bh, int map, int qb, char* lds) {
    const int TID = ltid();
    const int lane = TID & 63, wid = TID >> 6, ql = lane & 31, hi = lane >> 5;
    const int b = bh >> 2, h = bh & 3;
    const int row0 = b * SS + qb * 128;
    const int ntiles = (qb < 2 ? CL : SS) / 64;
    const float C = 0.125f * 1.4426950408889634f;
    float* wsf = (float*)(lds + 73728) + wid * 32;
    const int wu = __builtin_amdgcn_readfirstlane(wid);
    const bf16_t* kg[2]; const bf16_t* vg[4];
#pragma unroll
    for (int i = 0; i < 2; ++i) {
        const int krow = 8 * (wu + 4 * i) + (lane >> 3);
        kg[i] = P + (size_t)(b * SS + krow) * DINP + OKK + h * 128 + map * 64 + (((lane & 7) ^ ((krow >> 1) & 7)) << 3);
    }
#pragma unroll
    for (int i = 0; i < 4; ++i) {
        const int vrow = 8 * (wu + 4 * i) + (lane >> 3);
        vg[i] = VT + (size_t)(bh * 128 + vrow) * SS + (((lane & 7) ^ ((vrow >> 1) & 7)) << 3);
    }
    bf16x8 qf[4];
    {
        const bf16_t* qp = P + (size_t)(row0 + wid * 32 + ql) * DINP + OQ + h * 128 + map * 64 + 8 * hi;
#pragma unroll
        for (int d0 = 0; d0 < 4; ++d0) qf[d0] = *(const bf16x8*)(qp + 16 * d0);
    }
    f32x16 O[4];
#pragma unroll
    for (int cb = 0; cb < 4; ++cb)
#pragma unroll
        for (int r = 0; r < 16; ++r) O[cb][r] = 0.f;
    float mrun = -1e30f, lrun = 0.f;
    LDS_AS char* l3 = (LDS_AS char*)lds;
#define ATT_STAGE(t_, st_) do { \
        _Pragma("unroll") for (int i_ = 0; i_ < 2; ++i_) __builtin_amdgcn_global_load_lds((const unsigned*)(kg[i_] + (size_t)(t_) * 64 * DINP), (LDS_AS unsigned*)(l3 + (st_) * 24576 + (wu + 4 * i_) * 1024), 16, 0, 0); \
        _Pragma("unroll") for (int i_ = 0; i_ < 4; ++i_) __builtin_amdgcn_global_load_lds((const unsigned*)(vg[i_] + (t_) * 64), (LDS_AS unsigned*)(l3 + (st_) * 24576 + 8192 + (wu + 4 * i_) * 1024), 16, 0, 0); } while (0)
    ATT_WAIT_V(0); ATT_WAIT_L0();
    __builtin_amdgcn_s_barrier();
    ATT_STAGE(0, 0);
    if (ntiles > 1) ATT_STAGE(1, 1);
    if (ntiles > 1) ATT_WAIT_V(6); else ATT_WAIT_V(0);
    __builtin_amdgcn_s_barrier();
    const int swz = (ql >> 1) & 7;
    int st = 0;
    for (int t = 0; t < ntiles; ++t) {
        const int st2 = st >= 1 ? st - 1 : 2;
        if (t + 2 < ntiles) ATT_STAGE(t + 2, st2);
        const char* kb = lds + st * 24576;
        const char* vb = kb + 8192;
        f32x16 p0, p1;
#pragma unroll
        for (int r = 0; r < 16; ++r) { p0[r] = 0.f; p1[r] = 0.f; }
        {
            bf16x8 kf[8];
#pragma unroll
            for (int d0 = 0; d0 < 4; ++d0) {
                const int co = ((2 * d0 + hi) ^ swz) << 4;
                kf[2 * d0] = *(const bf16x8*)(kb + ql * 128 + co);
                kf[2 * d0 + 1] = *(const bf16x8*)(kb + (32 + ql) * 128 + co);
            }
            __builtin_amdgcn_sched_barrier(0);
#pragma unroll
            for (int d0 = 0; d0 < 4; ++d0) { p0 = MFMA32(kf[2 * d0], qf[d0], p0); p1 = MFMA32(kf[2 * d0 + 1], qf[d0], p1); }
        }
        float tm = fmaxf(p0[0], p1[0]);
#pragma unroll
        for (int r = 1; r < 16; ++r) tm = fmaxf(tm, fmaxf(p0[r], p1[r]));
        { auto rr = __builtin_amdgcn_permlane32_swap(__float_as_uint(tm), __float_as_uint(tm), false, false); tm = fmaxf(__uint_as_float(rr[0]), __uint_as_float(rr[1])); }
        const float mnew = fmaxf(mrun, tm);
        if (__any(mnew > mrun)) {
            const float alpha = __builtin_amdgcn_exp2f((mrun - mnew) * C);
            lrun *= alpha; mrun = mnew;
            if (hi == 0) wsf[ql] = alpha;
            ATT_WAIT_L0();
#pragma unroll
            for (int r = 0; r < 16; ++r) {
                const float f = wsf[crow(r, hi)];
#pragma unroll
                for (int cb = 0; cb < 4; ++cb) O[cb][r] *= f;
            }
        }
        bf16x8 vfa[4], vfb[4];
#pragma unroll
        for (int s = 0; s < 4; ++s) vfa[s] = *(const bf16x8*)(vb + ql * 128 + (((2 * s + hi) ^ swz) << 4));
        const float mc = mrun * C;
        float ls = 0.f;
#pragma unroll
        for (int r = 0; r < 16; ++r) {
            p0[r] = __builtin_amdgcn_exp2f(fmaf(p0[r], C, -mc)); p1[r] = __builtin_amdgcn_exp2f(fmaf(p1[r], C, -mc));
            ls += p0[r] + p1[r];
        }
        lrun += ls;
        bf16x8 pf[4];
#pragma unroll
        for (int s = 0; s < 4; ++s) {
            u32x4 w;
#pragma unroll
            for (int j = 0; j < 4; ++j) w[j] = (s < 2) ? pk2bf(p0[8 * (s & 1) + 2 * j], p0[8 * (s & 1) + 2 * j + 1]) : pk2bf(p1[8 * (s & 1) + 2 * j], p1[8 * (s & 1) + 2 * j + 1]);
            pf[s] = __builtin_bit_cast(bf16x8, w);
        }
        __builtin_amdgcn_sched_barrier(0);
#pragma unroll
        for (int s = 0; s < 4; ++s) vfb[s] = *(const bf16x8*)(vb + (32 + ql) * 128 + (((2 * s + hi) ^ swz) << 4));
#pragma unroll
        for (int s = 0; s < 4; ++s) O[0] = MFMA32(pf[s], vfa[s], O[0]);
        __builtin_amdgcn_sched_barrier(0);
#pragma unroll
        for (int s = 0; s < 4; ++s) vfa[s] = *(const bf16x8*)(vb + (64 + ql) * 128 + (((2 * s + hi) ^ swz) << 4));
#pragma unroll
        for (int s = 0; s < 4; ++s) O[1] = MFMA32(pf[s], vfb[s], O[1]);
        __builtin_amdgcn_sched_barrier(0);
#pragma unroll
        for (int s = 0; s < 4; ++s) vfb[s] = *(const bf16x8*)(vb + (96 + ql) * 128 + (((2 * s + hi) ^ swz) << 4));
#pragma unroll
        for (int s = 0; s < 4; ++s) O[2] = MFMA32(pf[s], vfa[s], O[2]);
        __builtin_amdgcn_sched_barrier(0);
#pragma unroll
        for (int s = 0; s < 4; ++s) O[3] = MFMA32(pf[s], vfb[s], O[3]);
        if (t + 2 < ntiles) ATT_WAIT_V(6); else ATT_WAIT_V(0);
        ATT_WAIT_L0();
        __builtin_amdgcn_s_barrier();
        __builtin_amdgcn_sched_barrier(0);
        st = st == 2 ? 0 : st + 1;
    }
#undef ATT_STAGE
    { auto rr = __builtin_amdgcn_permlane32_swap(__float_as_uint(lrun), __float_as_uint(lrun), false, false); lrun = __uint_as_float(rr[0]) + __uint_as_float(rr[1]); }
    if (hi == 0) wsf[ql] = 1.f / lrun;
    ATT_WAIT_L0();
    bf16_t* dst = OM + ((size_t)map * RR + row0 + wid * 32) * 512 + h * 128 + ql;
#pragma unroll
    for (int r = 0; r < 16; ++r) {
        const int q = crow(r, hi);
        const float f = wsf[q];
#pragma unroll
        for (int cb = 0; cb < 4; ++cb) dst[(size_t)q * 512 + cb * 32] = f2bf(O[cb][r] * f);
    }
}

__device__ __forceinline__ void f_gdn_prep(const bf16_t* __restrict__ p, const float* __restrict__ conv_w, const float* __restrict__ a_log,
                                                  const float* __restrict__ dt_bias, bf16_t* gq, bf16_t* gk, bf16_t* gv, float* gab, int vb) {
    const int TID = ltid();
    const int r0 = vb * 8, c = TID;
    const int b = r0 >= SS ? 1 : 0, s0 = r0 - b * SS;
    const int seg_lo = s0 < CL ? 0 : CL, seg_hi = s0 < CL ? CL : SS;
    float xin[3][12];
#pragma unroll
    for (int t = 0; t < 12; ++t) {
        const int s2 = s0 + t - 2;
        const bool ok = s2 >= seg_lo && s2 < seg_hi;
        const bf16_t* rp = p + (size_t)(b * SS + (ok ? s2 : s0)) * DINP + OGQKV + c;
#pragma unroll
        for (int j3 = 0; j3 < 3; ++j3) { const float v = bf2f(rp[j3 * 256]); xin[j3][t] = ok ? v : 0.f; }
    }
    float cw[3][5];
#pragma unroll
    for (int j3 = 0; j3 < 3; ++j3)
#pragma unroll
        for (int j = 0; j < 5; ++j) cw[j3][j] = conv_w[j * 768 + j3 * 256 + c];
#pragma unroll
    for (int i = 0; i < 8; ++i) {
        float val[3];
#pragma unroll
        for (int j3 = 0; j3 < 3; ++j3) {
            float acc = 0.f;
#pragma unroll
            for (int j = 0; j < 5; ++j) acc += xin[j3][i + j] * cw[j3][j];
            val[j3] = siluf(acc);
        }
        const float sq = wave_sum(val[0] * val[0]);
        const float sk = wave_sum(val[1] * val[1]);
        const size_t r = r0 + i;
        gq[r * 256 + c] = f2bf(val[0] * rsqrtf(sq + 1e-12f) * 0.125f);
        gk[r * 256 + c] = f2bf(val[1] * rsqrtf(sk + 1e-12f));
        gv[r * 256 + c] = f2bf(val[2]);
    }
    if (c < 128) {
        const size_t r = r0 + (c >> 4); const int q = c & 15;
        if (q < 8) {
            const float av = bf2f(p[r * DINP + OGA + q]);
            const float xx = av + dt_bias[q];
            const float sp = xx > 20.f ? xx : log1pf(expf(xx));
            gab[r * 16 + q] = -expf(a_log[q]) * sp;
        } else {
            gab[r * 16 + q] = sigmf(bf2f(p[r * DINP + OGB + (q - 8)]));
        }
    }
}

__device__ __forceinline__ void f_rwkv_prep(const bf16_t* __restrict__ p, const float* __restrict__ w0, const float* __restrict__ w_up,
                                                   const float* __restrict__ a0, const float* __restrict__ a_up, const float* __restrict__ k_k,
                                                   const float* __restrict__ k_a, bf16_t* kk_o, float* w_o, bf16_t* kka_o, bf16_t* kd_o, int vb, float* lds) {
    const int TID = ltid();
    float* xwT = lds;
    float* xaT = lds + 256;
    __syncthreads();
    const int r0 = vb * 8, c = TID;
    {
        const int i = TID >> 5, j = TID & 31;
        const bf16_t* pr = p + (size_t)(r0 + i) * DINP;
        xwT[j * 8 + i] = tanhf(bf2f(pr[OXW + j]));
        xaT[j * 8 + i] = bf2f(pr[OXA + j]);
    }
    float k[8], kk[8];
    const float kkc = k_k[c], kac = k_a[c];
#pragma unroll
    for (int i = 0; i < 8; ++i) k[i] = bf2f(p[(size_t)(r0 + i) * DINP + ORKV + 256 + c]);
#pragma unroll
    for (int i = 0; i < 8; ++i) {
        const float kq = k[i] * kkc;
        const float ss = wave_sum(kq * kq);
        kk[i] = kq * rsqrtf(ss + 1e-12f);
        kk_o[(size_t)(r0 + i) * 256 + c] = f2bf(kk[i]);
    }
    __syncthreads();
#pragma unroll
    for (int d = 0; d < 2; ++d) {
        float aw[8], aa[8];
        const float w0c = w0[d * 256 + c], a0c = a0[d * 256 + c];
#pragma unroll
        for (int i = 0; i < 8; ++i) { aw[i] = w0c; aa[i] = a0c; }
#pragma unroll 4
        for (int j = 0; j < 32; ++j) {
            const float wv = w_up[(d * 32 + j) * 256 + c], av = a_up[(d * 32 + j) * 256 + c];
            const f32x4 x0 = *(const f32x4*)(xwT + j * 8), x1 = *(const f32x4*)(xwT + j * 8 + 4);
            const f32x4 y0 = *(const f32x4*)(xaT + j * 8), y1 = *(const f32x4*)(xaT + j * 8 + 4);
#pragma unroll
            for (int i = 0; i < 4; ++i) { aw[i] += x0[i] * wv; aw[4 + i] += x1[i] * wv; aa[i] += y0[i] * av; aa[4 + i] += y1[i] * av; }
        }
#pragma unroll
        for (int i = 0; i < 8; ++i) {
            const float logw = -0.6065306597126334f * sigmf(aw[i]);
            const float ad = sigmf(aa[i]);
            const size_t r = r0 + i;
            w_o[r * 512 + d * 256 + c] = logw;
            kka_o[r * 512 + d * 256 + c] = f2bf(kk[i] * ad);
            kd_o[r * 512 + d * 256 + c] = f2bf(k[i] * (1.f + (ad - 1.f) * kac));
        }
    }
}

#define MFMA16(a, b, c) __builtin_amdgcn_mfma_f32_16x16x32_bf16((a), (b), (c), 0, 0, 0)
__device__ __forceinline__ int scan_row(int b, int dir, int p) {
    const int s = dir == 0 ? p : (p < CL ? (CL - 1 - p) : (CL + (TL - 1 - (p - CL))));
    return b * SS + s;
}
__device__ __forceinline__ void mm64(const char* A, const char* Bt, f32x4 (&acc)[4], int w, int fr, int fq) {
#pragma unroll
    for (int ks = 0; ks < 2; ++ks) {
        const int co = ((ks * 4 + fq) ^ (fr >> 1)) << 4;
        const bf16x8 af = *(const bf16x8*)(A + (16 * w + fr) * 128 + co);
#pragma unroll
        for (int n = 0; n < 4; ++n) { const bf16x8 bfr = *(const bf16x8*)(Bt + (16 * n + fr) * 128 + co); acc[n] = MFMA16(bfr, af, acc[n]); }
    }
}
__device__ __forceinline__ void zero4(f32x4 (&acc)[4]) {
#pragma unroll
    for (int n = 0; n < 4; ++n) acc[n] = (f32x4){0.f, 0.f, 0.f, 0.f};
}
__device__ __forceinline__ void tile_row_write(char* T, int c, const float (&x)[64]) {
#pragma unroll
    for (int ch = 0; ch < 8; ++ch) {
        u32x4 o; o[0] = pk2bf(x[8 * ch], x[8 * ch + 1]); o[1] = pk2bf(x[8 * ch + 2], x[8 * ch + 3]); o[2] = pk2bf(x[8 * ch + 4], x[8 * ch + 5]); o[3] = pk2bf(x[8 * ch + 6], x[8 * ch + 7]);
        *(u32x4*)(T + c * 128 + ((ch ^ ((c >> 1) & 7)) << 4)) = o;
    }
}
__device__ __forceinline__ void tri_solve(const float* Am, float (&x)[64]) {
#pragma unroll
    for (int i = 1; i < 64; ++i) {
        float acc = x[i];
#pragma unroll
        for (int j = 0; j < i; ++j) acc -= Am[i * 64 + j] * x[j];
        x[i] = acc;
    }
}
__device__ __forceinline__ void store_perm(bf16_t* dst, const f32x4 (&acc)[4], int w, int fr, int fq) {
#pragma unroll
    for (int n = 0; n < 4; ++n) {
        u32x2 o; o[0] = pk2bf(acc[n][0], acc[n][1]); o[1] = pk2bf(acc[n][2], acc[n][3]);
        *(u32x2*)(dst + (16 * w + fr) * 64 + 32 * (n >> 1) + 8 * fq + 4 * (n & 1)) = o;
    }
}
__device__ __forceinline__ void store_acc(bf16_t* dst, const f32x4 (&acc)[4], int w, int fr, int fq) {
#pragma unroll
    for (int n = 0; n < 4; ++n)
#pragma unroll
        for (int jj = 0; jj < 4; ++jj) dst[((n * 4 + w) * 64 + (4 * fq + jj) + 16 * (fr >> 2)) * 4 + (fr & 3)] = f2bf(acc[n][jj]);
}

#define TILE(k) (lds + (k) * 8192)
#define SCAL ((float*)(lds + 73728))
__device__ __forceinline__ float tile_get(const char* T, int i, int c3, int clow) { return bf2f(*(const bf16_t*)(T + i * 128 + (((c3 ^ ((i >> 1) & 7)) << 4) | clow))); }
__device__ __forceinline__ void tile_put(char* T, int i, int c3, int clow, float v) { *(bf16_t*)(T + i * 128 + (((c3 ^ ((i >> 1) & 7)) << 4) | clow)) = f2bf(v); }
__device__ __forceinline__ void stage_tile(char* T, const bf16_t* base, size_t ld, int b, int dir, int p0, int TID) {
#pragma unroll
    for (int k = 0; k < 2; ++k) {
        const int id = TID + 256 * k, row = id >> 3, chn = id & 7;
        const size_t r = scan_row(b, dir, p0 + row);
        *(u32x4*)(T + row * 128 + ((chn ^ ((row >> 1) & 7)) << 4)) = *(const u32x4*)(base + r * ld + chn * 8);
    }
}
__device__ __forceinline__ f32x4 tile_get4(const char* T, int i, int j0) {
    const u32x2 rv = *(const u32x2*)(T + i * 128 + (((j0 >> 3) ^ ((i >> 1) & 7)) << 4) + (j0 & 7) * 2);
    return (f32x4){bf2f((bf16_t)(rv[0] & 0xffffu)), bf2f((bf16_t)(rv[0] >> 16)), bf2f((bf16_t)(rv[1] & 0xffffu)), bf2f((bf16_t)(rv[1] >> 16))};
}
__device__ __forceinline__ void tile_put4(char* T, int i, int j0, float v0, float v1, float v2, float v3) {
    u32x2 o; o[0] = pk2bf(v0, v1); o[1] = pk2bf(v2, v3);
    *(u32x2*)(T + i * 128 + (((j0 >> 3) ^ ((i >> 1) & 7)) << 4) + (j0 & 7) * 2) = o;
}

__device__ __forceinline__ void f_chunk_gdn(const bf16_t* __restrict__ gq, const bf16_t* __restrict__ gk, const bf16_t* __restrict__ gv, const float* __restrict__ gab,
                                            bf16_t* X, int chain, int n, char* lds) {
    const int TID = ltid();
    const int lane = TID & 63, w = TID >> 6, fr = lane & 15, fq = lane >> 4;
    const int dir = chain & 1, h = (chain >> 1) & 3, b = chain >> 3;
    float* gcs = SCAL; float* bts = SCAL + 64;
    float* Am = (float*)TILE(7);
    __syncthreads();
    if (TID < 64) {
        const int r = scan_row(b, dir, n * 64 + TID);
        float g = gab[(size_t)r * 16 + dir * 4 + h];
#pragma unroll
        for (int o = 1; o < 64; o <<= 1) { const float t = __shfl_up(g, o); if (lane >= o) g += t; }
        gcs[TID] = g; bts[TID] = gab[(size_t)r * 16 + 8 + dir * 4 + h];
    }
    stage_tile(TILE(0), gq + h * 64, 256, b, dir, n * 64, TID);
    stage_tile(TILE(1), gk + h * 64, 256, b, dir, n * 64, TID);
    stage_tile(TILE(3), gv + h * 64, 256, b, dir, n * 64, TID);
    __syncthreads();
    {
        const int i = 16 * w + fr; const float gi = gcs[i], bi = bts[i];
        f32x4 acc[4]; zero4(acc); mm64(TILE(1), TILE(1), acc, w, fr, fq);
#pragma unroll
        for (int nn = 0; nn < 4; ++nn)
#pragma unroll
            for (int jj = 0; jj < 4; ++jj) { const int j = 16 * nn + 4 * fq + jj; Am[i * 64 + j] = j < i ? bi * acc[nn][jj] * __expf(gi - gcs[j]) : 0.f; }
        zero4(acc); mm64(TILE(0), TILE(1), acc, w, fr, fq);
#pragma unroll
        for (int nn = 0; nn < 4; ++nn) {
            float v[4];
#pragma unroll
            for (int jj = 0; jj < 4; ++jj) { const int j = 16 * nn + 4 * fq + jj; v[jj] = j <= i ? acc[nn][jj] * __expf(gi - gcs[j]) : 0.f; }
            tile_put4(TILE(2), i, 16 * nn + 4 * fq, v[0], v[1], v[2], v[3]);
        }
    }
    __syncthreads();
    if (TID < 192) {
        const int c = lane, c3 = c >> 3, clow = (c & 7) << 1;
        float x[64];
        if (w == 0) {
#pragma unroll
            for (int i = 0; i < 64; ++i) x[i] = tile_get(TILE(3), i, c3, clow) * bts[i];
            tri_solve(Am, x); tile_row_write(TILE(4), c, x);
        } else if (w == 1) {
#pragma unroll
            for (int i = 0; i < 64; ++i) x[i] = tile_get(TILE(1), i, c3, clow) * bts[i] * __expf(gcs[i]);
            tri_solve(Am, x); tile_row_write(TILE(5), c, x);
        } else {
            const float g63 = gcs[63];
#pragma unroll
            for (int i = 0; i < 64; ++i) x[i] = tile_get(TILE(1), i, c3, clow) * __expf(g63 - gcs[i]);
            tile_row_write(TILE(6), c, x);
        }
    }
    __syncthreads();
    {
        bf16_t* Xi = X + ((size_t)(chain * 132 + n)) * 16384;
        const int i = 16 * w + fr;
        f32x4 acc[4];
        zero4(acc); mm64(TILE(2), TILE(4), acc, w, fr, fq); store_acc(Xi + 8192, acc, w, fr, fq);
        zero4(acc); mm64(TILE(2), TILE(5), acc, w, fr, fq);
        {
            const float eg = __expf(gcs[i]);
#pragma unroll
            for (int nn = 0; nn < 4; ++nn) { const f32x4 qv = tile_get4(TILE(0), i, 16 * nn + 4 * fq); acc[nn] = qv * eg - acc[nn]; }
            store_perm(Xi + 4096, acc, w, fr, fq);
        }
        zero4(acc); mm64(TILE(6), TILE(5), acc, w, fr, fq);
        {
            const float gt = __expf(gcs[63]);
#pragma unroll
            for (int nn = 0; nn < 4; ++nn)
#pragma unroll
                for (int jj = 0; jj < 4; ++jj) acc[nn][jj] = ((16 * nn + 4 * fq + jj) == i ? gt : 0.f) - acc[nn][jj];
            store_perm(Xi, acc, w, fr, fq);
        }
        zero4(acc); mm64(TILE(6), TILE(4), acc, w, fr, fq); store_acc(Xi + 12288, acc, w, fr, fq);
    }
}

__device__ __forceinline__ void f_chunk_rwkv(const bf16_t* __restrict__ P, const bf16_t* __restrict__ kk_i, const float* __restrict__ lw_i, const bf16_t* __restrict__ kka_i,
                                             const bf16_t* __restrict__ kd_i, bf16_t* X, int chain, int n, char* lds) {
    const int TID = ltid();
    const int lane = TID & 63, w = TID >> 6, fr = lane & 15, fq = lane >> 4;
    const int dir = chain & 1, h = (chain >> 1) & 3, b = chain >> 3;
    const int c3 = lane >> 3, clow = (lane & 7) << 1;
    float* wc = SCAL;
    float* Am = (float*)TILE(7);
    __syncthreads();
    stage_tile(TILE(0), kk_i + h * 64, 256, b, dir, n * 64, TID);
    stage_tile(TILE(1), kka_i + dir * 256 + h * 64, 512, b, dir, n * 64, TID);
    stage_tile(TILE(2), kd_i + dir * 256 + h * 64, 512, b, dir, n * 64, TID);
    stage_tile(TILE(3), P + ORKV + h * 64, DINP, b, dir, n * 64, TID);
    stage_tile(TILE(4), P + ORKV + 512 + h * 64, DINP, b, dir, n * 64, TID);
#pragma unroll
    for (int k = 0; k < 4; ++k) {
        const int id = TID + 256 * k, row = id >> 4, chn = id & 15;
        const size_t r = scan_row(b, dir, n * 64 + row);
        *(f32x4*)(Am + row * 64 + chn * 4) = *(const f32x4*)(lw_i + r * 512 + dir * 256 + h * 64 + chn * 4);
    }
    __syncthreads();
    {
        float lc = 0.f;
        char* T = TILE(w);
#pragma unroll
        for (int i = 0; i < 64; ++i) {
            const float lprev = lc; lc += Am[i * 64 + lane];
            const float e = w == 0 ? lprev : (w == 3 ? lc : -lc);
            tile_put(T, i, c3, clow, tile_get(T, i, c3, clow) * __expf(e));
        }
        if (w == 0) wc[lane] = __expf(lc);
    }
    __syncthreads();
    if (w == 0) {
        float x[64];
#pragma unroll
        for (int i = 0; i < 64; ++i) x[i] = tile_get(TILE(4), i, c3, clow);
        tile_row_write(TILE(5), lane, x);
    }
    {
        const int i = 16 * w + fr;
        f32x4 acc[4];
        zero4(acc); mm64(TILE(0), TILE(1), acc, w, fr, fq);
#pragma unroll
        for (int nn = 0; nn < 4; ++nn)
#pragma unroll
            for (int jj = 0; jj < 4; ++jj) { const int j = 16 * nn + 4 * fq + jj; Am[i * 64 + j] = j < i ? acc[nn][jj] : 0.f; }
        zero4(acc); mm64(TILE(0), TILE(2), acc, w, fr, fq);
#pragma unroll
        for (int nn = 0; nn < 4; ++nn) {
            float v[4];
#pragma unroll
            for (int jj = 0; jj < 4; ++jj) { const int j = 16 * nn + 4 * fq + jj; v[jj] = j < i ? acc[nn][jj] : 0.f; }
            tile_put4(TILE(6), i, 16 * nn + 4 * fq, v[0], v[1], v[2], v[3]);
        }
    }
    __syncthreads();
    {
        const int i = 16 * w + fr;
        f32x4 acc[4]; zero4(acc); mm64(TILE(6), TILE(5), acc, w, fr, fq);
#pragma unroll
        for (int nn = 0; nn < 4; ++nn)
#pragma unroll
            for (int jj = 0; jj < 4; ++jj) { const int c = 16 * nn + 4 * fq + jj; *(bf16_t*)(TILE(4) + c * 128 + ((((i >> 3) ^ ((c >> 1) & 7)) << 4) | ((i & 7) << 1))) = f2bf(acc[nn][jj]); }
    }
    __syncthreads();
    if (w < 2) {
        float x[64];
        if (w == 0) {
#pragma unroll
            for (int ch = 0; ch < 8; ++ch) {
                const bf16x8 v = *(const bf16x8*)(TILE(4) + lane * 128 + ((ch ^ ((lane >> 1) & 7)) << 4));
#pragma unroll
                for (int e = 0; e < 8; ++e) x[8 * ch + e] = -bf2f((bf16_t)v[e]);
            }
        } else {
#pragma unroll
            for (int i = 0; i < 64; ++i) x[i] = tile_get(TILE(0), i, c3, clow);
        }
        tri_solve(Am, x);
        tile_row_write(w == 0 ? TILE(6) : TILE(0), lane, x);
    }
    __syncthreads();
    {
        const int i = 16 * w + fr;
#pragma unroll
        for (int q = 0; q < 2; ++q) {
            f32x4 acc[4]; zero4(acc); mm64(TILE(3), TILE(1 + q), acc, w, fr, fq);
#pragma unroll
            for (int nn = 0; nn < 4; ++nn) {
                float v[4];
#pragma unroll
                for (int jj = 0; jj < 4; ++jj) { const int j = 16 * nn + 4 * fq + jj; v[jj] = j <= i ? acc[nn][jj] : 0.f; }
                tile_put4(TILE(7 + q), i, 16 * nn + 4 * fq, v[0], v[1], v[2], v[3]);
            }
        }
    }
    if (w == 0) {
        float x[64]; const float wd = wc[lane];
#pragma unroll
        for (int i = 0; i < 64; ++i) x[i] = tile_get(TILE(1), i, c3, clow) * wd;
        tile_row_write(TILE(4), lane, x);
    }
    __syncthreads();
    bf16_t* Xi = X + ((size_t)((16 + chain) * 132 + n)) * 16384;
    f32x4 sa[4];
    {
        const int i = 16 * w + fr;
        f32x4 acc[4];
        zero4(acc); mm64(TILE(7), TILE(6), acc, w, fr, fq); mm64(TILE(8), TILE(5), acc, w, fr, fq); store_acc(Xi + 8192, acc, w, fr, fq);
        zero4(acc); mm64(TILE(7), TILE(0), acc, w, fr, fq);
#pragma unroll
        for (int nn = 0; nn < 4; ++nn) { const f32x4 rv = tile_get4(TILE(3), i, 16 * nn + 4 * fq); acc[nn] = rv - acc[nn]; }
        store_perm(Xi + 4096, acc, w, fr, fq);
        zero4(acc); mm64(TILE(4), TILE(0), acc, w, fr, fq);
        {
            const float wd = wc[i];
#pragma unroll
            for (int nn = 0; nn < 4; ++nn)
#pragma unroll
                for (int jj = 0; jj < 4; ++jj) acc[nn][jj] = ((16 * nn + 4 * fq + jj) == i ? wd : 0.f) - acc[nn][jj];
            store_perm(Xi, acc, w, fr, fq);
        }
        zero4(sa); mm64(TILE(4), TILE(6), sa, w, fr, fq);
    }
    __syncthreads();
    if (w == 0) {
        float x[64]; const float wd = wc[lane];
#pragma unroll
        for (int i = 0; i < 64; ++i) x[i] = tile_get(TILE(2), i, c3, clow) * wd;
        tile_row_write(TILE(4), lane, x);
    }
    __syncthreads();
    mm64(TILE(4), TILE(5), sa, w, fr, fq); store_acc(Xi + 12288, sa, w, fr, fq);
}

struct ScanOps { bf16x8 ar[4][2], ag[4][2]; u32x2 y0[4], s0[4]; };
__device__ __forceinline__ void scan_load(ScanOps& o, const bf16_t* Xi, int slab, int lane, int c, int q) {
#pragma unroll
    for (int mb = 0; mb < 4; ++mb) {
        o.y0[mb] = *(const u32x2*)(Xi + 8192 + ((slab * 4 + mb) * 64 + lane) * 4);
        o.s0[mb] = *(const u32x2*)(Xi + 12288 + ((slab * 4 + mb) * 64 + lane) * 4);
#pragma unroll
        for (int s = 0; s < 2; ++s) {
            o.ar[mb][s] = *(const bf16x8*)(Xi + 4096 + (16 * mb + c) * 64 + 32 * s + 8 * q);
            o.ag[mb][s] = *(const bf16x8*)(Xi + (16 * mb + c) * 64 + 32 * s + 8 * q);
        }
    }
}
__device__ __forceinline__ void scan_step(const ScanOps& o, f32x4 (&S)[4], bf16_t* so, int b, int dir, int colbase, int n, int c, int q) {
    bf16x8 bS[2];
#pragma unroll
    for (int s = 0; s < 2; ++s) {
        u32x4 w; w[0] = pk2bf(S[2 * s][0], S[2 * s][1]); w[1] = pk2bf(S[2 * s][2], S[2 * s][3]); w[2] = pk2bf(S[2 * s + 1][0], S[2 * s + 1][1]); w[3] = pk2bf(S[2 * s + 1][2], S[2 * s + 1][3]);
        bS[s] = __builtin_bit_cast(bf16x8, w);
    }
#pragma unroll
    for (int mb = 0; mb < 4; ++mb) {
        f32x4 y = (f32x4){bf2f((bf16_t)(o.y0[mb][0] & 0xffffu)), bf2f((bf16_t)(o.y0[mb][0] >> 16)), bf2f((bf16_t)(o.y0[mb][1] & 0xffffu)), bf2f((bf16_t)(o.y0[mb][1] >> 16))};
        f32x4 sn = (f32x4){bf2f((bf16_t)(o.s0[mb][0] & 0xffffu)), bf2f((bf16_t)(o.s0[mb][0] >> 16)), bf2f((bf16_t)(o.s0[mb][1] & 0xffffu)), bf2f((bf16_t)(o.s0[mb][1] >> 16))};
#pragma unroll
        for (int s = 0; s < 2; ++s) { y = MFMA16(o.ar[mb][s], bS[s], y); sn = MFMA16(o.ag[mb][s], bS[s], sn); }
#pragma unroll
        for (int reg = 0; reg < 4; ++reg) {
            const int r = scan_row(b, dir, n * 64 + 16 * mb + 4 * q + reg);
            so[((size_t)dir * RR + r) * 512 + colbase + c] = f2bf(y[reg]);
        }
        S[mb] = sn;
    }
}
__device__ __forceinline__ void f_scan2(const bf16_t* __restrict__ X, bf16_t* so, int mc  ) {
    const int TID = ltid();
    const int lane = TID & 63, slab = TID >> 6, c = lane & 15, q = lane >> 4;
    const int mixer = mc >> 4, chain = mc & 15, dir = chain & 1, h = (chain >> 1) & 3, b = chain >> 3;
    const int colbase = mixer * 256 + h * 64 + slab * 16;
    f32x4 S[4];
#pragma unroll
    for (int mb = 0; mb < 4; ++mb) S[mb] = (f32x4){0.f, 0.f, 0.f, 0.f};
    const bf16_t* X0 = X + (size_t)(mc * 132) * 16384;
    ScanOps A, B;
    scan_load(A, X0, slab, lane, c, q);
#pragma unroll 1
    for (int n = 0; n < 132; n += 2) {
        scan_load(B, X0 + (size_t)(n + 1) * 16384, slab, lane, c, q);
        scan_step(A, S, so, b, dir, colbase, n, c, q);
        if (n + 2 < 132) scan_load(A, X0 + (size_t)(n + 2) * 16384, slab, lane, c, q);
        scan_step(B, S, so, b, dir, colbase, n + 1, c, q);
    }
}

__device__ __forceinline__ void f_mix_out(const bf16_t* __restrict__ p, bf16_t* cat, const bf16_t* __restrict__ so, const float* __restrict__ gdn_norm,
                                                 const bf16_t* __restrict__ kd_i, const float* __restrict__ g_up, const float* __restrict__ r_k,
                                                 const float* __restrict__ gn_w, const float* __restrict__ gn_b,
                                                 const bf16_t* __restrict__ OM, const float* __restrict__ da_lambda, const float* __restrict__ da_norm, float lam_init, int vb, float* lds) {
    const int TID = ltid();
    float* xgT = lds;
    __syncthreads();
    const int r0 = vb * 8, c = TID;
#pragma unroll
    for (int t = 0; t < 2; ++t) { const int id = TID + 256 * t, i = id >> 6, j = id & 63; xgT[j * 8 + i] = sigmf(bf2f(p[(size_t)(r0 + i) * DINP + OXG + j])); }
    __syncthreads();
    float g[8];
#pragma unroll
    for (int i = 0; i < 8; ++i) g[i] = 0.f;
#pragma unroll 4
    for (int j = 0; j < 64; ++j) {
        const float gu = g_up[j * 256 + c];
        const f32x4 x0 = *(const f32x4*)(xgT + j * 8), x1 = *(const f32x4*)(xgT + j * 8 + 4);
#pragma unroll
        for (int i = 0; i < 4; ++i) { g[i] += x0[i] * gu; g[4 + i] += x1[i] * gu; }
    }
    const float gnc = gdn_norm[c & 63], rkc = r_k[c], gw = gn_w[c], gb = gn_b[c];
    float s01 = 0.f, s23 = 0.f;
    for (int d = 0; d < 64; ++d) { s01 += da_lambda[d] * da_lambda[64 + d]; s23 += da_lambda[128 + d] * da_lambda[192 + d]; }
    const float lam = expf(s01) - expf(s23) + lam_init;
    const int hw = c >> 6, ln = c & 63;
    const float dg0 = da_norm[ln] * (1.f - lam_init), dg1 = da_norm[ln + 64] * (1.f - lam_init);
#pragma unroll
    for (int i = 0; i < 8; ++i) {
        const size_t r = r0 + i;
        const bf16_t* pr = p + r * DINP;
        {
            const bf16_t* o0 = OM + r * 512 + hw * 128; const bf16_t* o1 = OM + ((size_t)RR + r) * 512 + hw * 128;
            const float v0 = bf2f(o0[ln]) - lam * bf2f(o1[ln]), v1 = bf2f(o0[ln + 64]) - lam * bf2f(o1[ln + 64]);
            const float ssq = wave_sum(v0 * v0 + v1 * v1);
            const float rstd = rsqrtf(ssq * (1.f / 128.f) + 1e-6f);
            cat[r * DM + hw * 128 + ln] = f2bf(v0 * rstd * dg0); cat[r * DM + hw * 128 + ln + 64] = f2bf(v1 * rstd * dg1);
        }
        const float o = bf2f(so[r * 512 + c]) + bf2f(so[((size_t)RR + r) * 512 + c]);
        const float ss = wave_sum(o * o);
        const float y = o * rsqrtf(ss * (1.f / 64.f) + 1e-6f) * gnc * siluf(bf2f(pr[OGGATE + c]));
        const float yv = bf2f(so[r * 512 + 256 + c]) + bf2f(so[((size_t)RR + r) * 512 + 256 + c]);
        const float mu = wave_sum(yv) * (1.f / 64.f);
        const float dv = yv - mu;
        const float var = wave_sum(dv * dv) * (1.f / 64.f);
        const float yn = dv * rsqrtf(var + 64e-5f) * gw + gb;
        const float rr = bf2f(pr[ORKV + c]), vv = bf2f(pr[ORKV + 512 + c]);
        const float kds = bf2f(kd_i[r * 512 + c]) + bf2f(kd_i[r * 512 + 256 + c]);
        const float bs = wave_sum(rr * kds * rkc);
        cat[r * DM + 512 + c] = f2bf(y);
        cat[r * DM + 768 + c] = f2bf((yn + bs * vv) * g[i]);
    }
}

__device__ __forceinline__ void f_resid1_prep(const float* __restrict__ router, float* lds) {
    const int TID = ltid();
    __syncthreads();
    for (int i = TID; i < DM * NE; i += 256) { const int col = i >> 4, e = i & 15; lds[e * DM + col] = router[i]; }
    __syncthreads();
}
__device__ __forceinline__ void f_resid1(float* ctxs, float* out, const float* __restrict__ mix, const float* __restrict__ g_post, const float* __restrict__ g_pre2,
                         const float* __restrict__ modl, const float* routerT, bf16_t* h2, float* aff, int vb) {
    const int TID = ltid();
    const int r = vb * 4 + (TID >> 6), lane = TID & 63;
    float* x = xrow_ptr(ctxs, out, r);
    const float* m = modl + modrow(r) * 6 * DM;
    f32x4 v[4], xv[4]; float ss = 0.f;
#pragma unroll
    for (int j = 0; j < 4; ++j) { v[j] = *(const f32x4*)(mix + (size_t)r * DM + 4 * lane + 256 * j); xv[j] = *(const f32x4*)(x + 4 * lane + 256 * j); ss += v[j][0] * v[j][0] + v[j][1] * v[j][1] + v[j][2] * v[j][2] + v[j][3] * v[j][3]; }
    ss = wave_sum(ss);
    const float rstd = rsqrtf(ss * (1.f / DM) + 1e-6f);
    float s2 = 0.f;
#pragma unroll
    for (int j = 0; j < 4; ++j) {
        const int c0 = 4 * lane + 256 * j;
        const f32x4 gp = *(const f32x4*)(g_post + c0), gt = *(const f32x4*)(m + 2048 + c0);
        xv[j] = xv[j] + gt * (v[j] * rstd * gp);
        *(f32x4*)(x + c0) = xv[j];
        s2 += xv[j][0] * xv[j][0] + xv[j][1] * xv[j][1] + xv[j][2] * xv[j][2] + xv[j][3] * xv[j][3];
    }
    s2 = wave_sum(s2);
    const float rstd2 = rsqrtf(s2 * (1.f / DM) + 1e-6f);
    f32x4 hv[4];
#pragma unroll
    for (int j = 0; j < 4; ++j) {
        const int c0 = 4 * lane + 256 * j;
        const f32x4 g2 = *(const f32x4*)(g_pre2 + c0), sc = *(const f32x4*)(m + 4096 + c0), sh = *(const f32x4*)(m + 3072 + c0);
        hv[j] = xv[j] * rstd2 * g2 * (1.f + sc) + sh;
        u32x2 o; o[0] = pk2bf(hv[j][0], hv[j][1]); o[1] = pk2bf(hv[j][2], hv[j][3]);
        *(u32x2*)(h2 + (size_t)r * DM + c0) = o;
    }
    float lg[NE];
#pragma unroll
    for (int e = 0; e < NE; ++e) {
        float acc = 0.f;
#pragma unroll
        for (int j = 0; j < 4; ++j) { const f32x4 rt = *(const f32x4*)(routerT + e * DM + 4 * lane + 256 * j); acc += hv[j][0] * rt[0] + hv[j][1] * rt[1] + hv[j][2] * rt[2] + hv[j][3] * rt[3]; }
        lg[e] = acc;
    }
#pragma unroll
    for (int e = 0; e < 8; ++e) { const float give = (lane & 32) ? lg[e] : lg[e + 8], keep = (lane & 32) ? lg[e + 8] : lg[e]; lg[e] = keep + __shfl_xor(give, 32); }
#pragma unroll
    for (int e = 0; e < 4; ++e) { const float give = (lane & 16) ? lg[e] : lg[e + 4], keep = (lane & 16) ? lg[e + 4] : lg[e]; lg[e] = keep + __shfl_xor(give, 16); }
#pragma unroll
    for (int e = 0; e < 2; ++e) { const float give = (lane & 8) ? lg[e] : lg[e + 2], keep = (lane & 8) ? lg[e + 2] : lg[e]; lg[e] = keep + __shfl_xor(give, 8); }
    { const float give = (lane & 4) ? lg[0] : lg[1], keep = (lane & 4) ? lg[1] : lg[0]; lg[0] = keep + __shfl_xor(give, 4); }
    float tot = lg[0];
    tot += __shfl_xor(tot, 2); tot += __shfl_xor(tot, 1);
    const int myexp = ((lane >> 5) & 1) * 8 + ((lane >> 4) & 1) * 4 + ((lane >> 3) & 1) * 2 + ((lane >> 2) & 1);
    float mxv = tot;
#pragma unroll
    for (int o = 4; o < 64; o <<= 1) mxv = fmaxf(mxv, __shfl_xor(mxv, o));
    const float ex = expf(tot - mxv);
    float sum = ex;
#pragma unroll
    for (int o = 4; o < 64; o <<= 1) sum += __shfl_xor(sum, o);
    if ((lane & 3) == 0) aff[(size_t)r * NE + myexp] = ex / sum;
}

__device__ __forceinline__ void f_topk(const float* __restrict__ aff, int* sel_lat, int* sel_ctx, int* slot, int vb, float* lds) {
    const int TID = ltid();
    unsigned* vals = (unsigned*)lds;
    unsigned* hist = (unsigned*)lds + 8192 + 256;
    unsigned* sc = hist + 256;
    unsigned* ctl = sc + 512;
    const int set = vb >> 5, b = (vb >> 4) & 1, e = vb & 15;
    const int n = set == 0 ? TL : CL, cap = set == 0 ? CAPL : CAPC;
    const int per = n >> 8;
    const int rbase = b * SS + (set == 0 ? CL : 0);
    __syncthreads();
    for (int t = TID; t < n; t += 256) vals[t + (t >> 5)] = __float_as_uint(aff[(size_t)(rbase + t) * NE + e]);
    if (TID == 0) { ctl[0] = 0u; ctl[1] = (unsigned)cap; }
    __syncthreads();
    for (int pass = 0; pass < 4; ++pass) {
        const int shift = 24 - 8 * pass;
        hist[TID] = 0u;
        __syncthreads();
        const unsigned prefix = ctl[0];
        const unsigned pmask = pass == 0 ? 0u : (0xffffffffu << (shift + 8));
        for (int j = 0; j < per; ++j) {
            const int t = TID * per + j;
            const unsigned v = vals[t + (t >> 5)];
            if ((v & pmask) == prefix) atomicAdd(&hist[(v >> shift) & 255u], 1u);
        }
        __syncthreads();
        if (TID == 0) {
            unsigned rem = ctl[1], d = 255u;
            for (;; --d) { const unsigned hc = hist[d]; if (hc >= rem || d == 0u) break; rem -= hc; }
            ctl[0] = prefix | (d << shift); ctl[1] = rem;
        }
        __syncthreads();
    }
    const unsigned thr = ctl[0], need_eq = ctl[1];
    unsigned cg = 0u, ce = 0u;
    for (int j = 0; j < per; ++j) { const int t = TID * per + j; const unsigned v = vals[t + (t >> 5)]; cg += v > thr ? 1u : 0u; ce += v == thr ? 1u : 0u; }
    sc[TID] = ce; __syncthreads();
    for (int o = 1; o < 256; o <<= 1) { const unsigned add = TID >= o ? sc[TID - o] : 0u; __syncthreads(); sc[TID] += add; __syncthreads(); }
    const unsigned eq_before = sc[TID] - ce;
    const unsigned eq_take = eq_before >= need_eq ? 0u : (need_eq - eq_before < ce ? need_eq - eq_before : ce);
    const unsigned csel = cg + eq_take;
    sc[256 + TID] = csel; __syncthreads();
    for (int o = 1; o < 256; o <<= 1) { const unsigned add = TID >= o ? sc[256 + TID - o] : 0u; __syncthreads(); sc[256 + TID] += add; __syncthreads(); }
    unsigned pos = sc[256 + TID] - csel;
    unsigned eq_seen = eq_before;
    for (int j = 0; j < per; ++j) {
        const int t = TID * per + j; const unsigned v = vals[t + (t >> 5)];
        bool take = v > thr;
        if (v == thr) { take = eq_seen < need_eq; ++eq_seen; }
        int sl = -1;
        if (take) { sl = (int)pos; ++pos; if (set == 0) sel_lat[(b * NE + e) * CAPL + sl] = rbase + t; else sel_ctx[(b * NE + e) * CAPC + sl] = rbase + t; }
        slot[(size_t)e * RR + rbase + t] = sl;
    }
}

__device__ __forceinline__ void f_resid2(float* ctxs, float* out, const bf16_t* __restrict__ ye_lat, const bf16_t* __restrict__ ye_ctx, const int* __restrict__ slot,
                         const float* __restrict__ g_post, const float* __restrict__ modl, int vb) {
    const int TID = ltid();
    const int r = vb * 4 + (TID >> 6), lane = TID & 63;
    float* x = xrow_ptr(ctxs, out, r);
    const float* m = modl + modrow(r) * 6 * DM;
    const int b = r >= SS ? 1 : 0, s = r - b * SS;
    const int myslot = slot[(size_t)(lane & 15) * RR + r];
    f32x4 xv[4];
#pragma unroll
    for (int j = 0; j < 4; ++j) xv[j] = *(const f32x4*)(x + 4 * lane + 256 * j);
    f32x4 y[4];
#pragma unroll
    for (int j = 0; j < 4; ++j) y[j] = (f32x4){0.f, 0.f, 0.f, 0.f};
    unsigned long long mask = __ballot(myslot >= 0) & 0xffffull;
    while (mask) {
        const int e = __builtin_ctzll(mask); mask &= mask - 1;
        const int sl = __shfl(myslot, e);
        const bf16_t* src = s < CL ? ye_ctx + ((size_t)(b * NE + e) * CAPC + sl) * DM : ye_lat + ((size_t)(b * NE + e) * CAPL + sl) * DM;
#pragma unroll
        for (int j = 0; j < 4; ++j) {
            const u32x2 w = *(const u32x2*)(src + 4 * lane + 256 * j);
            y[j][0] += bf2f((bf16_t)(w[0] & 0xffffu)); y[j][1] += bf2f((bf16_t)(w[0] >> 16)); y[j][2] += bf2f((bf16_t)(w[1] & 0xffffu)); y[j][3] += bf2f((bf16_t)(w[1] >> 16));
        }
    }
    float ss = 0.f;
#pragma unroll
    for (int j = 0; j < 4; ++j) ss += y[j][0] * y[j][0] + y[j][1] * y[j][1] + y[j][2] * y[j][2] + y[j][3] * y[j][3];
    ss = wave_sum(ss);
    const float rstd = rsqrtf(ss * (1.f / DM) + 1e-6f);
#pragma unroll
    for (int j = 0; j < 4; ++j) {
        const int c0 = 4 * lane + 256 * j;
        const f32x4 gp = *(const f32x4*)(g_post + c0), gt = *(const f32x4*)(m + 5120 + c0);
        *(f32x4*)(x + c0) = xv[j] + gt * (y[j] * rstd * gp);
    }
}

#define XB_TMO      128
#define XB_XCNT(j)  (256  + 64 * (j))
#define XB_XSUB(j)  (1280 + 64 * (j))
#define XB_XGEN(j)  (2304 + 64 * (j))
#define XB_TOP      3328
#define XB_TOPGEN   3392
#define XCD_BAR_WORDS 3456
#define XB_SPIN_CAP (1u << 18)
__device__ __forceinline__ unsigned xb_ld(unsigned* p)              { return __hip_atomic_load(p, __ATOMIC_RELAXED, __HIP_MEMORY_SCOPE_AGENT); }
__device__ __forceinline__ unsigned xb_add(unsigned* p, unsigned v) { return __hip_atomic_fetch_add(p, v, __ATOMIC_RELAXED, __HIP_MEMORY_SCOPE_AGENT); }
__device__ __forceinline__ unsigned xb_xcc_id() { return (unsigned)__builtin_amdgcn_s_getreg((3 << 11) | 20) & 0xFu; }
#define XB_SPIN(cond, bar) do { unsigned _sp = 0; while (cond) { __builtin_amdgcn_s_sleep(1); \
    if ((++_sp & 255u) == 0u) { if (xb_ld(&(bar)[XB_TMO])) break; if (_sp > XB_SPIN_CAP) { atomicAdd(&(bar)[XB_TMO], 1u); break; } } } } while (0)
__device__ __forceinline__ void xcd_barrier_complete(unsigned* bar, unsigned x, unsigned& nloc, unsigned& nx) {
    const unsigned G = gridDim.x * gridDim.y * gridDim.z;
    unsigned sum, cntx, mine, sp = 0u;
    for (;;) {
        sum = 0u; cntx = 0u; mine = 0u;
#pragma unroll
        for (unsigned j = 0; j < 16; ++j) { const unsigned c = xb_ld(&bar[XB_XCNT(j)]); sum += c; cntx += (c > 0u) ? 1u : 0u; mine = (j == x) ? c : mine; }
        if (sum == G) break;
        __builtin_amdgcn_s_sleep(1);
        if ((++sp & 255u) == 0u) { if (xb_ld(&bar[XB_TMO])) break; if (sp > XB_SPIN_CAP) { atomicAdd(&bar[XB_TMO], 1u); break; } }
    }
    nloc = mine > 0u ? mine : 1u; nx = cntx > 0u ? cntx : 1u;
}
__device__ __forceinline__ void xcd_barrier(unsigned* bar, volatile unsigned* st) {
    asm volatile("s_waitcnt vmcnt(0)" ::: "memory");
    __syncthreads();
    if (threadIdx.x == 0) {
        __builtin_amdgcn_s_waitcnt(0);
        const unsigned x = st[2];
        unsigned nloc = st[0], nx = st[1];
        if (nloc == 0u) { xcd_barrier_complete(bar, x, nloc, nx); st[0] = nloc; st[1] = nx; }
        const unsigned old = xb_add(&bar[XB_XSUB(x)], 1u);
        const unsigned gen = old / nloc;
        if (old + 1u == (gen + 1u) * nloc) {
            __builtin_amdgcn_fence(__ATOMIC_RELEASE, "agent");
            asm volatile("s_waitcnt vmcnt(0)" ::: "memory");
            const unsigned og = xb_add(&bar[XB_TOP], 1u);
            const unsigned tg = og / nx;
            if (og + 1u == (tg + 1u) * nx) xb_add(&bar[XB_TOPGEN], 1u);
            else XB_SPIN(xb_ld(&bar[XB_TOPGEN]) == tg, bar);
            __builtin_amdgcn_fence(__ATOMIC_ACQUIRE, "agent");
            xb_add(&bar[XB_XGEN(x)], 1u);
            asm volatile("s_waitcnt vmcnt(0)" ::: "memory");
        } else {
            XB_SPIN(xb_ld(&bar[XB_XGEN(x)]) == gen, bar);
            __builtin_amdgcn_fence(__ATOMIC_ACQUIRE, "agent");
            asm volatile("s_waitcnt vmcnt(0)" ::: "memory");
        }
    }
    __syncthreads();
}
#ifndef CHUNKREP
#define CHUNKREP 1
#endif
#ifndef REPMASK
#define REPMASK 0
#endif
#define REPS(k) for (int rep_ = 0; rep_ < (((REPMASK) >> (k)) & 1) + 1; ++rep_)
struct MP { const float* in[30]; float* out; char* ws; };
enum { I_X = 0, I_C, I_CTX, I_CCTX, I_WMOD, I_BMOD, I_NPRE, I_NPOST, I_WIN, I_WOUT, I_LAM, I_DAN, I_GCONV, I_GALOG, I_GDT, I_GNORM,
       I_W0, I_WUP, I_A0, I_AUP, I_GUP, I_KK, I_KA, I_RK, I_GNW, I_GNB, I_ROUTER, I_MGATE, I_MUP, I_MDOWN };
constexpr int PB_NPRE = 0, PB_NPOST = PB_NPRE + 4096, PB_LAM = PB_NPOST + 4096, PB_DAN = PB_LAM + 512, PB_GCONV = PB_DAN + 256, PB_GALOG = PB_GCONV + 7680,
              PB_GDT = PB_GALOG + 16, PB_GNORM = PB_GDT + 16, PB_W0 = PB_GNORM + 128, PB_WUP = PB_W0 + 1024, PB_A0 = PB_WUP + 32768, PB_AUP = PB_A0 + 1024,
              PB_GUP = PB_AUP + 32768, PB_KK = PB_GUP + 32768, PB_KA = PB_KK + 512, PB_RK = PB_KA + 512, PB_GNW = PB_RK + 512, PB_GNB = PB_GNW + 512,
              PB_ROUTER = PB_GNB + 512, PB_END = PB_ROUTER + 32768;
constexpr size_t al256c(size_t x) { return (x + 255) & ~(size_t)255; }
constexpr size_t WS_BAR = 0, WS_CNT = 16384, WS_PRM = 16384 + 256, WS_MOD = al256c(WS_PRM + (size_t)PB_END * 4), WS_CTXS = al256c(WS_MOD + (size_t)2 * 3 * 6 * DM * 4),
                 WS_AFF = al256c(WS_CTXS + (size_t)NB * CL * DM * 4), WS_TAB = al256c(WS_AFF + (size_t)RR * NE * 4), WS_SLOT = al256c(WS_TAB + (size_t)128 * 16 * 8),
                 WS_SELL = al256c(WS_SLOT + (size_t)NE * RR * 4), WS_SELC = al256c(WS_SELL + (size_t)32 * CAPL * 4), WS_WTIN = al256c(WS_SELC + (size_t)32 * CAPC * 4),
                 WS_WTOUT = al256c(WS_WTIN + (size_t)2 * DINP * DM * 2), WS_BUFA = al256c(WS_WTOUT + (size_t)2 * DM * DM * 2), WS_SO = al256c(WS_BUFA + (size_t)RR * DM * 2),
                 WS_P = al256c(WS_SO + (size_t)2 * RR * 512 * 2), WS_R3 = al256c(WS_P + (size_t)RR * DINP * 2), WS_VT = al256c(WS_R3 + (size_t)RR * 6208),
                 WS_OM = al256c(WS_VT + (size_t)NB * 4 * 128 * SS * 2), WS_XC = al256c(WS_OM + (size_t)2 * RR * 512 * 2), WS_END = al256c(WS_XC + (size_t)32 * 132 * 16384 * 2);

__device__ __forceinline__ char* lptr(char* p) { asm volatile("" : "+s"(p)); return p; }
#define PHASE char* const W = lptr(a.ws); float* const out = (float*)lptr((char*)a.out); (void)W; (void)out;
#define bar ((unsigned*)(W + WS_BAR))
#define cnt ((int*)(W + WS_CNT))
#define prm ((float*)(W + WS_PRM))
#define mod ((float*)(W + WS_MOD))
#define ctxs ((float*)(W + WS_CTXS))
#define aff ((float*)(W + WS_AFF))
#define tab ((float2*)(W + WS_TAB))
#define slot ((int*)(W + WS_SLOT))
#define sel_lat ((int*)(W + WS_SELL))
#define sel_ctx ((int*)(W + WS_SELC))
#define wt_in ((bf16_t*)(W + WS_WTIN))
#define wt_out ((bf16_t*)(W + WS_WTOUT))
#define bufA ((bf16_t*)(W + WS_BUFA))
#define so ((bf16_t*)(W + WS_SO))
#define P ((bf16_t*)(W + WS_P))
#define R3 ((bf16_t*)(W + WS_R3))
#define VT ((bf16_t*)(W + WS_VT))
#define XC ((bf16_t*)(W + WS_XC))
#define OM ((bf16_t*)(W + WS_OM))
#define gq R3
#define gk (R3 + (size_t)RR * 256)
#define gv (R3 + (size_t)RR * 512)
#define kk_b (R3 + (size_t)RR * 768)
#define kka_b (R3 + (size_t)RR * 1024)
#define kd_b (R3 + (size_t)RR * 1536)
#define w_b ((float*)(R3 + (size_t)RR * 2048))
#define gab (w_b + (size_t)RR * 512)
#define mix ((float*)R3)
#define ye_lat R3
#define ye_ctx (R3 + (size_t)32 * CAPL * DM)
#define hid_lat P
#define hid_ctx (P + (size_t)32 * CAPL * DM)
#define h bufA
#define cat bufA
#define h2 bufA
#define wt_gu XC
#define wt_dn (XC + (size_t)NE * 2 * DM * DM)
#define modl (mod + (size_t)i * 3 * 6 * DM)
#define GBAR { PHASE xcd_barrier(bar, (volatile unsigned*)(lds + 18432 + 132)); }

__global__ __launch_bounds__(256, 2) void mega(MP a) {
    __shared__ __attribute__((aligned(16))) float lds[18432 + 256];
    cg::grid_group grid = cg::this_grid();
    const int nb = gridDim.x, bid = blockIdx.x;
    if (threadIdx.x == 0) {
        volatile unsigned* st = (volatile unsigned*)(lds + 18432 + 132);
        st[0] = 0u; st[1] = 0u; st[2] = xb_xcc_id();
        (void)xb_add(&((unsigned*)(a.ws + WS_BAR))[XB_XCNT(st[2])], 1u);
    }
    __syncthreads();

    {
    PHASE
    if (bid == 0 && threadIdx.x < 64) cnt[threadIdx.x] = 0;
    {
        const int gt = lsgpr(bid) * 256 + ltid(), gn = nb * 256;
#define CPY(idx, off, n) for (int q_ = gt; q_ < (n); q_ += gn) prm[(off) + q_] = a.in[idx][q_];
        CPY(I_NPRE, PB_NPRE, 4096) CPY(I_NPOST, PB_NPOST, 4096) CPY(I_LAM, PB_LAM, 512) CPY(I_DAN, PB_DAN, 256) CPY(I_GCONV, PB_GCONV, 7680) CPY(I_GALOG, PB_GALOG, 16)
        CPY(I_GDT, PB_GDT, 16) CPY(I_GNORM, PB_GNORM, 128) CPY(I_W0, PB_W0, 1024) CPY(I_WUP, PB_WUP, 32768) CPY(I_A0, PB_A0, 1024) CPY(I_AUP, PB_AUP, 32768)
        CPY(I_GUP, PB_GUP, 32768) CPY(I_KK, PB_KK, 512) CPY(I_KA, PB_KA, 512) CPY(I_RK, PB_RK, 512) CPY(I_GNW, PB_GNW, 512) CPY(I_GNB, PB_GNB, 512) CPY(I_ROUTER, PB_ROUTER, 32768)
#undef CPY
    }
    REPS(0) {
    f_init(a.in[I_X], a.in[I_CTX], out, ctxs, lsgpr(bid), nb);
    for (int vb = lsgpr(bid); vb < 384; vb += nb) f_mod1(a.in[I_C], a.in[I_CCTX], a.in[I_WMOD], (float*)XC, vb, lds);
    for (int i = lsgpr(bid) * 256 + ltid(); i < 128 * 16; i += nb * 256) {
        int pos = i >> 4, f = i & 15;
        float ang = (float)pos * powf(10000.f, -(float)f / 16.f);
        tab[i] = make_float2(cosf(ang), sinf(ang));
    }
    {
        const int T_IN = 2 * 16 * 28, T_OUT = 2 * 16 * 8;
        for (int vb = lsgpr(bid); vb < T_IN + T_OUT; vb += nb) {
            int t = vb;
            if (t < T_IN) { int l = t / (16 * 28), q = t % (16 * 28); f_wconv(a.in[I_WIN] + (size_t)l * DM * DIN, DIN, wt_in + (size_t)l * DINP * DM, 0, q / 28, q % 28, lds); continue; }
            t -= T_IN;
            { int l = t / 128, q = t % 128; f_wconv(a.in[I_WOUT] + (size_t)l * DM * DM, DM, wt_out + (size_t)l * DM * DM, 0, q / 8, q % 8, lds); }
        }
    }
    }
    }
    grid.sync();
    { PHASE for (int vb = lsgpr(bid); vb < (2 * 3 * 6 * DM) / 256; vb += nb) f_mod2((const float*)XC, a.in[I_BMOD], mod, vb); }
    GBAR

    _Pragma("unroll") for (int i = 0; i < 2; ++i) {
        const float lam_init = 0.8f - 0.6f * expf(-0.3f * (float)i);
        { PHASE
        REPS(1) for (int vb = lsgpr(bid); vb < RR / 4; vb += nb) f_normmod(ctxs, out, (prm + PB_NPRE) + (size_t)(i * 2 + 0) * DM, modl, 0, 1024, h, vb);
        }
        GBAR
        { PHASE
        REPS(2) for (int vb = lsgpr(bid); vb < 132 * 28; vb += nb) {
            const int mt = vb / 28, nt = vb % 28;
            RowDense ap{h + (size_t)mt * 128 * DM, DM}; RowDense bp{wt_in + (size_t)i * DINP * DM + (size_t)nt * 128 * DM, DM};
            EpiInProj ep{P, VT, tab, mt * 128, nt * 128};
            gemm128(ap, bp, DM, ep, (char*)lds);
        }
        }
        GBAR
        { PHASE
        REPS(3) for (int vb = lsgpr(bid); vb < RR / 8; vb += nb) f_gdn_prep(P, (prm + PB_GCONV) + (size_t)i * 5 * 768, (prm + PB_GALOG) + i * 8, (prm + PB_GDT) + i * 8, gq, gk, gv, gab, vb);
        REPS(4) for (int vb = lsgpr(bid); vb < RR / 8; vb += nb) f_rwkv_prep(P, (prm + PB_W0) + i * 512, (prm + PB_WUP) + (size_t)i * 2 * 32 * 256, (prm + PB_A0) + i * 512, (prm + PB_AUP) + (size_t)i * 2 * 32 * 256,
                                                           (prm + PB_KK) + i * 256, (prm + PB_KA) + i * 256, kk_b, w_b, kka_b, kd_b, vb, lds);
        }
        GBAR
        { PHASE
        for (int vb_ = lsgpr(bid); vb_ < 32 * 132 * CHUNKREP; vb_ += nb) {
            const int vb = vb_ % (32 * 132);
            const int mc = vb / 132, n = vb % 132;
            if (mc < 16) f_chunk_gdn(gq, gk, gv, gab, XC, mc, n, (char*)lds);
            else f_chunk_rwkv(P, kk_b, w_b, kka_b, kd_b, XC, mc - 16, n, (char*)lds);
        }
        }
        GBAR
        { PHASE
        REPS(6) if (lsgpr(bid) < 32) f_scan2(XC, so, bid);
        REPS(7) {
            const int per_q = i == 0 ? 132 : 128;
            int* sidx = (int*)(lds + 18432 + 128);
            const int q0 = (int)(((volatile unsigned*)(lds + 18432 + 132))[2] & 7u);
            for (int qi = 0; qi < 8; ++qi) {
                const int q = (q0 + qi) & 7;
                for (;;) {
                    __syncthreads();
                    if (threadIdx.x == 0) *sidx = atomicAdd(cnt + 16 * (i + 2 * rep_) + q, 1);
                    __syncthreads();
                    const int u = *sidx;
                    if (u >= per_q) break;
                    const int uqb = u < 128 ? 2 + (u >> 1) : ((u - 128) >> 1);
                    f_attn(P, VT, OM, q, u & 1, uqb, (char*)lds);
                }
            }
        }
        }
        GBAR
        { PHASE
        REPS(8) for (int vb = lsgpr(bid); vb < RR / 8; vb += nb) f_mix_out(P, cat, so, (prm + PB_GNORM) + i * 64, kd_b, (prm + PB_GUP) + (size_t)i * 64 * 256, (prm + PB_RK) + i * 256, (prm + PB_GNW) + i * 256, (prm + PB_GNB) + i * 256, OM, (prm + PB_LAM) + (size_t)i * 256, (prm + PB_DAN) + (size_t)i * 128, lam_init, vb, lds);
        REPS(9) for (int vb = lsgpr(bid); vb < 3 * 2048; vb += nb) {
            const int which = vb / 2048, q = vb % 2048, e = q / 128, qq = q % 128;
            const size_t le = (size_t)(i * NE + e);
            if (which == 0) f_wconv(a.in[I_MGATE] + le * DM * DM, DM, wt_gu + (size_t)e * 2 * DM * DM, 1, qq / 8, qq % 8, lds);
            else if (which == 1) f_wconv(a.in[I_MUP] + le * DM * DM, DM, wt_gu + (size_t)e * 2 * DM * DM, 2, qq / 8, qq % 8, lds);
            else f_wconv(a.in[I_MDOWN] + le * DM * DM, DM, wt_dn + (size_t)e * DM * DM, 0, qq / 8, qq % 8, lds);
        }
        }
        GBAR
        { PHASE
        REPS(10) for (int vb = lsgpr(bid); vb < 132 * 8; vb += nb) {
            const int mt = vb / 8, nt = vb % 8;
            RowDense ap{cat + (size_t)mt * 128 * DM, DM}; RowDense bp{wt_out + (size_t)i * DM * DM + (size_t)nt * 128 * DM, DM};
            EpiF32 ep{mix, DM, mt * 128, nt * 128};
            gemm128(ap, bp, DM, ep, (char*)lds);
        }
        }
        GBAR
        { PHASE
        f_resid1_prep((prm + PB_ROUTER) + (size_t)i * DM * NE, lds);
        for (int vb = lsgpr(bid); vb < RR / 4; vb += nb) f_resid1(ctxs, out, mix, (prm + PB_NPOST) + (size_t)(i * 2 + 0) * DM, (prm + PB_NPRE) + (size_t)(i * 2 + 1) * DM, modl, lds, h2, aff, vb);
        }
        GBAR
        { PHASE
        REPS(11) for (int vb = lsgpr(bid); vb < 64; vb += nb) f_topk(aff, sel_lat, sel_ctx, slot, vb, lds);
        }
        GBAR
        { PHASE
        REPS(12) for (int vb = lsgpr(bid); vb < 32 * 8 * 16 + 32 * 16; vb += nb) {
            int g, mt, nt, cap; const int* sel; bf16_t* hid;
            if (vb < 32 * 8 * 16) { g = vb / 128; mt = (vb % 128) / 16; nt = vb % 16; cap = CAPL; sel = sel_lat + g * CAPL; hid = hid_lat + (size_t)g * CAPL * DM; }
            else { int t = vb - 32 * 8 * 16; g = t / 16; mt = 0; nt = t % 16; cap = CAPC; sel = sel_ctx + g * CAPC; hid = hid_ctx + (size_t)g * CAPC * DM; }
            const int e = g % NE;
            RowGather ap{h2, sel + mt * 128, cap - mt * 128}; RowDense bp{wt_gu + ((size_t)e * 2 * DM + (size_t)nt * 128) * DM, DM};
            EpiMoE1 ep{hid, mt * 128, nt * 128, cap};
            gemm128(ap, bp, DM, ep, (char*)lds);
        }
        }
        GBAR
        { PHASE
        REPS(13) for (int vb = lsgpr(bid); vb < 32 * 8 * 8 + 32 * 8; vb += nb) {
            int g, mt, nt, cap; const int* sel; const bf16_t* hid; bf16_t* ye;
            if (vb < 32 * 8 * 8) { g = vb / 64; mt = (vb % 64) / 8; nt = vb % 8; cap = CAPL; sel = sel_lat + g * CAPL; hid = hid_lat + (size_t)g * CAPL * DM; ye = ye_lat + (size_t)g * CAPL * DM; }
            else { int t = vb - 32 * 8 * 8; g = t / 8; mt = 0; nt = t % 8; cap = CAPC; sel = sel_ctx + g * CAPC; hid = hid_ctx + (size_t)g * CAPC * DM; ye = ye_ctx + (size_t)g * CAPC * DM; }
            const int e = g % NE;
            RowDense ap{hid + (size_t)mt * 128 * DM, DM}; RowDense bp{wt_dn + ((size_t)e * DM + (size_t)nt * 128) * DM, DM};
            EpiMoE2 ep{ye, aff, sel, e, mt * 128, nt * 128, cap};
            gemm128(ap, bp, DM, ep, (char*)lds);
        }
        }
        GBAR
        { PHASE
        for (int vb = lsgpr(bid); vb < RR / 4; vb += nb) f_resid2(ctxs, out, ye_lat, ye_ctx, slot, (prm + PB_NPOST) + (size_t)(i * 2 + 1) * DM, modl, vb);
        }
        GBAR
    }
}

#undef bar
#undef cnt
#undef prm
#undef mod
#undef ctxs
#undef aff
#undef tab
#undef slot
#undef sel_lat
#undef sel_ctx
#undef wt_in
#undef wt_out
#undef bufA
#undef so
#undef P
#undef R3
#undef VT
#undef XC
#undef OM
#undef gq
#undef gk
#undef gv
#undef kk_b
#undef kka_b
#undef kd_b
#undef w_b
#undef gab
#undef mix
#undef ye_lat
#undef ye_ctx
#undef hid_lat
#undef hid_ctx
#undef h
#undef cat
#undef h2
#undef wt_gu
#undef wt_dn
#undef modl
extern "C" void kernel_launch(void* const* d_in, const int* in_sizes, int n_in, void* d_out, int out_size, void* d_ws, size_t ws_size, hipStream_t stream) {
    static int grid_blocks = 0;
    if (!grid_blocks) {
        int dev = 0, cus = 0, per_cu = 0;
        (void)hipGetDevice(&dev);
        (void)hipDeviceGetAttribute(&cus, hipDeviceAttributeMultiprocessorCount, dev);
        (void)hipOccupancyMaxActiveBlocksPerMultiprocessor(&per_cu, mega, 256, 0);
        if (per_cu < 1) per_cu = 1;
        if (per_cu > 2) per_cu = 2;
        grid_blocks = cus * per_cu;
    }
    if (WS_END > ws_size) { fprintf(stderr, "workspace too small: need %zu have %zu\n", (size_t)WS_END, ws_size); return; }
    MP a{};
    for (int i = 0; i < 30; ++i) a.in[i] = (const float*)d_in[i];
    a.out = (float*)d_out; a.ws = (char*)d_ws;
    (void)hipMemsetAsync((char*)d_ws + WS_BAR, 0, 16384 + 256, stream);
    void* args[] = {&a};
    hipError_t e = hipLaunchCooperativeKernel((void*)mega, dim3(grid_blocks), dim3(256), args, 0, stream);
    if (e != hipSuccess) fprintf(stderr, "cooperative launch failed: %s (grid %d)\n", hipGetErrorString(e), grid_blocks);
}
```

```cpp
#include <hip/hip_runtime.h>
#include <stdint.h>
#include <stdio.h>
#include <hip/hip_cooperative_groups.h>
namespace cg = cooperative_groups;

#define NB 2
#define TL 8192
#define CL 256
#define SS 8448
#define RR 16896
#define DM 1024
#define DIN 3472
#define DINP 3584
#define NE 16
#define CAPL 1024
#define CAPC 32
#define OQ 0
#define OKK 512
#define OV 1024
#define OGQKV 1536
#define OGGATE 2304
#define OGA 2560
#define OGB 2568
#define ORKV 2576
#define OXW 3344
#define OXA 3376
#define OXG 3408

typedef unsigned short bf16_t;
typedef short bf16x8 __attribute__((ext_vector_type(8)));
typedef float f32x4 __attribute__((ext_vector_type(4)));
typedef unsigned u32x4 __attribute__((ext_vector_type(4)));
typedef unsigned u32x2 __attribute__((ext_vector_type(2)));
typedef float f32x16 __attribute__((ext_vector_type(16)));
#define MFMA32(a, b, c) __builtin_amdgcn_mfma_f32_32x32x16_bf16((a), (b), (c), 0, 0, 0)
__device__ __forceinline__ int crow(int r, int h) { return (r & 3) + 8 * (r >> 2) + 4 * h; }

#define LAUNDER(x) asm volatile("" : "+v"(x))
__device__ __forceinline__ int lsgpr(int x) { asm volatile("" : "+s"(x)); return x; }
__device__ __forceinline__ int ltid() { int t = threadIdx.x; LAUNDER(t); return t; }
__device__ __forceinline__ float siluf(float x) { return x / (1.f + expf(-x)); }
__device__ __forceinline__ float sigmf(float x) { return 1.f / (1.f + expf(-x)); }
__device__ __forceinline__ float dpp_ror(float v, int) { return v; }
#define DPP_ROR_ADD(v, n) v += __builtin_bit_cast(float, __builtin_amdgcn_update_dpp(0, __builtin_bit_cast(int, v), 0x120 + (n), 0xf, 0xf, false))
__device__ __forceinline__ float wave_sum(float v) {
    DPP_ROR_ADD(v, 8); DPP_ROR_ADD(v, 4); DPP_ROR_ADD(v, 2); DPP_ROR_ADD(v, 1);
    const int iv = __builtin_bit_cast(int, v);
    const float a = __builtin_bit_cast(float, __builtin_amdgcn_readlane(iv, 0)), b = __builtin_bit_cast(float, __builtin_amdgcn_readlane(iv, 16));
    const float c = __builtin_bit_cast(float, __builtin_amdgcn_readlane(iv, 32)), d = __builtin_bit_cast(float, __builtin_amdgcn_readlane(iv, 48));
    return (a + b) + (c + d);
}
__device__ __forceinline__ unsigned pk2bf(float lo, float hi) {
    typedef float f2 __attribute__((ext_vector_type(2))); typedef __bf16 b2 __attribute__((ext_vector_type(2)));
    f2 v = {lo, hi}; b2 b = __builtin_convertvector(v, b2); return __builtin_bit_cast(unsigned, b);
}
__device__ __forceinline__ bf16_t f2bf(float f) { return (bf16_t)(pk2bf(f, 0.f) & 0xffffu); }
__device__ __forceinline__ float bf2f(bf16_t u) { return __uint_as_float(((unsigned)u) << 16); }
__device__ __forceinline__ float* xrow_ptr(float* ctxs, float* out, int r) {
    int b = r >= SS ? 1 : 0, s = r - b * SS;
    return s < CL ? ctxs + ((size_t)(b * CL + s)) * DM : out + ((size_t)(b * TL + (s - CL))) * DM;
}
__device__ __forceinline__ int modrow(int r) { int b = r >= SS ? 1 : 0, s = r - b * SS; return s < CL ? 2 : b; }

__device__ __forceinline__ void f_init(const float* __restrict__ x, const float* __restrict__ ctx, float* out, float* ctxs, int vb, int nvb) {
    const int TID = ltid();
    size_t i = (size_t)vb * 256 + TID;
    size_t n1 = (size_t)NB * TL * DM / 4, n2 = (size_t)NB * CL * DM / 4;
    for (size_t j = i; j < n1; j += (size_t)nvb * 256) ((float4*)out)[j] = ((const float4*)x)[j];
    for (size_t j = i; j < n2; j += (size_t)nvb * 256) ((float4*)ctxs)[j] = ((const float4*)ctx)[j];
}

__device__ __forceinline__ void f_mod1(const float* __restrict__ c, const float* __restrict__ c_ctx, const float* __restrict__ w_mod, float* modp, int item, float* lds) {
    const int TID = ltid();
    float* cs = lds;
    const int kc = item & 31, cb = (item >> 5) % 6, l = item / 192;
    __syncthreads();
    if (TID < 96) { const int k = TID & 31, j = TID >> 5; const float v = j == 0 ? c[kc * 32 + k] : (j == 1 ? c[DM + kc * 32 + k] : c_ctx[kc * 32 + k]); cs[k * 4 + j] = siluf(v); }
    __syncthreads();
    const float* w = w_mod + ((size_t)l * DM + kc * 32) * 6 * DM + cb * 1024 + 4 * TID;
    f32x4 a0 = (f32x4){0.f, 0.f, 0.f, 0.f}, a1 = a0, a2 = a0;
#pragma unroll 8
    for (int k = 0; k < 32; ++k) {
        const f32x4 wv = *(const f32x4*)(w + (size_t)k * 6 * DM);
        const f32x4 cv = *(const f32x4*)(cs + k * 4);
        a0 += wv * cv[0]; a1 += wv * cv[1]; a2 += wv * cv[2];
    }
    float* dst = modp + ((size_t)(kc * 2 + l) * 3) * 6 * DM + cb * 1024 + 4 * TID;
    *(f32x4*)(dst) = a0; *(f32x4*)(dst + 6 * DM) = a1; *(f32x4*)(dst + 2 * 6 * DM) = a2;
}
__device__ __forceinline__ void f_mod2(const float* __restrict__ modp, const float* __restrict__ b_mod, float* mod, int vb) {
    const int idx = vb * 256 + ltid();
    const int l = idx / (3 * 6 * DM), n = idx % (6 * DM);
    float acc = b_mod[l * 6 * DM + n];
    const int j = (idx / (6 * DM)) % 3;
#pragma unroll 8
    for (int kc = 0; kc < 32; ++kc) acc += modp[((size_t)(kc * 2 + l) * 3 + j) * 6 * DM + n];
    mod[idx] = acc;
}

__device__ __forceinline__ void f_wconv(const float* __restrict__ W, int N, bf16_t* Wt, int rowmap, int kt, int nt, float* lds) {
    const int TID = ltid();
    float (*T)[129] = (float (*)[129])lds;
    const int tid = TID;
    __syncthreads();
    f32x4 v[8];
#pragma unroll
    for (int i = 0; i < 8; ++i) {
        const int k = (tid >> 5) + 8 * i, n4 = (tid & 31) * 4;
        const int gn = nt * 128 + n4;
        v[i] = gn < N ? *(const f32x4*)(W + (size_t)(kt * 64 + k) * N + gn) : (f32x4){0.f, 0.f, 0.f, 0.f};
    }
#pragma unroll
    for (int i = 0; i < 8; ++i) {
        const int k = (tid >> 5) + 8 * i, n4 = (tid & 31) * 4;
        T[k][n4] = v[i][0]; T[k][n4 + 1] = v[i][1]; T[k][n4 + 2] = v[i][2]; T[k][n4 + 3] = v[i][3];
    }
    __syncthreads();
#pragma unroll
    for (int i = 0; i < 4; ++i) {
        const int n = (tid >> 3) + 32 * i, kc = tid & 7;
        const int gn = nt * 128 + n;
        const int drow = rowmap == 0 ? gn : (32 * (gn >> 4) + (gn & 15) + (rowmap == 2 ? 16 : 0));
        u32x4 o;
        o[0] = pk2bf(T[kc * 8 + 0][n], T[kc * 8 + 1][n]); o[1] = pk2bf(T[kc * 8 + 2][n], T[kc * 8 + 3][n]);
        o[2] = pk2bf(T[kc * 8 + 4][n], T[kc * 8 + 5][n]); o[3] = pk2bf(T[kc * 8 + 6][n], T[kc * 8 + 7][n]);
        *(u32x4*)(Wt + (size_t)drow * DM + kt * 64 + kc * 8) = o;
    }
}

__device__ __forceinline__ void f_normmod(float* ctxs, float* out, const float* __restrict__ g, const float* __restrict__ modl, int sh_off, int sc_off, bf16_t* h, int vb) {
    const int TID = ltid();
    int r = vb * 4 + (TID >> 6), lane = TID & 63;
    const float* x = xrow_ptr(ctxs, out, r);
    const float* m = modl + modrow(r) * 6 * DM;
    f32x4 v[4]; float ss = 0.f;
#pragma unroll
    for (int j = 0; j < 4; ++j) { v[j] = *(const f32x4*)(x + 4 * lane + 256 * j); ss += v[j][0] * v[j][0] + v[j][1] * v[j][1] + v[j][2] * v[j][2] + v[j][3] * v[j][3]; }
    ss = wave_sum(ss);
    float rstd = rsqrtf(ss * (1.f / DM) + 1e-6f);
#pragma unroll
    for (int j = 0; j < 4; ++j) {
        int c0 = 4 * lane + 256 * j;
        f32x4 gg = *(const f32x4*)(g + c0), sc = *(const f32x4*)(m + sc_off + c0), sh = *(const f32x4*)(m + sh_off + c0);
        f32x4 o4 = v[j] * rstd * gg * (1.f + sc) + sh;
        u32x2 o; o[0] = pk2bf(o4[0], o4[1]); o[1] = pk2bf(o4[2], o4[3]);
        *(u32x2*)(h + (size_t)r * DM + c0) = o;
    }
}

#define LDS_AS __attribute__((address_space(3)))
template <class AP, class BP, class Epi>
__device__ __forceinline__ void gemm128(const AP& aptr, const BP& bptr, int K, const Epi& epi, char* lds) {
    const int TID = ltid();
    const int tid = TID, lane = tid & 63, wid = __builtin_amdgcn_readfirstlane(tid >> 6), wr = wid >> 1, wc = wid & 1, fr = lane & 15, fq = lane >> 4;
    const bf16_t* ag[4]; const bf16_t* bg[4];
#pragma unroll
    for (int i = 0; i < 4; ++i) {
        const int row = 8 * (4 * i + wid) + (lane >> 3), ch = (lane & 7) ^ ((row >> 1) & 7);
        ag[i] = aptr(row) + ch * 8; bg[i] = bptr(row) + ch * 8;
    }
    f32x4 acc[4][4];
#pragma unroll
    for (int m = 0; m < 4; ++m)
#pragma unroll
        for (int n = 0; n < 4; ++n) acc[m][n] = (f32x4){0.f, 0.f, 0.f, 0.f};
    LDS_AS char* l3 = (LDS_AS char*)lds;
    __syncthreads();
#pragma unroll
    for (int i = 0; i < 4; ++i) {
        __builtin_amdgcn_global_load_lds((const unsigned*)ag[i], (LDS_AS unsigned*)(l3 + (4 * i + wid) * 1024), 16, 0, 0);
        __builtin_amdgcn_global_load_lds((const unsigned*)bg[i], (LDS_AS unsigned*)(l3 + 16384 + (4 * i + wid) * 1024), 16, 0, 0);
    }
    __syncthreads();
    const int nk = K / 64;
    const int swz = fr >> 1;
    for (int kt = 0; kt < nk; ++kt) {
        const int buf = kt & 1;
        if (kt + 1 < nk) {
#pragma unroll
            for (int i = 0; i < 4; ++i) {
                __builtin_amdgcn_global_load_lds((const unsigned*)(ag[i] + (kt + 1) * 64), (LDS_AS unsigned*)(l3 + (buf ^ 1) * 32768 + (4 * i + wid) * 1024), 16, 0, 0);
                __builtin_amdgcn_global_load_lds((const unsigned*)(bg[i] + (kt + 1) * 64), (LDS_AS unsigned*)(l3 + (buf ^ 1) * 32768 + 16384 + (4 * i + wid) * 1024), 16, 0, 0);
            }
        }
        const char* la = lds + buf * 32768; const char* lb = la + 16384;
#pragma unroll
        for (int ks = 0; ks < 2; ++ks) {
            bf16x8 af[4], bfr[4];
            const int coff = ((ks * 4 + fq) ^ swz) << 4;
#pragma unroll
            for (int m = 0; m < 4; ++m) af[m] = *(const bf16x8*)(la + (wr * 64 + m * 16 + fr) * 128 + coff);
#pragma unroll
            for (int n = 0; n < 4; ++n) bfr[n] = *(const bf16x8*)(lb + (wc * 64 + n * 16 + fr) * 128 + coff);
#pragma unroll
            for (int m = 0; m < 4; ++m)
#pragma unroll
                for (int n = 0; n < 4; ++n) acc[m][n] = __builtin_amdgcn_mfma_f32_16x16x32_bf16(bfr[n], af[m], acc[m][n], 0, 0, 0);
        }
        __syncthreads();
    }
    epi(acc, wr, wc, fr, fq);
}

struct RowDense { const bf16_t* base; size_t ld; __device__ __forceinline__ const bf16_t* operator()(int row) const { return base + (size_t)row * ld; } };
struct RowGather { const bf16_t* base; const int* idx; int maxrow; __device__ __forceinline__ const bf16_t* operator()(int row) const { int r = row < maxrow ? row : maxrow - 1; return base + (size_t)idx[r] * DM; } };

struct EpiInProj {
    bf16_t* P; bf16_t* VT; const float2* tab; int m0, n0;
    __device__ __forceinline__ void operator()(f32x4 (&acc)[4][4], int wr, int wc, int fr, int fq) const {
        const bool rope = n0 < 1024;
        const bool isv = n0 >= OV && n0 < OGQKV;
#pragma unroll
        for (int m = 0; m < 4; ++m) {
            const int r = m0 + wr * 64 + m * 16 + fr;
            const int b = r / SS, s = r % SS;
            if (rope && s >= CL) {
                const int t = s - CL;
#pragma unroll
                for (int ax = 0; ax < 2; ++ax) {
                    const int pos = ax == 0 ? (t >> 6) : (t & 63);
#pragma unroll
                    for (int j = 0; j < 4; ++j) {
                        const float2 cs = tab[pos * 16 + 4 * fq + j];
                        const float x1 = acc[m][2 * ax][j], x2 = acc[m][2 * ax + 1][j];
                        acc[m][2 * ax][j] = x1 * cs.x - x2 * cs.y;
                        acc[m][2 * ax + 1][j] = x2 * cs.x + x1 * cs.y;
                    }
                }
            }
            if (isv) {
                const int u = s & 15;
                const int ps = (s & ~15) | (((u >> 2) & 1) << 3) | ((u >> 3) << 2) | (u & 3);
#pragma unroll
                for (int n = 0; n < 4; ++n)
#pragma unroll
                    for (int j = 0; j < 4; ++j) {
                        const int c = n0 - OV + wc * 64 + n * 16 + 4 * fq + j;
                        VT[((size_t)(b * 4 + (c >> 7)) * 128 + (c & 127)) * SS + ps] = f2bf(acc[m][n][j]);
                    }
            } else {
#pragma unroll
                for (int n = 0; n < 4; ++n) {
                    u32x2 o; o[0] = pk2bf(acc[m][n][0], acc[m][n][1]); o[1] = pk2bf(acc[m][n][2], acc[m][n][3]);
                    *(u32x2*)(P + (size_t)r * DINP + n0 + wc * 64 + n * 16 + 4 * fq) = o;
                }
            }
        }
    }
};
struct EpiF32 {
    float* C; int ldc; int m0, n0;
    __device__ __forceinline__ void operator()(f32x4 (&acc)[4][4], int wr, int wc, int fr, int fq) const {
#pragma unroll
        for (int m = 0; m < 4; ++m)
#pragma unroll
            for (int n = 0; n < 4; ++n) *(f32x4*)(C + (size_t)(m0 + wr * 64 + m * 16 + fr) * ldc + n0 + wc * 64 + n * 16 + 4 * fq) = acc[m][n];
    }
};
struct EpiMoE1 {
    bf16_t* hid; int m0, n0, cap;
    __device__ __forceinline__ void operator()(f32x4 (&acc)[4][4], int wr, int wc, int fr, int fq) const {
#pragma unroll
        for (int m = 0; m < 4; ++m) {
            const int r = m0 + wr * 64 + m * 16 + fr;
            if (r >= cap) continue;
#pragma unroll
            for (int q = 0; q < 2; ++q) {
                float v[4];
#pragma unroll
                for (int j = 0; j < 4; ++j) v[j] = siluf(acc[m][2 * q][j]) * acc[m][2 * q + 1][j];
                u32x2 o; o[0] = pk2bf(v[0], v[1]); o[1] = pk2bf(v[2], v[3]);
                *(u32x2*)(hid + (size_t)r * DM + (n0 >> 1) + wc * 32 + q * 16 + 4 * fq) = o;
            }
        }
    }
};
struct EpiMoE2 {
    bf16_t* ye; const float* aff; const int* sel; int e, m0, n0, cap;
    __device__ __forceinline__ void operator()(f32x4 (&acc)[4][4], int wr, int wc, int fr, int fq) const {
#pragma unroll
        for (int m = 0; m < 4; ++m) {
            const int r = m0 + wr * 64 + m * 16 + fr;
            if (r >= cap) continue;
            const float sc = aff[(size_t)sel[r] * NE + e];
#pragma unroll
            for (int n = 0; n < 4; ++n) {
                u32x2 o; o[0] = pk2bf(acc[m][n][0] * sc, acc[m][n][1] * sc); o[1] = pk2bf(acc[m][n][2] * sc, acc[m][n][3] * sc);
                *(u32x2*)(ye + (size_t)r * DM + n0 + wc * 64 + n * 16 + 4 * fq) = o;
            }
        }
    }
};

#define ATT_WAIT_V(n) asm volatile("s_waitcnt vmcnt(" #n ")" ::: "memory")
#define ATT_WAIT_L0() asm volatile("s_waitcnt lgkmcnt(0)" ::: "memory")
__device__ __forceinline__ void f_attn(const bf16_t* __restrict__ P, const bf16_t* __restrict__ VT, bf16_t* OM, int bh, int map, int qb, char* lds) {
    const int TID = ltid();
    const int lane = TID & 63, wid = TID >> 6, ql = lane & 31, hi = lane >> 5;
    const int b = bh >> 2, h = bh & 3;
    const int row0 = b * SS + qb * 128;
    const int ntiles = (qb < 2 ? CL : SS) / 64;
    const float C = 0.125f * 1.4426950408889634f;
    float* wsf = (float*)(lds + 73728) + wid * 32;
    const int wu = __builtin_amdgcn_readfirstlane(wid);
    const bf16_t* kg[2]; const bf16_t* vg[4];
#pragma unroll
    for (int i = 0; i < 2; ++i) {
        const int krow = 8 * (wu + 4 * i) + (lane >> 3);
        kg[i] = P + (size_t)(b * SS + krow) * DINP + OKK + h * 128 + map * 64 + (((lane & 7) ^ ((krow >> 1) & 7)) << 3);
    }
#pragma unroll
    for (int i = 0; i < 4; ++i) {
        const int vrow = 8 * (wu + 4 * i) + (lane >> 3);
        vg[i] = VT + (size_t)(bh * 128 + vrow) * SS + (((lane & 7) ^ ((vrow >> 1) & 7)) << 3);
    }
    bf16x8 qf[4];
    {
        const bf16_t* qp = P + (size_t)(row0 + wid * 32 + ql) * DINP + OQ + h * 128 + map * 64 + 8 * hi;
#pragma unroll
        for (int d0 = 0; d0 < 4; ++d0) qf[d0] = *(const bf16x8*)(qp + 16 * d0);
    }
    f32x16 O[4];
#pragma unroll
    for (int cb = 0; cb < 4; ++cb)
#pragma unroll
        for (int r = 0; r < 16; ++r) O[cb][r] = 0.f;
    float mrun = -1e30f, lrun = 0.f;
    LDS_AS char* l3 = (LDS_AS char*)lds;
#define ATT_STAGE(t_, st_) do { \
        _Pragma("unroll") for (int i_ = 0; i_ < 2; ++i_) __builtin_amdgcn_global_load_lds((const unsigned*)(kg[i_] + (size_t)(t_) * 64 * DINP), (LDS_AS unsigned*)(l3 + (st_) * 24576 + (wu + 4 * i_) * 1024), 16, 0, 0); \
        _Pragma("unroll") for (int i_ = 0; i_ < 4; ++i_) __builtin_amdgcn_global_load_lds((const unsigned*)(vg[i_] + (t_) * 64), (LDS_AS unsigned*)(l3 + (st_) * 24576 + 8192 + (wu + 4 * i_) * 1024), 16, 0, 0); } while (0)
    ATT_WAIT_V(0); ATT_WAIT_L0();
    __builtin_amdgcn_s_barrier();
    ATT_STAGE(0, 0);
    if (ntiles > 1) ATT_STAGE(1, 1);
    if (ntiles > 1) ATT_WAIT_V(6); else ATT_WAIT_V(0);
    __builtin_amdgcn_s_barrier();
    const int swz = (ql >> 1) & 7;
    int st = 0;
    for (int t = 0; t < ntiles; ++t) {
        const int st2 = st >= 1 ? st - 1 : 2;
        if (t + 2 < ntiles) ATT_STAGE(t + 2, st2);
        const char* kb = lds + st * 24576;
        const char* vb = kb + 8192;
        f32x16 p0, p1;
#pragma unroll
        for (int r = 0; r < 16; ++r) { p0[r] = 0.f; p1[r] = 0.f; }
        bf16x8 kf[8];
#pragma unroll
        for (int d0 = 0; d0 < 4; ++d0) {
            const int co = ((2 * d0 + hi) ^ swz) << 4;
            kf[2 * d0] = *(const bf16x8*)(kb + ql * 128 + co);
            kf[2 * d0 + 1] = *(const bf16x8*)(kb + (32 + ql) * 128 + co);
        }
#pragma unroll
        for (int d0 = 0; d0 < 4; ++d0) p0 = MFMA32(kf[2 * d0], qf[d0], p0);
        bf16x8 vf[8];
#pragma unroll
        for (int cb = 0; cb < 4; ++cb)
#pragma unroll
            for (int s = 0; s < 2; ++s) vf[cb * 2 + s] = *(const bf16x8*)(vb + (cb * 32 + ql) * 128 + (((2 * s + hi) ^ swz) << 4));
#pragma unroll
        for (int d0 = 0; d0 < 4; ++d0) p1 = MFMA32(kf[2 * d0 + 1], qf[d0], p1);
#define ATT_SOFTMAX_HALF(PP, PF0, PF1) do { \
        float tm_ = PP[0]; \
        _Pragma("unroll") for (int r = 1; r < 16; ++r) tm_ = fmaxf(tm_, PP[r]); \
        { auto rr_ = __builtin_amdgcn_permlane32_swap(__float_as_uint(tm_), __float_as_uint(tm_), false, false); tm_ = fmaxf(__uint_as_float(rr_[0]), __uint_as_float(rr_[1])); } \
        const float mnew_ = fmaxf(mrun, tm_); \
        if (__any((mnew_ - mrun) * C > 8.f)) { \
            const float alpha_ = __builtin_amdgcn_exp2f((mrun - mnew_) * C); \
            lrun *= alpha_; mrun = mnew_; \
            if (hi == 0) wsf[ql] = alpha_; \
            ATT_WAIT_L0(); \
            _Pragma("unroll") for (int r = 0; r < 16; ++r) { const float f_ = wsf[crow(r, hi)]; _Pragma("unroll") for (int cb = 0; cb < 4; ++cb) O[cb][r] *= f_; } \
        } \
        const float mc_ = mrun * C; float ls_ = 0.f; \
        _Pragma("unroll") for (int r = 0; r < 16; ++r) { PP[r] = __builtin_amdgcn_exp2f(fmaf(PP[r], C, -mc_)); ls_ += PP[r]; } \
        lrun += ls_; \
        { u32x4 w_; _Pragma("unroll") for (int j = 0; j < 4; ++j) w_[j] = pk2bf(PP[2 * j], PP[2 * j + 1]); PF0 = __builtin_bit_cast(bf16x8, w_); } \
        { u32x4 w_; _Pragma("unroll") for (int j = 0; j < 4; ++j) w_[j] = pk2bf(PP[8 + 2 * j], PP[8 + 2 * j + 1]); PF1 = __builtin_bit_cast(bf16x8, w_); } } while (0)
        bf16x8 pfa, pfb;
        ATT_SOFTMAX_HALF(p0, pfa, pfb);
#pragma unroll
        for (int cb = 0; cb < 4; ++cb) { O[cb] = MFMA32(pfa, vf[cb * 2], O[cb]); O[cb] = MFMA32(pfb, vf[cb * 2 + 1], O[cb]); }
#pragma unroll
        for (int cb = 0; cb < 4; ++cb)
#pragma unroll
            for (int s = 0; s < 2; ++s) vf[cb * 2 + s] = *(const bf16x8*)(vb + (cb * 32 + ql) * 128 + (((2 * (2 + s) + hi) ^ swz) << 4));
        ATT_SOFTMAX_HALF(p1, pfa, pfb);
#pragma unroll
        for (int cb = 0; cb < 4; ++cb) { O[cb] = MFMA32(pfa, vf[cb * 2], O[cb]); O[cb] = MFMA32(pfb, vf[cb * 2 + 1], O[cb]); }
#undef ATT_SOFTMAX_HALF
        if (t + 2 < ntiles) ATT_WAIT_V(6); else ATT_WAIT_V(0);
        ATT_WAIT_L0();
        __builtin_amdgcn_s_barrier();
        __builtin_amdgcn_sched_barrier(0);
        st = st == 2 ? 0 : st + 1;
    }
#undef ATT_STAGE
    { auto rr = __builtin_amdgcn_permlane32_swap(__float_as_uint(lrun), __float_as_uint(lrun), false, false); lrun = __uint_as_float(rr[0]) + __uint_as_float(rr[1]); }
    if (hi == 0) wsf[ql] = 1.f / lrun;
    ATT_WAIT_L0();
    bf16_t* dst = OM + ((size_t)map * RR + row0 + wid * 32) * 512 + h * 128 + ql;
#pragma unroll
    for (int r = 0; r < 16; ++r) {
        const int q = crow(r, hi);
        const float f = wsf[q];
#pragma unroll
        for (int cb = 0; cb < 4; ++cb) dst[(size_t)q * 512 + cb * 32] = f2bf(O[cb][r] * f);
    }
}

__device__ __forceinline__ void f_gdn_prep(const bf16_t* __restrict__ p, const float* __restrict__ conv_w, const float* __restrict__ a_log,
                                                  const float* __restrict__ dt_bias, bf16_t* gq, bf16_t* gk, bf16_t* gv, float* gab, int vb) {
    const int TID = ltid();
    const int r0 = vb * 8, c = TID;
    const int b = r0 >= SS ? 1 : 0, s0 = r0 - b * SS;
    const int seg_lo = s0 < CL ? 0 : CL, seg_hi = s0 < CL ? CL : SS;
    float xin[3][12];
#pragma unroll
    for (int t = 0; t < 12; ++t) {
        const int s2 = s0 + t - 2;
        const bool ok = s2 >= seg_lo && s2 < seg_hi;
        const bf16_t* rp = p + (size_t)(b * SS + (ok ? s2 : s0)) * DINP + OGQKV + c;
#pragma unroll
        for (int j3 = 0; j3 < 3; ++j3) { const float v = bf2f(rp[j3 * 256]); xin[j3][t] = ok ? v : 0.f; }
    }
    float cw[3][5];
#pragma unroll
    for (int j3 = 0; j3 < 3; ++j3)
#pragma unroll
        for (int j = 0; j < 5; ++j) cw[j3][j] = conv_w[j * 768 + j3 * 256 + c];
#pragma unroll
    for (int i = 0; i < 8; ++i) {
        float val[3];
#pragma unroll
        for (int j3 = 0; j3 < 3; ++j3) {
            float acc = 0.f;
#pragma unroll
            for (int j = 0; j < 5; ++j) acc += xin[j3][i + j] * cw[j3][j];
            val[j3] = siluf(acc);
        }
        const float sq = wave_sum(val[0] * val[0]);
        const float sk = wave_sum(val[1] * val[1]);
        const size_t r = r0 + i;
        gq[r * 256 + c] = f2bf(val[0] * rsqrtf(sq + 1e-12f) * 0.125f);
        gk[r * 256 + c] = f2bf(val[1] * rsqrtf(sk + 1e-12f));
        gv[r * 256 + c] = f2bf(val[2]);
    }
    if (c < 128) {
        const size_t r = r0 + (c >> 4); const int q = c & 15;
        if (q < 8) {
            const float av = bf2f(p[r * DINP + OGA + q]);
            const float xx = av + dt_bias[q];
            const float sp = xx > 20.f ? xx : log1pf(expf(xx));
            gab[r * 16 + q] = -expf(a_log[q]) * sp;
        } else {
            gab[r * 16 + q] = sigmf(bf2f(p[r * DINP + OGB + (q - 8)]));
        }
    }
}

__device__ __forceinline__ void f_rwkv_prep_phase(const bf16_t* __restrict__ p, const float* __restrict__ w0, const float* __restrict__ w_up,
                                                   const float* __restrict__ a0, const float* __restrict__ a_up, const float* __restrict__ k_k,
                                                   const float* __restrict__ k_a, bf16_t* kk_o, float* w_o, bf16_t* kka_o, bf16_t* kd_o, int vb0, int nvb, int nitems, float* lds) {
    const int TID = ltid();
    float* xwT = lds;
    float* xaT = lds + 256;
    const int c = TID;
    float wu[2][32], au[2][32];
#pragma unroll
    for (int d = 0; d < 2; ++d)
#pragma unroll
        for (int j = 0; j < 32; ++j) { wu[d][j] = w_up[(d * 32 + j) * 256 + c]; au[d][j] = a_up[(d * 32 + j) * 256 + c]; }
    const float kkc = k_k[c], kac = k_a[c];
    const float w0c[2] = {w0[c], w0[256 + c]}, a0c[2] = {a0[c], a0[256 + c]};
    for (int vb = vb0; vb < nitems; vb += nvb) {
        const int r0 = vb * 8;
        __syncthreads();
        {
            const int i = TID >> 5, j = TID & 31;
            const bf16_t* pr = p + (size_t)(r0 + i) * DINP;
            xwT[j * 8 + i] = tanhf(bf2f(pr[OXW + j]));
            xaT[j * 8 + i] = bf2f(pr[OXA + j]);
        }
        float k[8], kk[8];
#pragma unroll
        for (int i = 0; i < 8; ++i) k[i] = bf2f(p[(size_t)(r0 + i) * DINP + ORKV + 256 + c]);
#pragma unroll
        for (int i = 0; i < 8; ++i) {
            const float kq = k[i] * kkc;
            const float ss = wave_sum(kq * kq);
            kk[i] = kq * rsqrtf(ss + 1e-12f);
            kk_o[(size_t)(r0 + i) * 256 + c] = f2bf(kk[i]);
        }
        __syncthreads();
#pragma unroll
        for (int d = 0; d < 2; ++d) {
            float aw[8], aa[8];
#pragma unroll
            for (int i = 0; i < 8; ++i) { aw[i] = w0c[d]; aa[i] = a0c[d]; }
#pragma unroll
            for (int j = 0; j < 32; ++j) {
                const f32x4 x0 = *(const f32x4*)(xwT + j * 8), x1 = *(const f32x4*)(xwT + j * 8 + 4);
                const f32x4 y0 = *(const f32x4*)(xaT + j * 8), y1 = *(const f32x4*)(xaT + j * 8 + 4);
#pragma unroll
                for (int i = 0; i < 4; ++i) { aw[i] += x0[i] * wu[d][j]; aw[4 + i] += x1[i] * wu[d][j]; aa[i] += y0[i] * au[d][j]; aa[4 + i] += y1[i] * au[d][j]; }
            }
#pragma unroll
            for (int i = 0; i < 8; ++i) {
                const float logw = -0.6065306597126334f * sigmf(aw[i]);
                const float ad = sigmf(aa[i]);
                const size_t r = r0 + i;
                w_o[r * 512 + d * 256 + c] = logw;
                kka_o[r * 512 + d * 256 + c] = f2bf(kk[i] * ad);
                kd_o[r * 512 + d * 256 + c] = f2bf(k[i] * (1.f + (ad - 1.f) * kac));
            }
        }
    }
}

#define MFMA16(a, b, c) __builtin_amdgcn_mfma_f32_16x16x32_bf16((a), (b), (c), 0, 0, 0)
__device__ __forceinline__ int scan_row(int b, int dir, int p) {
    const int s = dir == 0 ? p : (p < CL ? (CL - 1 - p) : (CL + (TL - 1 - (p - CL))));
    return b * SS + s;
}
__device__ __forceinline__ void mm64(const char* A, const char* Bt, f32x4 (&acc)[4], int w, int fr, int fq) {
#pragma unroll
    for (int ks = 0; ks < 2; ++ks) {
        const int co = ((ks * 4 + fq) ^ (fr >> 1)) << 4;
        const bf16x8 af = *(const bf16x8*)(A + (16 * w + fr) * 128 + co);
#pragma unroll
        for (int n = 0; n < 4; ++n) { const bf16x8 bfr = *(const bf16x8*)(Bt + (16 * n + fr) * 128 + co); acc[n] = MFMA16(bfr, af, acc[n]); }
    }
}
__device__ __forceinline__ void zero4(f32x4 (&acc)[4]) {
#pragma unroll
    for (int n = 0; n < 4; ++n) acc[n] = (f32x4){0.f, 0.f, 0.f, 0.f};
}
__device__ __forceinline__ void tile_row_write(char* T, int c, const float (&x)[64]) {
#pragma unroll
    for (int ch = 0; ch < 8; ++ch) {
        u32x4 o; o[0] = pk2bf(x[8 * ch], x[8 * ch + 1]); o[1] = pk2bf(x[8 * ch + 2], x[8 * ch + 3]); o[2] = pk2bf(x[8 * ch + 4], x[8 * ch + 5]); o[3] = pk2bf(x[8 * ch + 6], x[8 * ch + 7]);
        *(u32x4*)(T + c * 128 + ((ch ^ ((c >> 1) & 7)) << 4)) = o;
    }
}
__device__ __forceinline__ void tri_solve_tile(const float* Am, char* T, int c) {
    const int rs = (c >> 1) & 7;
    char* rowp = T + c * 128;
#pragma unroll 1
    for (int b = 0; b < 8; ++b) {
        float acc[8];
        {
            const bf16x8 v = *(const bf16x8*)(rowp + ((b ^ rs) << 4));
#pragma unroll
            for (int e = 0; e < 8; ++e) acc[e] = bf2f((bf16_t)v[e]);
        }
        const float* Ab = Am + (8 * b) * 64;
#pragma unroll 1
        for (int ch = 0; ch < b; ++ch) {
            const bf16x8 v = *(const bf16x8*)(rowp + ((ch ^ rs) << 4));
            float xv[8];
#pragma unroll
            for (int e = 0; e < 8; ++e) xv[e] = bf2f((bf16_t)v[e]);
#pragma unroll
            for (int r = 0; r < 8; ++r) {
                const f32x4 a0 = *(const f32x4*)(Ab + r * 64 + 8 * ch), a1 = *(const f32x4*)(Ab + r * 64 + 8 * ch + 4);
                acc[r] -= ((a0[0] * xv[0] + a0[1] * xv[1]) + (a0[2] * xv[2] + a0[3] * xv[3])) + ((a1[0] * xv[4] + a1[1] * xv[5]) + (a1[2] * xv[6] + a1[3] * xv[7]));
            }
        }
        f32x4 d0[8], d1[8];
#pragma unroll
        for (int r = 1; r < 8; ++r) { d0[r] = *(const f32x4*)(Ab + r * 64 + 8 * b); d1[r] = *(const f32x4*)(Ab + r * 64 + 8 * b + 4); }
#pragma unroll
        for (int r = 1; r < 8; ++r) {
            float s = 0.f;
#pragma unroll
            for (int q = 0; q < r; ++q) s += (q < 4 ? d0[r][q & 3] : d1[r][q & 3]) * acc[q];
            acc[r] -= s;
        }
        u32x4 o; o[0] = pk2bf(acc[0], acc[1]); o[1] = pk2bf(acc[2], acc[3]); o[2] = pk2bf(acc[4], acc[5]); o[3] = pk2bf(acc[6], acc[7]);
        *(u32x4*)(rowp + ((b ^ rs) << 4)) = o;
    }
}
__device__ __forceinline__ void store_perm(bf16_t* dst, const f32x4 (&acc)[4], int w, int fr, int fq) {
#pragma unroll
    for (int n = 0; n < 4; ++n) {
        u32x2 o; o[0] = pk2bf(acc[n][0], acc[n][1]); o[1] = pk2bf(acc[n][2], acc[n][3]);
        *(u32x2*)(dst + (16 * w + fr) * 64 + 32 * (n >> 1) + 8 * fq + 4 * (n & 1)) = o;
    }
}
__device__ __forceinline__ void store_acc(bf16_t* dst, const f32x4 (&acc)[4], int w, int fr, int fq) {
#pragma unroll
    for (int n = 0; n < 4; ++n)
#pragma unroll
        for (int jj = 0; jj < 4; ++jj) dst[((n * 4 + w) * 64 + (4 * fq + jj) + 16 * (fr >> 2)) * 4 + (fr & 3)] = f2bf(acc[n][jj]);
}

#define TILE(k) (lds + (k) * 8192)
#define SCAL ((float*)(lds + 73728))
__device__ __forceinline__ float tile_get(const char* T, int i, int c3, int clow) { return bf2f(*(const bf16_t*)(T + i * 128 + (((c3 ^ ((i >> 1) & 7)) << 4) | clow))); }
__device__ __forceinline__ void tile_put(char* T, int i, int c3, int clow, float v) { *(bf16_t*)(T + i * 128 + (((c3 ^ ((i >> 1) & 7)) << 4) | clow)) = f2bf(v); }
__device__ __forceinline__ void stage_tile(char* T, const bf16_t* base, size_t ld, int b, int dir, int p0, int TID) {
#pragma unroll
    for (int k = 0; k < 2; ++k) {
        const int id = TID + 256 * k, row = id >> 3, chn = id & 7;
        const size_t r = scan_row(b, dir, p0 + row);
        *(u32x4*)(T + row * 128 + ((chn ^ ((row >> 1) & 7)) << 4)) = *(const u32x4*)(base + r * ld + chn * 8);
    }
}
__device__ __forceinline__ f32x4 tile_get4(const char* T, int i, int j0) {
    const u32x2 rv = *(const u32x2*)(T + i * 128 + (((j0 >> 3) ^ ((i >> 1) & 7)) << 4) + (j0 & 7) * 2);
    return (f32x4){bf2f((bf16_t)(rv[0] & 0xffffu)), bf2f((bf16_t)(rv[0] >> 16)), bf2f((bf16_t)(rv[1] & 0xffffu)), bf2f((bf16_t)(rv[1] >> 16))};
}
__device__ __forceinline__ void tile_put4(char* T, int i, int j0, float v0, float v1, float v2, float v3) {
    u32x2 o; o[0] = pk2bf(v0, v1); o[1] = pk2bf(v2, v3);
    *(u32x2*)(T + i * 128 + (((j0 >> 3) ^ ((i >> 1) & 7)) << 4) + (j0 & 7) * 2) = o;
}

__device__ __forceinline__ void f_chunk_gdn(const bf16_t* __restrict__ gq, const bf16_t* __restrict__ gk, const bf16_t* __restrict__ gv, const float* __restrict__ gab,
                                            bf16_t* X, int chain, int n, char* lds) {
    const int TID = ltid();
    const int lane = TID & 63, w = TID >> 6, fr = lane & 15, fq = lane >> 4;
    const int dir = chain & 1, h = (chain >> 1) & 3, b = chain >> 3;
    float* gcs = SCAL; float* bts = SCAL + 64;
    float* Am = (float*)TILE(7);
    __syncthreads();
    if (TID < 64) {
        const int r = scan_row(b, dir, n * 64 + TID);
        float g = gab[(size_t)r * 16 + dir * 4 + h];
#pragma unroll
        for (int o = 1; o < 64; o <<= 1) { const float t = __shfl_up(g, o); if (lane >= o) g += t; }
        gcs[TID] = g; bts[TID] = gab[(size_t)r * 16 + 8 + dir * 4 + h];
    }
    stage_tile(TILE(0), gq + h * 64, 256, b, dir, n * 64, TID);
    stage_tile(TILE(1), gk + h * 64, 256, b, dir, n * 64, TID);
    stage_tile(TILE(3), gv + h * 64, 256, b, dir, n * 64, TID);
    __syncthreads();
    {
        const int i = 16 * w + fr; const float gi = gcs[i], bi = bts[i];
        f32x4 acc[4]; zero4(acc); mm64(TILE(1), TILE(1), acc, w, fr, fq);
#pragma unroll
        for (int nn = 0; nn < 4; ++nn)
#pragma unroll
            for (int jj = 0; jj < 4; ++jj) { const int j = 16 * nn + 4 * fq + jj; Am[i * 64 + j] = j < i ? bi * acc[nn][jj] * __expf(gi - gcs[j]) : 0.f; }
        zero4(acc); mm64(TILE(0), TILE(1), acc, w, fr, fq);
#pragma unroll
        for (int nn = 0; nn < 4; ++nn) {
            float v[4];
#pragma unroll
            for (int jj = 0; jj < 4; ++jj) { const int j = 16 * nn + 4 * fq + jj; v[jj] = j <= i ? acc[nn][jj] * __expf(gi - gcs[j]) : 0.f; }
            tile_put4(TILE(2), i, 16 * nn + 4 * fq, v[0], v[1], v[2], v[3]);
        }
    }
    __syncthreads();
    if (TID < 192) {
        const int c = lane, c3 = c >> 3, clow = (c & 7) << 1;
        float x[64];
        if (w == 0) {
#pragma unroll
            for (int i = 0; i < 64; ++i) x[i] = tile_get(TILE(3), i, c3, clow) * bts[i];
            tile_row_write(TILE(4), c, x); tri_solve_tile(Am, TILE(4), c);
        } else if (w == 1) {
#pragma unroll
            for (int i = 0; i < 64; ++i) x[i] = tile_get(TILE(1), i, c3, clow) * bts[i] * __expf(gcs[i]);
            tile_row_write(TILE(5), c, x); tri_solve_tile(Am, TILE(5), c);
        } else {
            const float g63 = gcs[63];
#pragma unroll
            for (int i = 0; i < 64; ++i) x[i] = tile_get(TILE(1), i, c3, clow) * __expf(g63 - gcs[i]);
            tile_row_write(TILE(6), c, x);
        }
    }
    __syncthreads();
    {
        bf16_t* Xi = X + ((size_t)(chain * 132 + n)) * 16384;
        const int i = 16 * w + fr;
        f32x4 acc[4];
        zero4(acc); mm64(TILE(2), TILE(4), acc, w, fr, fq); store_acc(Xi + 8192, acc, w, fr, fq);
        zero4(acc); mm64(TILE(2), TILE(5), acc, w, fr, fq);
        {
            const float eg = __expf(gcs[i]);
#pragma unroll
            for (int nn = 0; nn < 4; ++nn) { const f32x4 qv = tile_get4(TILE(0), i, 16 * nn + 4 * fq); acc[nn] = qv * eg - acc[nn]; }
            store_perm(Xi + 4096, acc, w, fr, fq);
        }
        zero4(acc); mm64(TILE(6), TILE(5), acc, w, fr, fq);
        {
            const float gt = __expf(gcs[63]);
#pragma unroll
            for (int nn = 0; nn < 4; ++nn)
#pragma unroll
                for (int jj = 0; jj < 4; ++jj) acc[nn][jj] = ((16 * nn + 4 * fq + jj) == i ? gt : 0.f) - acc[nn][jj];
            store_perm(Xi, acc, w, fr, fq);
        }
        zero4(acc); mm64(TILE(6), TILE(4), acc, w, fr, fq); store_acc(Xi + 12288, acc, w, fr, fq);
    }
}

__device__ __forceinline__ void f_chunk_rwkv(const bf16_t* __restrict__ P, const bf16_t* __restrict__ kk_i, const float* __restrict__ lw_i, const bf16_t* __restrict__ kka_i,
                                             const bf16_t* __restrict__ kd_i, bf16_t* X, int chain, int n, char* lds) {
    const int TID = ltid();
    const int lane = TID & 63, w = TID >> 6, fr = lane & 15, fq = lane >> 4;
    const int dir = chain & 1, h = (chain >> 1) & 3, b = chain >> 3;
    const int c3 = lane >> 3, clow = (lane & 7) << 1;
    float* wc = SCAL;
    float* Am = (float*)TILE(7);
    __syncthreads();
    stage_tile(TILE(0), kk_i + h * 64, 256, b, dir, n * 64, TID);
    stage_tile(TILE(1), kka_i + dir * 256 + h * 64, 512, b, dir, n * 64, TID);
    stage_tile(TILE(2), kd_i + dir * 256 + h * 64, 512, b, dir, n * 64, TID);
    stage_tile(TILE(3), P + ORKV + h * 64, DINP, b, dir, n * 64, TID);
    stage_tile(TILE(4), P + ORKV + 512 + h * 64, DINP, b, dir, n * 64, TID);
#pragma unroll
    for (int k = 0; k < 4; ++k) {
        const int id = TID + 256 * k, row = id >> 4, chn = id & 15;
        const size_t r = scan_row(b, dir, n * 64 + row);
        *(f32x4*)(Am + row * 64 + chn * 4) = *(const f32x4*)(lw_i + r * 512 + dir * 256 + h * 64 + chn * 4);
    }
    __syncthreads();
    {
        float lc = 0.f;
        char* T = TILE(w);
#pragma unroll
        for (int i = 0; i < 64; ++i) {
            const float lprev = lc; lc += Am[i * 64 + lane];
            const float e = w == 0 ? lprev : (w == 3 ? lc : -lc);
            tile_put(T, i, c3, clow, tile_get(T, i, c3, clow) * __expf(e));
        }
        if (w == 0) wc[lane] = __expf(lc);
    }
    __syncthreads();
    if (w == 0) {
        float x[64];
#pragma unroll
        for (int i = 0; i < 64; ++i) x[i] = tile_get(TILE(4), i, c3, clow);
        tile_row_write(TILE(5), lane, x);
    }
    {
        const int i = 16 * w + fr;
        f32x4 acc[4];
        zero4(acc); mm64(TILE(0), TILE(1), acc, w, fr, fq);
#pragma unroll
        for (int nn = 0; nn < 4; ++nn)
#pragma unroll
            for (int jj = 0; jj < 4; ++jj) { const int j = 16 * nn + 4 * fq + jj; Am[i * 64 + j] = j < i ? acc[nn][jj] : 0.f; }
        zero4(acc); mm64(TILE(0), TILE(2), acc, w, fr, fq);
#pragma unroll
        for (int nn = 0; nn < 4; ++nn) {
            float v[4];
#pragma unroll
            for (int jj = 0; jj < 4; ++jj) { const int j = 16 * nn + 4 * fq + jj; v[jj] = j < i ? acc[nn][jj] : 0.f; }
            tile_put4(TILE(6), i, 16 * nn + 4 * fq, v[0], v[1], v[2], v[3]);
        }
    }
    __syncthreads();
    {
        const int i = 16 * w + fr;
        f32x4 acc[4]; zero4(acc); mm64(TILE(6), TILE(5), acc, w, fr, fq);
#pragma unroll
        for (int nn = 0; nn < 4; ++nn)
#pragma unroll
            for (int jj = 0; jj < 4; ++jj) { const int c = 16 * nn + 4 * fq + jj; *(bf16_t*)(TILE(4) + c * 128 + ((((i >> 3) ^ ((c >> 1) & 7)) << 4) | ((i & 7) << 1))) = f2bf(acc[nn][jj]); }
    }
    __syncthreads();
    if (w < 2) {
        float x[64];
        if (w == 0) {
#pragma unroll
            for (int ch = 0; ch < 8; ++ch) {
                const bf16x8 v = *(const bf16x8*)(TILE(4) + lane * 128 + ((ch ^ ((lane >> 1) & 7)) << 4));
#pragma unroll
                for (int e = 0; e < 8; ++e) x[8 * ch + e] = -bf2f((bf16_t)v[e]);
            }
        } else {
#pragma unroll
            for (int i = 0; i < 64; ++i) x[i] = tile_get(TILE(0), i, c3, clow);
        }
        tile_row_write(w == 0 ? TILE(6) : TILE(0), lane, x);
        tri_solve_tile(Am, w == 0 ? TILE(6) : TILE(0), lane);
    }
    __syncthreads();
    {
        const int i = 16 * w + fr;
#pragma unroll
        for (int q = 0; q < 2; ++q) {
            f32x4 acc[4]; zero4(acc); mm64(TILE(3), TILE(1 + q), acc, w, fr, fq);
#pragma unroll
            for (int nn = 0; nn < 4; ++nn) {
                float v[4];
#pragma unroll
                for (int jj = 0; jj < 4; ++jj) { const int j = 16 * nn + 4 * fq + jj; v[jj] = j <= i ? acc[nn][jj] : 0.f; }
                tile_put4(TILE(7 + q), i, 16 * nn + 4 * fq, v[0], v[1], v[2], v[3]);
            }
        }
    }
    if (w == 0) {
        float x[64]; const float wd = wc[lane];
#pragma unroll
        for (int i = 0; i < 64; ++i) x[i] = tile_get(TILE(1), i, c3, clow) * wd;
        tile_row_write(TILE(4), lane, x);
    }
    __syncthreads();
    bf16_t* Xi = X + ((size_t)((16 + chain) * 132 + n)) * 16384;
    f32x4 sa[4];
    {
        const int i = 16 * w + fr;
        f32x4 acc[4];
        zero4(acc); mm64(TILE(7), TILE(6), acc, w, fr, fq); mm64(TILE(8), TILE(5), acc, w, fr, fq); store_acc(Xi + 8192, acc, w, fr, fq);
        zero4(acc); mm64(TILE(7), TILE(0), acc, w, fr, fq);
#pragma unroll
        for (int nn = 0; nn < 4; ++nn) { const f32x4 rv = tile_get4(TILE(3), i, 16 * nn + 4 * fq); acc[nn] = rv - acc[nn]; }
        store_perm(Xi + 4096, acc, w, fr, fq);
        zero4(acc); mm64(TILE(4), TILE(0), acc, w, fr, fq);
        {
            const float wd = wc[i];
#pragma unroll
            for (int nn = 0; nn < 4; ++nn)
#pragma unroll
                for (int jj = 0; jj < 4; ++jj) acc[nn][jj] = ((16 * nn + 4 * fq + jj) == i ? wd : 0.f) - acc[nn][jj];
            store_perm(Xi, acc, w, fr, fq);
        }
        zero4(sa); mm64(TILE(4), TILE(6), sa, w, fr, fq);
    }
    __syncthreads();
    if (w == 0) {
        float x[64]; const float wd = wc[lane];
#pragma unroll
        for (int i = 0; i < 64; ++i) x[i] = tile_get(TILE(2), i, c3, clow) * wd;
        tile_row_write(TILE(4), lane, x);
    }
    __syncthreads();
    mm64(TILE(4), TILE(5), sa, w, fr, fq); store_acc(Xi + 12288, sa, w, fr, fq);
}

struct ScanOps { bf16x8 ar[4][2], ag[4][2]; u32x2 y0[4], s0[4]; };
__device__ __forceinline__ void scan_load(ScanOps& o, const bf16_t* Xi, int slab, int lane, int c, int q) {
#pragma unroll
    for (int mb = 0; mb < 4; ++mb) {
        o.y0[mb] = *(const u32x2*)(Xi + 8192 + ((slab * 4 + mb) * 64 + lane) * 4);
        o.s0[mb] = *(const u32x2*)(Xi + 12288 + ((slab * 4 + mb) * 64 + lane) * 4);
#pragma unroll
        for (int s = 0; s < 2; ++s) {
            o.ar[mb][s] = *(const bf16x8*)(Xi + 4096 + (16 * mb + c) * 64 + 32 * s + 8 * q);
            o.ag[mb][s] = *(const bf16x8*)(Xi + (16 * mb + c) * 64 + 32 * s + 8 * q);
        }
    }
}
__device__ __forceinline__ void scan_step(const ScanOps& o, f32x4 (&S)[4], bf16_t* so, int b, int dir, int colbase, int n, int c, int q) {
    bf16x8 bS[2];
#pragma unroll
    for (int s = 0; s < 2; ++s) {
        u32x4 w; w[0] = pk2bf(S[2 * s][0], S[2 * s][1]); w[1] = pk2bf(S[2 * s][2], S[2 * s][3]); w[2] = pk2bf(S[2 * s + 1][0], S[2 * s + 1][1]); w[3] = pk2bf(S[2 * s + 1][2], S[2 * s + 1][3]);
        bS[s] = __builtin_bit_cast(bf16x8, w);
    }
#pragma unroll
    for (int mb = 0; mb < 4; ++mb) {
        f32x4 y = (f32x4){bf2f((bf16_t)(o.y0[mb][0] & 0xffffu)), bf2f((bf16_t)(o.y0[mb][0] >> 16)), bf2f((bf16_t)(o.y0[mb][1] & 0xffffu)), bf2f((bf16_t)(o.y0[mb][1] >> 16))};
        f32x4 sn = (f32x4){bf2f((bf16_t)(o.s0[mb][0] & 0xffffu)), bf2f((bf16_t)(o.s0[mb][0] >> 16)), bf2f((bf16_t)(o.s0[mb][1] & 0xffffu)), bf2f((bf16_t)(o.s0[mb][1] >> 16))};
#pragma unroll
        for (int s = 0; s < 2; ++s) { y = MFMA16(o.ar[mb][s], bS[s], y); sn = MFMA16(o.ag[mb][s], bS[s], sn); }
#pragma unroll
        for (int reg = 0; reg < 4; ++reg) {
            const int r = scan_row(b, dir, n * 64 + 16 * mb + 4 * q + reg);
            so[((size_t)dir * RR + r) * 512 + colbase + c] = f2bf(y[reg]);
        }
        S[mb] = sn;
    }
}
__device__ __forceinline__ void f_scan2(const bf16_t* __restrict__ X, bf16_t* so, int mc  ) {
    const int TID = ltid();
    const int lane = TID & 63, slab = TID >> 6, c = lane & 15, q = lane >> 4;
    const int mixer = mc >> 4, chain = mc & 15, dir = chain & 1, h = (chain >> 1) & 3, b = chain >> 3;
    const int colbase = mixer * 256 + h * 64 + slab * 16;
    f32x4 S[4];
#pragma unroll
    for (int mb = 0; mb < 4; ++mb) S[mb] = (f32x4){0.f, 0.f, 0.f, 0.f};
    const bf16_t* X0 = X + (size_t)(mc * 132) * 16384;
    ScanOps A, B;
    scan_load(A, X0, slab, lane, c, q);
#pragma unroll 1
    for (int n = 0; n < 132; n += 2) {
        scan_load(B, X0 + (size_t)(n + 1) * 16384, slab, lane, c, q);
        scan_step(A, S, so, b, dir, colbase, n, c, q);
        if (n + 2 < 132) scan_load(A, X0 + (size_t)(n + 2) * 16384, slab, lane, c, q);
        scan_step(B, S, so, b, dir, colbase, n + 1, c, q);
    }
}

__device__ __forceinline__ void f_mix_out_phase(const bf16_t* __restrict__ p, bf16_t* cat, const bf16_t* __restrict__ so, const float* __restrict__ gdn_norm,
                                                 const bf16_t* __restrict__ kd_i, const float* __restrict__ g_up, const float* __restrict__ r_k,
                                                 const float* __restrict__ gn_w, const float* __restrict__ gn_b,
                                                 const bf16_t* __restrict__ OM, const float* __restrict__ da_lambda, const float* __restrict__ da_norm, float lam_init,
                                                 int vb0, int nvb, int nitems, float* lds) {
    const int TID = ltid();
    const int c = TID;
    float* xgT = lds;
    float gu[64];
#pragma unroll
    for (int j = 0; j < 64; ++j) gu[j] = g_up[j * 256 + c];
    const float gnc = gdn_norm[c & 63], rkc = r_k[c], gw = gn_w[c], gb = gn_b[c];
    float s01 = 0.f, s23 = 0.f;
    for (int d = 0; d < 64; ++d) { s01 += da_lambda[d] * da_lambda[64 + d]; s23 += da_lambda[128 + d] * da_lambda[192 + d]; }
    const float lam = expf(s01) - expf(s23) + lam_init;
    const int hw = c >> 6, ln = c & 63;
    const float dg0 = da_norm[ln] * (1.f - lam_init), dg1 = da_norm[ln + 64] * (1.f - lam_init);
    for (int vb = vb0; vb < nitems; vb += nvb) {
        const size_t r0 = (size_t)vb * 8;
        __syncthreads();
#pragma unroll
        for (int t = 0; t < 2; ++t) { const int id = TID + 256 * t, i = id >> 6, j = id & 63; xgT[j * 8 + i] = sigmf(bf2f(p[(r0 + i) * DINP + OXG + j])); }
        {
            float a0[8], a1[8], b0[8], b1[8];
#pragma unroll
            for (int i = 0; i < 8; ++i) {
                const bf16_t* o0 = OM + (r0 + i) * 512 + hw * 128; const bf16_t* o1 = OM + ((size_t)RR + r0 + i) * 512 + hw * 128;
                a0[i] = bf2f(o0[ln]); a1[i] = bf2f(o0[ln + 64]); b0[i] = bf2f(o1[ln]); b1[i] = bf2f(o1[ln + 64]);
            }
#pragma unroll
            for (int i = 0; i < 8; ++i) {
                const float v0 = a0[i] - lam * b0[i], v1 = a1[i] - lam * b1[i];
                const float ssq = wave_sum(v0 * v0 + v1 * v1);
                const float rstd = rsqrtf(ssq * (1.f / 128.f) + 1e-6f);
                cat[(r0 + i) * DM + hw * 128 + ln] = f2bf(v0 * rstd * dg0); cat[(r0 + i) * DM + hw * 128 + ln + 64] = f2bf(v1 * rstd * dg1);
            }
        }
        {
            float o[8], gt[8];
#pragma unroll
            for (int i = 0; i < 8; ++i) { const size_t r = r0 + i; o[i] = bf2f(so[r * 512 + c]) + bf2f(so[((size_t)RR + r) * 512 + c]); gt[i] = bf2f(p[r * DINP + OGGATE + c]); }
#pragma unroll
            for (int i = 0; i < 8; ++i) {
                const float ss = wave_sum(o[i] * o[i]);
                cat[(r0 + i) * DM + 512 + c] = f2bf(o[i] * rsqrtf(ss * (1.f / 64.f) + 1e-6f) * gnc * siluf(gt[i]));
            }
        }
        {
            float yv[8], rr[8], vv[8], kds[8];
#pragma unroll
            for (int i = 0; i < 8; ++i) {
                const size_t r = r0 + i;
                yv[i] = bf2f(so[r * 512 + 256 + c]) + bf2f(so[((size_t)RR + r) * 512 + 256 + c]);
                rr[i] = bf2f(p[r * DINP + ORKV + c]); vv[i] = bf2f(p[r * DINP + ORKV + 512 + c]);
                kds[i] = bf2f(kd_i[r * 512 + c]) + bf2f(kd_i[r * 512 + 256 + c]);
            }
            __syncthreads();
            float g[8];
#pragma unroll
            for (int i = 0; i < 8; ++i) g[i] = 0.f;
#pragma unroll
            for (int j = 0; j < 64; ++j) {
                const f32x4 x0 = *(const f32x4*)(xgT + j * 8), x1 = *(const f32x4*)(xgT + j * 8 + 4);
#pragma unroll
                for (int i = 0; i < 4; ++i) { g[i] += x0[i] * gu[j]; g[4 + i] += x1[i] * gu[j]; }
            }
#pragma unroll
            for (int i = 0; i < 8; ++i) {
                const float mu = wave_sum(yv[i]) * (1.f / 64.f);
                const float dv = yv[i] - mu;
                const float var = wave_sum(dv * dv) * (1.f / 64.f);
                const float yn = dv * rsqrtf(var + 64e-5f) * gw + gb;
                const float bs = wave_sum(rr[i] * kds[i] * rkc);
                cat[(r0 + i) * DM + 768 + c] = f2bf((yn + bs * vv[i]) * g[i]);
            }
        }
    }
}

__device__ __forceinline__ void f_resid1_prep(const float* __restrict__ router, float* lds) {
    const int TID = ltid();
    __syncthreads();
    for (int i = TID; i < DM * NE; i += 256) { const int col = i >> 4, e = i & 15; lds[e * DM + col] = router[i]; }
    __syncthreads();
}
__device__ __forceinline__ void f_resid1(float* ctxs, float* out, const float* __restrict__ mix, const float* __restrict__ g_post, const float* __restrict__ g_pre2,
                         const float* __restrict__ modl, const float* routerT, bf16_t* h2, float* aff, int vb) {
    const int TID = ltid();
    const int r = vb * 4 + (TID >> 6), lane = TID & 63;
    float* x = xrow_ptr(ctxs, out, r);
    const float* m = modl + modrow(r) * 6 * DM;
    f32x4 v[4], xv[4]; float ss = 0.f;
#pragma unroll
    for (int j = 0; j < 4; ++j) { v[j] = *(const f32x4*)(mix + (size_t)r * DM + 4 * lane + 256 * j); xv[j] = *(const f32x4*)(x + 4 * lane + 256 * j); ss += v[j][0] * v[j][0] + v[j][1] * v[j][1] + v[j][2] * v[j][2] + v[j][3] * v[j][3]; }
    ss = wave_sum(ss);
    const float rstd = rsqrtf(ss * (1.f / DM) + 1e-6f);
    float s2 = 0.f;
#pragma unroll
    for (int j = 0; j < 4; ++j) {
        const int c0 = 4 * lane + 256 * j;
        const f32x4 gp = *(const f32x4*)(g_post + c0), gt = *(const f32x4*)(m + 2048 + c0);
        xv[j] = xv[j] + gt * (v[j] * rstd * gp);
        *(f32x4*)(x + c0) = xv[j];
        s2 += xv[j][0] * xv[j][0] + xv[j][1] * xv[j][1] + xv[j][2] * xv[j][2] + xv[j][3] * xv[j][3];
    }
    s2 = wave_sum(s2);
    const float rstd2 = rsqrtf(s2 * (1.f / DM) + 1e-6f);
    f32x4 hv[4];
#pragma unroll
    for (int j = 0; j < 4; ++j) {
        const int c0 = 4 * lane + 256 * j;
        const f32x4 g2 = *(const f32x4*)(g_pre2 + c0), sc = *(const f32x4*)(m + 4096 + c0), sh = *(const f32x4*)(m + 3072 + c0);
        hv[j] = xv[j] * rstd2 * g2 * (1.f + sc) + sh;
        u32x2 o; o[0] = pk2bf(hv[j][0], hv[j][1]); o[1] = pk2bf(hv[j][2], hv[j][3]);
        *(u32x2*)(h2 + (size_t)r * DM + c0) = o;
    }
    float lg[NE];
#pragma unroll
    for (int e = 0; e < NE; ++e) {
        float acc = 0.f;
#pragma unroll
        for (int j = 0; j < 4; ++j) { const f32x4 rt = *(const f32x4*)(routerT + e * DM + 4 * lane + 256 * j); acc += hv[j][0] * rt[0] + hv[j][1] * rt[1] + hv[j][2] * rt[2] + hv[j][3] * rt[3]; }
        lg[e] = acc;
    }
#pragma unroll
    for (int e = 0; e < 8; ++e) { const float give = (lane & 32) ? lg[e] : lg[e + 8], keep = (lane & 32) ? lg[e + 8] : lg[e]; lg[e] = keep + __shfl_xor(give, 32); }
#pragma unroll
    for (int e = 0; e < 4; ++e) { const float give = (lane & 16) ? lg[e] : lg[e + 4], keep = (lane & 16) ? lg[e + 4] : lg[e]; lg[e] = keep + __shfl_xor(give, 16); }
#pragma unroll
    for (int e = 0; e < 2; ++e) { const float give = (lane & 8) ? lg[e] : lg[e + 2], keep = (lane & 8) ? lg[e + 2] : lg[e]; lg[e] = keep + __shfl_xor(give, 8); }
    { const float give = (lane & 4) ? lg[0] : lg[1], keep = (lane & 4) ? lg[1] : lg[0]; lg[0] = keep + __shfl_xor(give, 4); }
    float tot = lg[0];
    tot += __shfl_xor(tot, 2); tot += __shfl_xor(tot, 1);
    const int myexp = ((lane >> 5) & 1) * 8 + ((lane >> 4) & 1) * 4 + ((lane >> 3) & 1) * 2 + ((lane >> 2) & 1);
    float mxv = tot;
#pragma unroll
    for (int o = 4; o < 64; o <<= 1) mxv = fmaxf(mxv, __shfl_xor(mxv, o));
    const float ex = expf(tot - mxv);
    float sum = ex;
#pragma unroll
    for (int o = 4; o < 64; o <<= 1) sum += __shfl_xor(sum, o);
    if ((lane & 3) == 0) aff[(size_t)r * NE + myexp] = ex / sum;
}

__device__ __forceinline__ void f_topk(const float* __restrict__ aff, int* sel_lat, int* sel_ctx, int* slot, int vb, float* lds) {
    const int TID = ltid();
    unsigned* vals = (unsigned*)lds;
    unsigned* hist = (unsigned*)lds + 8192 + 256;
    unsigned* sc = hist + 256;
    unsigned* ctl = sc + 512;
    const int set = vb >> 5, b = (vb >> 4) & 1, e = vb & 15;
    const int n = set == 0 ? TL : CL, cap = set == 0 ? CAPL : CAPC;
    const int per = n >> 8;
    const int rbase = b * SS + (set == 0 ? CL : 0);
    __syncthreads();
    for (int t = TID; t < n; t += 256) vals[t + (t >> 5)] = __float_as_uint(aff[(size_t)(rbase + t) * NE + e]);
    if (TID == 0) { ctl[0] = 0u; ctl[1] = (unsigned)cap; }
    __syncthreads();
    for (int pass = 0; pass < 4; ++pass) {
        const int shift = 24 - 8 * pass;
        hist[TID] = 0u;
        __syncthreads();
        const unsigned prefix = ctl[0];
        const unsigned pmask = pass == 0 ? 0u : (0xffffffffu << (shift + 8));
        for (int j = 0; j < per; ++j) {
            const int t = TID * per + j;
            const unsigned v = vals[t + (t >> 5)];
            if ((v & pmask) == prefix) atomicAdd(&hist[(v >> shift) & 255u], 1u);
        }
        __syncthreads();
        {
            const unsigned hc = hist[255 - TID], rem = ctl[1];
            sc[TID] = hc; __syncthreads();
            for (int o = 1; o < 256; o <<= 1) { const unsigned add = TID >= o ? sc[TID - o] : 0u; __syncthreads(); sc[TID] += add; __syncthreads(); }
            const unsigned cum = sc[TID];
            __syncthreads();
            if (cum >= rem && cum - hc < rem) { ctl[0] = prefix | ((unsigned)(255 - TID) << shift); ctl[1] = rem - (cum - hc); }
        }
        __syncthreads();
    }
    const unsigned thr = ctl[0], need_eq = ctl[1];
    unsigned cg = 0u, ce = 0u;
    for (int j = 0; j < per; ++j) { const int t = TID * per + j; const unsigned v = vals[t + (t >> 5)]; cg += v > thr ? 1u : 0u; ce += v == thr ? 1u : 0u; }
    sc[TID] = ce; __syncthreads();
    for (int o = 1; o < 256; o <<= 1) { const unsigned add = TID >= o ? sc[TID - o] : 0u; __syncthreads(); sc[TID] += add; __syncthreads(); }
    const unsigned eq_before = sc[TID] - ce;
    const unsigned eq_take = eq_before >= need_eq ? 0u : (need_eq - eq_before < ce ? need_eq - eq_before : ce);
    const unsigned csel = cg + eq_take;
    sc[256 + TID] = csel; __syncthreads();
    for (int o = 1; o < 256; o <<= 1) { const unsigned add = TID >= o ? sc[256 + TID - o] : 0u; __syncthreads(); sc[256 + TID] += add; __syncthreads(); }
    unsigned pos = sc[256 + TID] - csel;
    unsigned eq_seen = eq_before;
    for (int j = 0; j < per; ++j) {
        const int t = TID * per + j; const unsigned v = vals[t + (t >> 5)];
        bool take = v > thr;
        if (v == thr) { take = eq_seen < need_eq; ++eq_seen; }
        int sl = -1;
        if (take) { sl = (int)pos; ++pos; if (set == 0) sel_lat[(b * NE + e) * CAPL + sl] = rbase + t; else sel_ctx[(b * NE + e) * CAPC + sl] = rbase + t; }
        slot[(size_t)e * RR + rbase + t] = sl;
    }
}

__device__ __forceinline__ void f_resid2(float* ctxs, float* out, const bf16_t* __restrict__ ye_lat, const bf16_t* __restrict__ ye_ctx, const int* __restrict__ slot,
                         const float* __restrict__ g_post, const float* __restrict__ modl, int vb) {
    const int TID = ltid();
    const int r = vb * 4 + (TID >> 6), lane = TID & 63;
    float* x = xrow_ptr(ctxs, out, r);
    const float* m = modl + modrow(r) * 6 * DM;
    const int b = r >= SS ? 1 : 0, s = r - b * SS;
    const int myslot = slot[(size_t)(lane & 15) * RR + r];
    f32x4 xv[4];
#pragma unroll
    for (int j = 0; j < 4; ++j) xv[j] = *(const f32x4*)(x + 4 * lane + 256 * j);
    f32x4 y[4];
#pragma unroll
    for (int j = 0; j < 4; ++j) y[j] = (f32x4){0.f, 0.f, 0.f, 0.f};
    unsigned long long mask = __ballot(myslot >= 0) & 0xffffull;
    while (mask) {
        const int e = __builtin_ctzll(mask); mask &= mask - 1;
        const int sl = __shfl(myslot, e);
        const bf16_t* src = s < CL ? ye_ctx + ((size_t)(b * NE + e) * CAPC + sl) * DM : ye_lat + ((size_t)(b * NE + e) * CAPL + sl) * DM;
#pragma unroll
        for (int j = 0; j < 4; ++j) {
            const u32x2 w = *(const u32x2*)(src + 4 * lane + 256 * j);
            y[j][0] += bf2f((bf16_t)(w[0] & 0xffffu)); y[j][1] += bf2f((bf16_t)(w[0] >> 16)); y[j][2] += bf2f((bf16_t)(w[1] & 0xffffu)); y[j][3] += bf2f((bf16_t)(w[1] >> 16));
        }
    }
    float ss = 0.f;
#pragma unroll
    for (int j = 0; j < 4; ++j) ss += y[j][0] * y[j][0] + y[j][1] * y[j][1] + y[j][2] * y[j][2] + y[j][3] * y[j][3];
    ss = wave_sum(ss);
    const float rstd = rsqrtf(ss * (1.f / DM) + 1e-6f);
#pragma unroll
    for (int j = 0; j < 4; ++j) {
        const int c0 = 4 * lane + 256 * j;
        const f32x4 gp = *(const f32x4*)(g_post + c0), gt = *(const f32x4*)(m + 5120 + c0);
        *(f32x4*)(x + c0) = xv[j] + gt * (y[j] * rstd * gp);
    }
}

#define XB_TMO      128
#define XB_XCNT(j)  (256  + 64 * (j))
#define XB_XSUB(j)  (1280 + 64 * (j))
#define XB_XGEN(j)  (2304 + 64 * (j))
#define XB_TOP      3328
#define XB_TOPGEN   3392
#define XCD_BAR_WORDS 3456
#define XB_SPIN_CAP (1u << 18)
__device__ __forceinline__ unsigned xb_ld(unsigned* p)              { return __hip_atomic_load(p, __ATOMIC_RELAXED, __HIP_MEMORY_SCOPE_AGENT); }
__device__ __forceinline__ unsigned xb_add(unsigned* p, unsigned v) { return __hip_atomic_fetch_add(p, v, __ATOMIC_RELAXED, __HIP_MEMORY_SCOPE_AGENT); }
__device__ __forceinline__ unsigned xb_xcc_id() { return (unsigned)__builtin_amdgcn_s_getreg((3 << 11) | 20) & 0xFu; }
#define XB_SPIN(cond, bar) do { unsigned _sp = 0; while (cond) { __builtin_amdgcn_s_sleep(1); \
    if ((++_sp & 255u) == 0u) { if (xb_ld(&(bar)[XB_TMO])) break; if (_sp > XB_SPIN_CAP) { atomicAdd(&(bar)[XB_TMO], 1u); break; } } } } while (0)
__device__ __forceinline__ void xcd_barrier_complete(unsigned* bar, unsigned x, unsigned& nloc, unsigned& nx) {
    const unsigned G = gridDim.x * gridDim.y * gridDim.z;
    unsigned sum, cntx, mine, sp = 0u;
    for (;;) {
        sum = 0u; cntx = 0u; mine = 0u;
#pragma unroll
        for (unsigned j = 0; j < 16; ++j) { const unsigned c = xb_ld(&bar[XB_XCNT(j)]); sum += c; cntx += (c > 0u) ? 1u : 0u; mine = (j == x) ? c : mine; }
        if (sum == G) break;
        __builtin_amdgcn_s_sleep(1);
        if ((++sp & 255u) == 0u) { if (xb_ld(&bar[XB_TMO])) break; if (sp > XB_SPIN_CAP) { atomicAdd(&bar[XB_TMO], 1u); break; } }
    }
    nloc = mine > 0u ? mine : 1u; nx = cntx > 0u ? cntx : 1u;
}
__device__ __forceinline__ void xcd_barrier(unsigned* bar, volatile unsigned* st) {
    asm volatile("s_waitcnt vmcnt(0)" ::: "memory");
    __syncthreads();
    if (threadIdx.x == 0) {
        __builtin_amdgcn_s_waitcnt(0);
        const unsigned x = st[2];
        unsigned nloc = st[0], nx = st[1];
        if (nloc == 0u) { xcd_barrier_complete(bar, x, nloc, nx); st[0] = nloc; st[1] = nx; }
        const unsigned old = xb_add(&bar[XB_XSUB(x)], 1u);
        const unsigned gen = old / nloc;
        if (old + 1u == (gen + 1u) * nloc) {
            __builtin_amdgcn_fence(__ATOMIC_RELEASE, "agent");
            asm volatile("s_waitcnt vmcnt(0)" ::: "memory");
            const unsigned og = xb_add(&bar[XB_TOP], 1u);
            const unsigned tg = og / nx;
            if (og + 1u == (tg + 1u) * nx) xb_add(&bar[XB_TOPGEN], 1u);
            else XB_SPIN(xb_ld(&bar[XB_TOPGEN]) == tg, bar);
            __builtin_amdgcn_fence(__ATOMIC_ACQUIRE, "agent");
            xb_add(&bar[XB_XGEN(x)], 1u);
            asm volatile("s_waitcnt vmcnt(0)" ::: "memory");
        } else {
            XB_SPIN(xb_ld(&bar[XB_XGEN(x)]) == gen, bar);
            __builtin_amdgcn_fence(__ATOMIC_ACQUIRE, "agent");
            asm volatile("s_waitcnt vmcnt(0)" ::: "memory");
        }
    }
    __syncthreads();
}
#ifndef CHUNKREP
#define CHUNKREP 1
#endif
#ifndef REPMASK
#define REPMASK 0
#endif
#define REPS(k) for (int rep_ = 0; rep_ < (((REPMASK) >> (k)) & 1) + 1; ++rep_)
struct MP { const float* in[30]; float* out; char* ws; };
enum { I_X = 0, I_C, I_CTX, I_CCTX, I_WMOD, I_BMOD, I_NPRE, I_NPOST, I_WIN, I_WOUT, I_LAM, I_DAN, I_GCONV, I_GALOG, I_GDT, I_GNORM,
       I_W0, I_WUP, I_A0, I_AUP, I_GUP, I_KK, I_KA, I_RK, I_GNW, I_GNB, I_ROUTER, I_MGATE, I_MUP, I_MDOWN };
constexpr int PB_NPRE = 0, PB_NPOST = PB_NPRE + 4096, PB_LAM = PB_NPOST + 4096, PB_DAN = PB_LAM + 512, PB_GCONV = PB_DAN + 256, PB_GALOG = PB_GCONV + 7680,
              PB_GDT = PB_GALOG + 16, PB_GNORM = PB_GDT + 16, PB_W0 = PB_GNORM + 128, PB_WUP = PB_W0 + 1024, PB_A0 = PB_WUP + 32768, PB_AUP = PB_A0 + 1024,
              PB_GUP = PB_AUP + 32768, PB_KK = PB_GUP + 32768, PB_KA = PB_KK + 512, PB_RK = PB_KA + 512, PB_GNW = PB_RK + 512, PB_GNB = PB_GNW + 512,
              PB_ROUTER = PB_GNB + 512, PB_END = PB_ROUTER + 32768;
constexpr size_t al256c(size_t x) { return (x + 255) & ~(size_t)255; }
constexpr size_t WS_BAR = 0, WS_CNT = 16384, WS_PRM = 16384 + 256, WS_MOD = al256c(WS_PRM + (size_t)PB_END * 4), WS_CTXS = al256c(WS_MOD + (size_t)2 * 3 * 6 * DM * 4),
                 WS_AFF = al256c(WS_CTXS + (size_t)NB * CL * DM * 4), WS_TAB = al256c(WS_AFF + (size_t)RR * NE * 4), WS_SLOT = al256c(WS_TAB + (size_t)128 * 16 * 8),
                 WS_SELL = al256c(WS_SLOT + (size_t)NE * RR * 4), WS_SELC = al256c(WS_SELL + (size_t)32 * CAPL * 4), WS_WTIN = al256c(WS_SELC + (size_t)32 * CAPC * 4),
                 WS_WTOUT = al256c(WS_WTIN + (size_t)2 * DINP * DM * 2), WS_BUFA = al256c(WS_WTOUT + (size_t)2 * DM * DM * 2), WS_SO = al256c(WS_BUFA + (size_t)RR * DM * 2),
                 WS_P = al256c(WS_SO + (size_t)2 * RR * 512 * 2), WS_R3 = al256c(WS_P + (size_t)RR * DINP * 2), WS_VT = al256c(WS_R3 + (size_t)RR * 6208),
                 WS_OM = al256c(WS_VT + (size_t)NB * 4 * 128 * SS * 2), WS_XC = al256c(WS_OM + (size_t)2 * RR * 512 * 2), WS_END = al256c(WS_XC + (size_t)32 * 132 * 16384 * 2);

__device__ __forceinline__ char* lptr(char* p) { asm volatile("" : "+s"(p)); return p; }
#define PHASE char* const W = lptr(a.ws); float* const out = (float*)lptr((char*)a.out); (void)W; (void)out;
#define bar ((unsigned*)(W + WS_BAR))
#define cnt ((int*)(W + WS_CNT))
#define prm ((float*)(W + WS_PRM))
#define mod ((float*)(W + WS_MOD))
#define ctxs ((float*)(W + WS_CTXS))
#define aff ((float*)(W + WS_AFF))
#define tab ((float2*)(W + WS_TAB))
#define slot ((int*)(W + WS_SLOT))
#define sel_lat ((int*)(W + WS_SELL))
#define sel_ctx ((int*)(W + WS_SELC))
#define wt_in ((bf16_t*)(W + WS_WTIN))
#define wt_out ((bf16_t*)(W + WS_WTOUT))
#define bufA ((bf16_t*)(W + WS_BUFA))
#define so ((bf16_t*)(W + WS_SO))
#define P ((bf16_t*)(W + WS_P))
#define R3 ((bf16_t*)(W + WS_R3))
#define VT ((bf16_t*)(W + WS_VT))
#define XC ((bf16_t*)(W + WS_XC))
#define OM ((bf16_t*)(W + WS_OM))
#define gq R3
#define gk (R3 + (size_t)RR * 256)
#define gv (R3 + (size_t)RR * 512)
#define kk_b (R3 + (size_t)RR * 768)
#define kka_b (R3 + (size_t)RR * 1024)
#define kd_b (R3 + (size_t)RR * 1536)
#define w_b ((float*)(R3 + (size_t)RR * 2048))
#define gab (w_b + (size_t)RR * 512)
#define mix ((float*)R3)
#define ye_lat R3
#define ye_ctx (R3 + (size_t)32 * CAPL * DM)
#define hid_lat P
#define hid_ctx (P + (size_t)32 * CAPL * DM)
#define h bufA
#define cat bufA
#define h2 bufA
#define wt_gu XC
#define wt_dn (XC + (size_t)NE * 2 * DM * DM)
#define modl (mod + (size_t)i * 3 * 6 * DM)
#define GBAR { PHASE xcd_barrier(bar, (volatile unsigned*)(lds + 18432 + 132)); }

__global__ __launch_bounds__(256, 2) void mega(MP a) {
    __shared__ __attribute__((aligned(16))) float lds[18432 + 256];
    cg::grid_group grid = cg::this_grid();
    const int nb = gridDim.x, bid = blockIdx.x;
    if (threadIdx.x == 0) {
        volatile unsigned* st = (volatile unsigned*)(lds + 18432 + 132);
        st[0] = 0u; st[1] = 0u; st[2] = xb_xcc_id();
        (void)xb_add(&((unsigned*)(a.ws + WS_BAR))[XB_XCNT(st[2])], 1u);
    }
    __syncthreads();

    {
    PHASE
    if (bid == 0 && threadIdx.x < 64) cnt[threadIdx.x] = 0;
    {
        const int gt = lsgpr(bid) * 256 + ltid(), gn = nb * 256;
#define CPY(idx, off, n) for (int q_ = gt; q_ < (n); q_ += gn) prm[(off) + q_] = a.in[idx][q_];
        CPY(I_NPRE, PB_NPRE, 4096) CPY(I_NPOST, PB_NPOST, 4096) CPY(I_LAM, PB_LAM, 512) CPY(I_DAN, PB_DAN, 256) CPY(I_GCONV, PB_GCONV, 7680) CPY(I_GALOG, PB_GALOG, 16)
        CPY(I_GDT, PB_GDT, 16) CPY(I_GNORM, PB_GNORM, 128) CPY(I_W0, PB_W0, 1024) CPY(I_WUP, PB_WUP, 32768) CPY(I_A0, PB_A0, 1024) CPY(I_AUP, PB_AUP, 32768)
        CPY(I_GUP, PB_GUP, 32768) CPY(I_KK, PB_KK, 512) CPY(I_KA, PB_KA, 512) CPY(I_RK, PB_RK, 512) CPY(I_GNW, PB_GNW, 512) CPY(I_GNB, PB_GNB, 512) CPY(I_ROUTER, PB_ROUTER, 32768)
#undef CPY
    }
    REPS(0) {
    f_init(a.in[I_X], a.in[I_CTX], out, ctxs, lsgpr(bid), nb);
    for (int vb = lsgpr(bid); vb < 384; vb += nb) f_mod1(a.in[I_C], a.in[I_CCTX], a.in[I_WMOD], (float*)XC, vb, lds);
    for (int i = lsgpr(bid) * 256 + ltid(); i < 128 * 16; i += nb * 256) {
        int pos = i >> 4, f = i & 15;
        float ang = (float)pos * powf(10000.f, -(float)f / 16.f);
        tab[i] = make_float2(cosf(ang), sinf(ang));
    }
    {
        const int T_IN = 2 * 16 * 28, T_OUT = 2 * 16 * 8;
        for (int vb = lsgpr(bid); vb < T_IN + T_OUT; vb += nb) {
            int t = vb;
            if (t < T_IN) { int l = t / (16 * 28), q = t % (16 * 28); f_wconv(a.in[I_WIN] + (size_t)l * DM * DIN, DIN, wt_in + (size_t)l * DINP * DM, 0, q / 28, q % 28, lds); continue; }
            t -= T_IN;
            { int l = t / 128, q = t % 128; f_wconv(a.in[I_WOUT] + (size_t)l * DM * DM, DM, wt_out + (size_t)l * DM * DM, 0, q / 8, q % 8, lds); }
        }
    }
    }
    }
    grid.sync();
    { PHASE for (int vb = lsgpr(bid); vb < (2 * 3 * 6 * DM) / 256; vb += nb) f_mod2((const float*)XC, a.in[I_BMOD], mod, vb); }
    GBAR

    _Pragma("unroll") for (int i = 0; i < 2; ++i) {
        const float lam_init = 0.8f - 0.6f * expf(-0.3f * (float)i);
        { PHASE
        REPS(1) for (int vb = lsgpr(bid); vb < RR / 4; vb += nb) f_normmod(ctxs, out, (prm + PB_NPRE) + (size_t)(i * 2 + 0) * DM, modl, 0, 1024, h, vb);
        }
        GBAR
        { PHASE
        REPS(2) for (int vb = lsgpr(bid); vb < 132 * 28; vb += nb) {
            const int mt = vb / 28, nt = vb % 28;
            RowDense ap{h + (size_t)mt * 128 * DM, DM}; RowDense bp{wt_in + (size_t)i * DINP * DM + (size_t)nt * 128 * DM, DM};
            EpiInProj ep{P, VT, tab, mt * 128, nt * 128};
            gemm128(ap, bp, DM, ep, (char*)lds);
        }
        }
        GBAR
        { PHASE
        REPS(3) for (int vb = lsgpr(bid); vb < RR / 8; vb += nb) f_gdn_prep(P, (prm + PB_GCONV) + (size_t)i * 5 * 768, (prm + PB_GALOG) + i * 8, (prm + PB_GDT) + i * 8, gq, gk, gv, gab, vb);
        REPS(4) f_rwkv_prep_phase(P, (prm + PB_W0) + i * 512, (prm + PB_WUP) + (size_t)i * 2 * 32 * 256, (prm + PB_A0) + i * 512, (prm + PB_AUP) + (size_t)i * 2 * 32 * 256,
                                  (prm + PB_KK) + i * 256, (prm + PB_KA) + i * 256, kk_b, w_b, kka_b, kd_b, lsgpr(bid), nb, RR / 8, lds);
        }
        GBAR
        { PHASE
        for (int vb_ = lsgpr(bid); vb_ < 32 * 132 * CHUNKREP; vb_ += nb) {
            const int vb = vb_ % (32 * 132);
            const int mc = vb / 132, n = vb % 132;
            if (mc < 16) f_chunk_gdn(gq, gk, gv, gab, XC, mc, n, (char*)lds);
            else f_chunk_rwkv(P, kk_b, w_b, kka_b, kd_b, XC, mc - 16, n, (char*)lds);
        }
        }
        GBAR
        { PHASE
        REPS(6) if (lsgpr(bid) < 32) f_scan2(XC, so, bid);
        REPS(7) {
            const int per_q = i == 0 ? 132 : 128;
            int* sidx = (int*)(lds + 18432 + 128);
            const int q0 = (int)(((volatile unsigned*)(lds + 18432 + 132))[2] & 7u);
            for (int qi = 0; qi < 8; ++qi) {
                const int q = (q0 + qi) & 7;
                for (;;) {
                    __syncthreads();
                    if (threadIdx.x == 0) *sidx = atomicAdd(cnt + 16 * (i + 2 * rep_) + q, 1);
                    __syncthreads();
                    const int u = *sidx;
                    if (u >= per_q) break;
                    const int uqb = u < 128 ? 2 + (u >> 1) : ((u - 128) >> 1);
                    f_attn(P, VT, OM, q, u & 1, uqb, (char*)lds);
                }
            }
        }
        }
        GBAR
        { PHASE
        REPS(8) f_mix_out_phase(P, cat, so, (prm + PB_GNORM) + i * 64, kd_b, (prm + PB_GUP) + (size_t)i * 64 * 256, (prm + PB_RK) + i * 256, (prm + PB_GNW) + i * 256, (prm + PB_GNB) + i * 256,
                                OM, (prm + PB_LAM) + (size_t)i * 256, (prm + PB_DAN) + (size_t)i * 128, lam_init, lsgpr(bid), nb, RR / 8, lds);
        REPS(9) for (int vb = lsgpr(bid); vb < 3 * 2048; vb += nb) {
            const int which = vb / 2048, q = vb % 2048, e = q / 128, qq = q % 128;
            const size_t le = (size_t)(i * NE + e);
            if (which == 0) f_wconv(a.in[I_MGATE] + le * DM * DM, DM, wt_gu + (size_t)e * 2 * DM * DM, 1, qq / 8, qq % 8, lds);
            else if (which == 1) f_wconv(a.in[I_MUP] + le * DM * DM, DM, wt_gu + (size_t)e * 2 * DM * DM, 2, qq / 8, qq % 8, lds);
            else f_wconv(a.in[I_MDOWN] + le * DM * DM, DM, wt_dn + (size_t)e * DM * DM, 0, qq / 8, qq % 8, lds);
        }
        }
        GBAR
        { PHASE
        REPS(10) for (int vb = lsgpr(bid); vb < 132 * 8; vb += nb) {
            const int mt = vb / 8, nt = vb % 8;
            RowDense ap{cat + (size_t)mt * 128 * DM, DM}; RowDense bp{wt_out + (size_t)i * DM * DM + (size_t)nt * 128 * DM, DM};
            EpiF32 ep{mix, DM, mt * 128, nt * 128};
            gemm128(ap, bp, DM, ep, (char*)lds);
        }
        }
        GBAR
        { PHASE
        f_resid1_prep((prm + PB_ROUTER) + (size_t)i * DM * NE, lds);
        for (int vb = lsgpr(bid); vb < RR / 4; vb += nb) f_resid1(ctxs, out, mix, (prm + PB_NPOST) + (size_t)(i * 2 + 0) * DM, (prm + PB_NPRE) + (size_t)(i * 2 + 1) * DM, modl, lds, h2, aff, vb);
        }
        GBAR
        { PHASE
        REPS(11) for (int vb = lsgpr(bid); vb < 64; vb += nb) f_topk(aff, sel_lat, sel_ctx, slot, vb, lds);
        }
        GBAR
        { PHASE
        REPS(12) for (int vb = lsgpr(bid); vb < 32 * 8 * 16 + 32 * 16; vb += nb) {
            int g, mt, nt, cap; const int* sel; bf16_t* hid;
            if (vb < 32 * 8 * 16) { g = vb / 128; mt = (vb % 128) / 16; nt = vb % 16; cap = CAPL; sel = sel_lat + g * CAPL; hid = hid_lat + (size_t)g * CAPL * DM; }
            else { int t = vb - 32 * 8 * 16; g = t / 16; mt = 0; nt = t % 16; cap = CAPC; sel = sel_ctx + g * CAPC; hid = hid_ctx + (size_t)g * CAPC * DM; }
            const int e = g % NE;
            RowGather ap{h2, sel + mt * 128, cap - mt * 128}; RowDense bp{wt_gu + ((size_t)e * 2 * DM + (size_t)nt * 128) * DM, DM};
            EpiMoE1 ep{hid, mt * 128, nt * 128, cap};
            gemm128(ap, bp, DM, ep, (char*)lds);
        }
        }
        GBAR
        { PHASE
        REPS(13) for (int vb = lsgpr(bid); vb < 32 * 8 * 8 + 32 * 8; vb += nb) {
            int g, mt, nt, cap; const int* sel; const bf16_t* hid; bf16_t* ye;
            if (vb < 32 * 8 * 8) { g = vb / 64; mt = (vb % 64) / 8; nt = vb % 8; cap = CAPL; sel = sel_lat + g * CAPL; hid = hid_lat + (size_t)g * CAPL * DM; ye = ye_lat + (size_t)g * CAPL * DM; }
            else { int t = vb - 32 * 8 * 8; g = t / 8; mt = 0; nt = t % 8; cap = CAPC; sel = sel_ctx + g * CAPC; hid = hid_ctx + (size_t)g * CAPC * DM; ye = ye_ctx + (size_t)g * CAPC * DM; }
            const int e = g % NE;
            RowDense ap{hid + (size_t)mt * 128 * DM, DM}; RowDense bp{wt_dn + ((size_t)e * DM + (size_t)nt * 128) * DM, DM};
            EpiMoE2 ep{ye, aff, sel, e, mt * 128, nt * 128, cap};
            gemm128(ap, bp, DM, ep, (char*)lds);
        }
        }
        GBAR
        { PHASE
        for (int vb = lsgpr(bid); vb < RR / 4; vb += nb) f_resid2(ctxs, out, ye_lat, ye_ctx, slot, (prm + PB_NPOST) + (size_t)(i * 2 + 1) * DM, modl, vb);
        }
        GBAR
    }
}

#undef bar
#undef cnt
#undef prm
#undef mod
#undef ctxs
#undef aff
#undef tab
#undef slot
#undef sel_lat
#undef sel_ctx
#undef wt_in
#undef wt_out
#undef bufA
#undef so
#undef P
#undef R3
#undef VT
#undef XC
#undef OM
#undef gq
#undef gk
#undef gv
#undef kk_b
#undef kka_b
#undef kd_b
#undef w_b
#undef gab
#undef mix
#undef ye_lat
#undef ye_ctx
#undef hid_lat
#undef hid_ctx
#undef h
#undef cat
#undef h2
#undef wt_gu
#undef wt_dn
#undef modl
extern "C" void kernel_launch(void* const* d_in, const int* in_sizes, int n_in, void* d_out, int out_size, void* d_ws, size_t ws_size, hipStream_t stream) {
    static int grid_blocks = 0;
    if (!grid_blocks) {
        int dev = 0, cus = 0, per_cu = 0;
        (void)hipGetDevice(&dev);
        (void)hipDeviceGetAttribute(&cus, hipDeviceAttributeMultiprocessorCount, dev);
        (void)hipOccupancyMaxActiveBlocksPerMultiprocessor(&per_cu, mega, 256, 0);
        if (per_cu < 1) per_cu = 1;
        if (per_cu > 2) per_cu = 2;
        grid_blocks = cus * per_cu;
    }
    if (WS_END > ws_size) { fprintf(stderr, "workspace too small: need %zu have %zu\n", (size_t)WS_END, ws_size); return; }
    MP a{};
    for (int i = 0; i < 30; ++i) a.in[i] = (const float*)d_in[i];
    a.out = (float*)d_out; a.ws = (char*)d_ws;
    (void)hipMemsetAsync((char*)d_ws + WS_BAR, 0, 16384 + 256, stream);
    void* args[] = {&a};
    hipError_t e = hipLaunchCooperativeKernel((void*)mega, dim3(grid_blocks), dim3(256), args, 0, stream);
    if (e != hipSuccess) fprintf(stderr, "cooperative launch failed: %s (grid %d)\n", hipGetErrorString(e), grid_blocks);
}
```

```cpp
#include <hip/hip_runtime.h>
#include <stdint.h>
#include <stdio.h>
#include <hip/hip_cooperative_groups.h>
namespace cg = cooperative_groups;

#define NB 2
#define TL 8192
#define CL 256
#define SS 8448
#define RR 16896
#define DM 1024
#define DIN 3472
#define DINP 3584
#define NE 16
#define CAPL 1024
#define CAPC 32
#define OQ 0
#define OKK 512
#define OV 1024
#define OGQKV 1536
#define OGGATE 2304
#define OGA 2560
#define OGB 2568
#define ORKV 2576
#define OXW 3344
#define OXA 3376
#define OXG 3408

typedef unsigned short bf16_t;
typedef short bf16x8 __attribute__((ext_vector_type(8)));
typedef float f32x4 __attribute__((ext_vector_type(4)));
typedef unsigned u32x4 __attribute__((ext_vector_type(4)));
typedef unsigned u32x2 __attribute__((ext_vector_type(2)));
typedef float f32x16 __attribute__((ext_vector_type(16)));
#define MFMA32(a, b, c) __builtin_amdgcn_mfma_f32_32x32x16_bf16((a), (b), (c), 0, 0, 0)
__device__ __forceinline__ int crow(int r, int h) { return (r & 3) + 8 * (r >> 2) + 4 * h; }

#define LAUNDER(x) asm volatile("" : "+v"(x))
__device__ __forceinline__ int lsgpr(int x) { asm volatile("" : "+s"(x)); return x; }
__device__ __forceinline__ int ltid() { int t = threadIdx.x; LAUNDER(t); return t; }
__device__ __forceinline__ float siluf(float x) { return x / (1.f + expf(-x)); }
__device__ __forceinline__ float sigmf(float x) { return 1.f / (1.f + expf(-x)); }
__device__ __forceinline__ float dpp_ror(float v, int) { return v; }
#define DPP_ROR_ADD(v, n) v += __builtin_bit_cast(float, __builtin_amdgcn_update_dpp(0, __builtin_bit_cast(int, v), 0x120 + (n), 0xf, 0xf, false))
__device__ __forceinline__ float wave_sum(float v) {
    DPP_ROR_ADD(v, 8); DPP_ROR_ADD(v, 4); DPP_ROR_ADD(v, 2); DPP_ROR_ADD(v, 1);
    const int iv = __builtin_bit_cast(int, v);
    const float a = __builtin_bit_cast(float, __builtin_amdgcn_readlane(iv, 0)), b = __builtin_bit_cast(float, __builtin_amdgcn_readlane(iv, 16));
    const float c = __builtin_bit_cast(float, __builtin_amdgcn_readlane(iv, 32)), d = __builtin_bit_cast(float, __builtin_amdgcn_readlane(iv, 48));
    return (a + b) + (c + d);
}
__device__ __forceinline__ unsigned pk2bf(float lo, float hi) {
    typedef float f2 __attribute__((ext_vector_type(2))); typedef __bf16 b2 __attribute__((ext_vector_type(2)));
    f2 v = {lo, hi}; b2 b = __builtin_convertvector(v, b2); return __builtin_bit_cast(unsigned, b);
}
__device__ __forceinline__ bf16_t f2bf(float f) { return (bf16_t)(pk2bf(f, 0.f) & 0xffffu); }
__device__ __forceinline__ float bf2f(bf16_t u) { return __uint_as_float(((unsigned)u) << 16); }
__device__ __forceinline__ const float* xrow_cptr(const float* ctxs, const float* out, int r) {
    int b = r >= SS ? 1 : 0, s = r - b * SS;
    return s < CL ? ctxs + ((size_t)(b * CL + s)) * DM : out + ((size_t)(b * TL + (s - CL))) * DM;
}
__device__ __forceinline__ float* xrow_ptr(float* ctxs, float* out, int r) {
    int b = r >= SS ? 1 : 0, s = r - b * SS;
    return s < CL ? ctxs + ((size_t)(b * CL + s)) * DM : out + ((size_t)(b * TL + (s - CL))) * DM;
}
__device__ __forceinline__ int modrow(int r) { int b = r >= SS ? 1 : 0, s = r - b * SS; return s < CL ? 2 : b; }

__device__ __forceinline__ void f_init(const float* __restrict__ x, const float* __restrict__ ctx, float* out, float* ctxs, int vb, int nvb) {
    const int TID = ltid();
    size_t i = (size_t)vb * 256 + TID;
    size_t n1 = (size_t)NB * TL * DM / 4, n2 = (size_t)NB * CL * DM / 4;
    for (size_t j = i; j < n1; j += (size_t)nvb * 256) ((float4*)out)[j] = ((const float4*)x)[j];
    for (size_t j = i; j < n2; j += (size_t)nvb * 256) ((float4*)ctxs)[j] = ((const float4*)ctx)[j];
}

__device__ __forceinline__ void f_mod1(const float* __restrict__ c, const float* __restrict__ c_ctx, const float* __restrict__ w_mod, float* modp, int item, float* lds) {
    const int TID = ltid();
    float* cs = lds;
    const int kc = item & 31, cb = (item >> 5) % 6, l = item / 192;
    __syncthreads();
    if (TID < 96) { const int k = TID & 31, j = TID >> 5; const float v = j == 0 ? c[kc * 32 + k] : (j == 1 ? c[DM + kc * 32 + k] : c_ctx[kc * 32 + k]); cs[k * 4 + j] = siluf(v); }
    __syncthreads();
    const float* w = w_mod + ((size_t)l * DM + kc * 32) * 6 * DM + cb * 1024 + 4 * TID;
    f32x4 a0 = (f32x4){0.f, 0.f, 0.f, 0.f}, a1 = a0, a2 = a0;
#pragma unroll 8
    for (int k = 0; k < 32; ++k) {
        const f32x4 wv = *(const f32x4*)(w + (size_t)k * 6 * DM);
        const f32x4 cv = *(const f32x4*)(cs + k * 4);
        a0 += wv * cv[0]; a1 += wv * cv[1]; a2 += wv * cv[2];
    }
    float* dst = modp + ((size_t)(kc * 2 + l) * 3) * 6 * DM + cb * 1024 + 4 * TID;
    *(f32x4*)(dst) = a0; *(f32x4*)(dst + 6 * DM) = a1; *(f32x4*)(dst + 2 * 6 * DM) = a2;
}
__device__ __forceinline__ void f_mod2(const float* __restrict__ modp, const float* __restrict__ b_mod, float* mod, int vb) {
    const int idx = vb * 256 + ltid();
    const int l = idx / (3 * 6 * DM), n = idx % (6 * DM);
    float acc = b_mod[l * 6 * DM + n];
    const int j = (idx / (6 * DM)) % 3;
#pragma unroll 8
    for (int kc = 0; kc < 32; ++kc) acc += modp[((size_t)(kc * 2 + l) * 3 + j) * 6 * DM + n];
    mod[idx] = acc;
}

__device__ __forceinline__ void f_wconv(const float* __restrict__ W, int N, bf16_t* Wt, int rowmap, int kt, int nt, float* lds) {
    const int TID = ltid();
    float (*T)[129] = (float (*)[129])lds;
    const int tid = TID;
    __syncthreads();
    f32x4 v[8];
#pragma unroll
    for (int i = 0; i < 8; ++i) {
        const int k = (tid >> 5) + 8 * i, n4 = (tid & 31) * 4;
        const int gn = nt * 128 + n4;
        v[i] = gn < N ? *(const f32x4*)(W + (size_t)(kt * 64 + k) * N + gn) : (f32x4){0.f, 0.f, 0.f, 0.f};
    }
#pragma unroll
    for (int i = 0; i < 8; ++i) {
        const int k = (tid >> 5) + 8 * i, n4 = (tid & 31) * 4;
        T[k][n4] = v[i][0]; T[k][n4 + 1] = v[i][1]; T[k][n4 + 2] = v[i][2]; T[k][n4 + 3] = v[i][3];
    }
    __syncthreads();
#pragma unroll
    for (int i = 0; i < 4; ++i) {
        const int n = (tid >> 3) + 32 * i, kc = tid & 7;
        const int gn = nt * 128 + n;
        const int drow = rowmap == 0 ? gn : (32 * (gn >> 4) + (gn & 15) + (rowmap == 2 ? 16 : 0));
        u32x4 o;
        o[0] = pk2bf(T[kc * 8 + 0][n], T[kc * 8 + 1][n]); o[1] = pk2bf(T[kc * 8 + 2][n], T[kc * 8 + 3][n]);
        o[2] = pk2bf(T[kc * 8 + 4][n], T[kc * 8 + 5][n]); o[3] = pk2bf(T[kc * 8 + 6][n], T[kc * 8 + 7][n]);
        *(u32x4*)(Wt + (size_t)drow * DM + kt * 64 + kc * 8) = o;
    }
}

__device__ __forceinline__ void f_normmod(const float* ctxs, const float* out, const float* __restrict__ g, const float* __restrict__ modl, int sh_off, int sc_off, bf16_t* h, int vb) {
    const int TID = ltid();
    int r = vb * 4 + (TID >> 6), lane = TID & 63;
    const float* x = xrow_cptr(ctxs, out, r);
    const float* m = modl + modrow(r) * 6 * DM;
    f32x4 v[4]; float ss = 0.f;
#pragma unroll
    for (int j = 0; j < 4; ++j) { v[j] = *(const f32x4*)(x + 4 * lane + 256 * j); ss += v[j][0] * v[j][0] + v[j][1] * v[j][1] + v[j][2] * v[j][2] + v[j][3] * v[j][3]; }
    ss = wave_sum(ss);
    float rstd = rsqrtf(ss * (1.f / DM) + 1e-6f);
#pragma unroll
    for (int j = 0; j < 4; ++j) {
        int c0 = 4 * lane + 256 * j;
        f32x4 gg = *(const f32x4*)(g + c0), sc = *(const f32x4*)(m + sc_off + c0), sh = *(const f32x4*)(m + sh_off + c0);
        f32x4 o4 = v[j] * rstd * gg * (1.f + sc) + sh;
        u32x2 o; o[0] = pk2bf(o4[0], o4[1]); o[1] = pk2bf(o4[2], o4[3]);
        *(u32x2*)(h + (size_t)r * DM + c0) = o;
    }
}

#define LDS_AS __attribute__((address_space(3)))
template <class AP, class BP, class Epi>
__device__ __forceinline__ void gemm128(const AP& aptr, const BP& bptr, int K, const Epi& epi, char* lds) {
    const int TID = ltid();
    const int tid = TID, lane = tid & 63, wid = __builtin_amdgcn_readfirstlane(tid >> 6), wr = wid >> 1, wc = wid & 1, fr = lane & 15, fq = lane >> 4;
    const bf16_t* ag[4]; const bf16_t* bg[4];
#pragma unroll
    for (int i = 0; i < 4; ++i) {
        const int row = 8 * (4 * i + wid) + (lane >> 3), ch = (lane & 7) ^ ((row >> 1) & 7);
        ag[i] = aptr(row) + ch * 8; bg[i] = bptr(row) + ch * 8;
    }
    f32x4 acc[4][4];
#pragma unroll
    for (int m = 0; m < 4; ++m)
#pragma unroll
        for (int n = 0; n < 4; ++n) acc[m][n] = (f32x4){0.f, 0.f, 0.f, 0.f};
    LDS_AS char* l3 = (LDS_AS char*)lds;
    __syncthreads();
#pragma unroll
    for (int i = 0; i < 4; ++i) {
        __builtin_amdgcn_global_load_lds((const unsigned*)ag[i], (LDS_AS unsigned*)(l3 + (4 * i + wid) * 1024), 16, 0, 0);
        __builtin_amdgcn_global_load_lds((const unsigned*)bg[i], (LDS_AS unsigned*)(l3 + 16384 + (4 * i + wid) * 1024), 16, 0, 0);
    }
    __syncthreads();
    const int nk = K / 64;
    const int swz = fr >> 1;
    for (int kt = 0; kt < nk; ++kt) {
        const int buf = kt & 1;
        if (kt + 1 < nk) {
#pragma unroll
            for (int i = 0; i < 4; ++i) {
                __builtin_amdgcn_global_load_lds((const unsigned*)(ag[i] + (kt + 1) * 64), (LDS_AS unsigned*)(l3 + (buf ^ 1) * 32768 + (4 * i + wid) * 1024), 16, 0, 0);
                __builtin_amdgcn_global_load_lds((const unsigned*)(bg[i] + (kt + 1) * 64), (LDS_AS unsigned*)(l3 + (buf ^ 1) * 32768 + 16384 + (4 * i + wid) * 1024), 16, 0, 0);
            }
        }
        const char* la = lds + buf * 32768; const char* lb = la + 16384;
#pragma unroll
        for (int ks = 0; ks < 2; ++ks) {
            bf16x8 af[4], bfr[4];
            const int coff = ((ks * 4 + fq) ^ swz) << 4;
#pragma unroll
            for (int m = 0; m < 4; ++m) af[m] = *(const bf16x8*)(la + (wr * 64 + m * 16 + fr) * 128 + coff);
#pragma unroll
            for (int n = 0; n < 4; ++n) bfr[n] = *(const bf16x8*)(lb + (wc * 64 + n * 16 + fr) * 128 + coff);
#pragma unroll
            for (int m = 0; m < 4; ++m)
#pragma unroll
                for (int n = 0; n < 4; ++n) acc[m][n] = __builtin_amdgcn_mfma_f32_16x16x32_bf16(bfr[n], af[m], acc[m][n], 0, 0, 0);
        }
        __syncthreads();
    }
    epi(acc, wr, wc, fr, fq);
}

struct RowDense { const bf16_t* base; size_t ld; __device__ __forceinline__ const bf16_t* operator()(int row) const { return base + (size_t)row * ld; } };
struct RowGather { const bf16_t* base; const int* idx; int maxrow; __device__ __forceinline__ const bf16_t* operator()(int row) const { int r = row < maxrow ? row : maxrow - 1; return base + (size_t)idx[r] * DM; } };

struct EpiInProj {
    bf16_t* P; bf16_t* VT; const float2* tab; int m0, n0;
    __device__ __forceinline__ void operator()(f32x4 (&acc)[4][4], int wr, int wc, int fr, int fq) const {
        const bool rope = n0 < 1024;
        const bool isv = n0 >= OV && n0 < OGQKV;
#pragma unroll
        for (int m = 0; m < 4; ++m) {
            const int r = m0 + wr * 64 + m * 16 + fr;
            const int b = r / SS, s = r % SS;
            if (rope && s >= CL) {
                const int t = s - CL;
#pragma unroll
                for (int ax = 0; ax < 2; ++ax) {
                    const int pos = ax == 0 ? (t >> 6) : (t & 63);
#pragma unroll
                    for (int j = 0; j < 4; ++j) {
                        const float2 cs = tab[pos * 16 + 4 * fq + j];
                        const float x1 = acc[m][2 * ax][j], x2 = acc[m][2 * ax + 1][j];
                        acc[m][2 * ax][j] = x1 * cs.x - x2 * cs.y;
                        acc[m][2 * ax + 1][j] = x2 * cs.x + x1 * cs.y;
                    }
                }
            }
            if (isv) {
                const int u = s & 15;
                const int ps = (s & ~15) | (((u >> 2) & 1) << 3) | ((u >> 3) << 2) | (u & 3);
#pragma unroll
                for (int n = 0; n < 4; ++n)
#pragma unroll
                    for (int j = 0; j < 4; ++j) {
                        const int c = n0 - OV + wc * 64 + n * 16 + 4 * fq + j;
                        VT[((size_t)(b * 4 + (c >> 7)) * 128 + (c & 127)) * SS + ps] = f2bf(acc[m][n][j]);
                    }
            } else {
#pragma unroll
                for (int n = 0; n < 4; ++n) {
                    u32x2 o; o[0] = pk2bf(acc[m][n][0], acc[m][n][1]); o[1] = pk2bf(acc[m][n][2], acc[m][n][3]);
                    *(u32x2*)(P + (size_t)r * DINP + n0 + wc * 64 + n * 16 + 4 * fq) = o;
                }
            }
        }
    }
};
struct EpiF32 {
    float* C; int ldc; int m0, n0;
    __device__ __forceinline__ void operator()(f32x4 (&acc)[4][4], int wr, int wc, int fr, int fq) const {
#pragma unroll
        for (int m = 0; m < 4; ++m)
#pragma unroll
            for (int n = 0; n < 4; ++n) *(f32x4*)(C + (size_t)(m0 + wr * 64 + m * 16 + fr) * ldc + n0 + wc * 64 + n * 16 + 4 * fq) = acc[m][n];
    }
};
struct EpiMoE1 {
    bf16_t* hid; int m0, n0, cap;
    __device__ __forceinline__ void operator()(f32x4 (&acc)[4][4], int wr, int wc, int fr, int fq) const {
#pragma unroll
        for (int m = 0; m < 4; ++m) {
            const int r = m0 + wr * 64 + m * 16 + fr;
            if (r >= cap) continue;
#pragma unroll
            for (int q = 0; q < 2; ++q) {
                float v[4];
#pragma unroll
                for (int j = 0; j < 4; ++j) v[j] = siluf(acc[m][2 * q][j]) * acc[m][2 * q + 1][j];
                u32x2 o; o[0] = pk2bf(v[0], v[1]); o[1] = pk2bf(v[2], v[3]);
                *(u32x2*)(hid + (size_t)r * DM + (n0 >> 1) + wc * 32 + q * 16 + 4 * fq) = o;
            }
        }
    }
};
struct EpiMoE2 {
    bf16_t* ye; const float* aff; const int* sel; int e, m0, n0, cap;
    __device__ __forceinline__ void operator()(f32x4 (&acc)[4][4], int wr, int wc, int fr, int fq) const {
#pragma unroll
        for (int m = 0; m < 4; ++m) {
            const int r = m0 + wr * 64 + m * 16 + fr;
            if (r >= cap) continue;
            const float sc = aff[(size_t)sel[r] * NE + e];
#pragma unroll
            for (int n = 0; n < 4; ++n) {
                u32x2 o; o[0] = pk2bf(acc[m][n][0] * sc, acc[m][n][1] * sc); o[1] = pk2bf(acc[m][n][2] * sc, acc[m][n][3] * sc);
                *(u32x2*)(ye + (size_t)r * DM + n0 + wc * 64 + n * 16 + 4 * fq) = o;
            }
        }
    }
};

#define ATT_WAIT_V(n) asm volatile("s_waitcnt vmcnt(" #n ")" ::: "memory")
#define ATT_WAIT_L0() asm volatile("s_waitcnt lgkmcnt(0)" ::: "memory")
__device__ __forceinline__ void f_attn(const bf16_t* __restrict__ P, const bf16_t* __restrict__ VT, bf16_t* OM, int bh, int map, int qb, char* lds) {
    const int TID = ltid();
    const int lane = TID & 63, wid = TID >> 6, ql = lane & 31, hi = lane >> 5;
    const int b = bh >> 2, h = bh & 3;
    const int row0 = b * SS + qb * 128;
    const int ntiles = (qb < 2 ? CL : SS) / 64;
    const float C = 0.125f * 1.4426950408889634f;
    float* wsf = (float*)(lds + 73728) + wid * 32;
    const int wu = __builtin_amdgcn_readfirstlane(wid);
    const bf16_t* kg[2]; const bf16_t* vg[4];
#pragma unroll
    for (int i = 0; i < 2; ++i) {
        const int krow = 8 * (wu + 4 * i) + (lane >> 3);
        kg[i] = P + (size_t)(b * SS + krow) * DINP + OKK + h * 128 + map * 64 + (((lane & 7) ^ ((krow >> 1) & 7)) << 3);
    }
#pragma unroll
    for (int i = 0; i < 4; ++i) {
        const int vrow = 8 * (wu + 4 * i) + (lane >> 3);
        vg[i] = VT + (size_t)(bh * 128 + vrow) * SS + (((lane & 7) ^ ((vrow >> 1) & 7)) << 3);
    }
    bf16x8 qf[4];
    {
        const bf16_t* qp = P + (size_t)(row0 + wid * 32 + ql) * DINP + OQ + h * 128 + map * 64 + 8 * hi;
#pragma unroll
        for (int d0 = 0; d0 < 4; ++d0) qf[d0] = *(const bf16x8*)(qp + 16 * d0);
    }
    f32x16 O[4];
#pragma unroll
    for (int cb = 0; cb < 4; ++cb)
#pragma unroll
        for (int r = 0; r < 16; ++r) O[cb][r] = 0.f;
    float mrun = -1e30f, lrun = 0.f;
    LDS_AS char* l3 = (LDS_AS char*)lds;
#define ATT_STAGE(t_, st_) do { \
        _Pragma("unroll") for (int i_ = 0; i_ < 2; ++i_) __builtin_amdgcn_global_load_lds((const unsigned*)(kg[i_] + (size_t)(t_) * 64 * DINP), (LDS_AS unsigned*)(l3 + (st_) * 24576 + (wu + 4 * i_) * 1024), 16, 0, 0); \
        _Pragma("unroll") for (int i_ = 0; i_ < 4; ++i_) __builtin_amdgcn_global_load_lds((const unsigned*)(vg[i_] + (t_) * 64), (LDS_AS unsigned*)(l3 + (st_) * 24576 + 8192 + (wu + 4 * i_) * 1024), 16, 0, 0); } while (0)
    ATT_WAIT_V(0); ATT_WAIT_L0();
    __builtin_amdgcn_s_barrier();
    ATT_STAGE(0, 0);
    if (ntiles > 1) ATT_STAGE(1, 1);
    if (ntiles > 1) ATT_WAIT_V(6); else ATT_WAIT_V(0);
    __builtin_amdgcn_s_barrier();
    const int swz = (ql >> 1) & 7;
    int st = 0;
    for (int t = 0; t < ntiles; ++t) {
        const int st2 = st >= 1 ? st - 1 : 2;
        if (t + 2 < ntiles) ATT_STAGE(t + 2, st2);
        const char* kb = lds + st * 24576;
        const char* vb = kb + 8192;
        f32x16 p0, p1;
#pragma unroll
        for (int r = 0; r < 16; ++r) { p0[r] = 0.f; p1[r] = 0.f; }
        bf16x8 kf[8];
#pragma unroll
        for (int d0 = 0; d0 < 4; ++d0) {
            const int co = ((2 * d0 + hi) ^ swz) << 4;
            kf[2 * d0] = *(const bf16x8*)(kb + ql * 128 + co);
            kf[2 * d0 + 1] = *(const bf16x8*)(kb + (32 + ql) * 128 + co);
        }
#pragma unroll
        for (int d0 = 0; d0 < 4; ++d0) p0 = MFMA32(kf[2 * d0], qf[d0], p0);
        bf16x8 vf[8];
#pragma unroll
        for (int cb = 0; cb < 4; ++cb)
#pragma unroll
            for (int s = 0; s < 2; ++s) vf[cb * 2 + s] = *(const bf16x8*)(vb + (cb * 32 + ql) * 128 + (((2 * s + hi) ^ swz) << 4));
#pragma unroll
        for (int d0 = 0; d0 < 4; ++d0) p1 = MFMA32(kf[2 * d0 + 1], qf[d0], p1);
#define ATT_SOFTMAX_HALF(PP, PF0, PF1) do { \
        float tm_ = PP[0]; \
        _Pragma("unroll") for (int r = 1; r < 16; ++r) tm_ = fmaxf(tm_, PP[r]); \
        { auto rr_ = __builtin_amdgcn_permlane32_swap(__float_as_uint(tm_), __float_as_uint(tm_), false, false); tm_ = fmaxf(__uint_as_float(rr_[0]), __uint_as_float(rr_[1])); } \
        const float mnew_ = fmaxf(mrun, tm_); \
        if (__any((mnew_ - mrun) * C > 8.f)) { \
            const float alpha_ = __builtin_amdgcn_exp2f((mrun - mnew_) * C); \
            lrun *= alpha_; mrun = mnew_; \
            if (hi == 0) wsf[ql] = alpha_; \
            ATT_WAIT_L0(); \
            _Pragma("unroll") for (int r = 0; r < 16; ++r) { const float f_ = wsf[crow(r, hi)]; _Pragma("unroll") for (int cb = 0; cb < 4; ++cb) O[cb][r] *= f_; } \
        } \
        const float mc_ = mrun * C; float ls_ = 0.f; \
        _Pragma("unroll") for (int r = 0; r < 16; ++r) { PP[r] = __builtin_amdgcn_exp2f(fmaf(PP[r], C, -mc_)); ls_ += PP[r]; } \
        lrun += ls_; \
        { u32x4 w_; _Pragma("unroll") for (int j = 0; j < 4; ++j) w_[j] = pk2bf(PP[2 * j], PP[2 * j + 1]); PF0 = __builtin_bit_cast(bf16x8, w_); } \
        { u32x4 w_; _Pragma("unroll") for (int j = 0; j < 4; ++j) w_[j] = pk2bf(PP[8 + 2 * j], PP[8 + 2 * j + 1]); PF1 = __builtin_bit_cast(bf16x8, w_); } } while (0)
        bf16x8 pfa, pfb;
        ATT_SOFTMAX_HALF(p0, pfa, pfb);
#pragma unroll
        for (int cb = 0; cb < 4; ++cb) { O[cb] = MFMA32(pfa, vf[cb * 2], O[cb]); O[cb] = MFMA32(pfb, vf[cb * 2 + 1], O[cb]); }
#pragma unroll
        for (int cb = 0; cb < 4; ++cb)
#pragma unroll
            for (int s = 0; s < 2; ++s) vf[cb * 2 + s] = *(const bf16x8*)(vb + (cb * 32 + ql) * 128 + (((2 * (2 + s) + hi) ^ swz) << 4));
        ATT_SOFTMAX_HALF(p1, pfa, pfb);
#pragma unroll
        for (int cb = 0; cb < 4; ++cb) { O[cb] = MFMA32(pfa, vf[cb * 2], O[cb]); O[cb] = MFMA32(pfb, vf[cb * 2 + 1], O[cb]); }
#undef ATT_SOFTMAX_HALF
        if (t + 2 < ntiles) ATT_WAIT_V(6); else ATT_WAIT_V(0);
        ATT_WAIT_L0();
        __builtin_amdgcn_s_barrier();
        __builtin_amdgcn_sched_barrier(0);
        st = st == 2 ? 0 : st + 1;
    }
#undef ATT_STAGE
    { auto rr = __builtin_amdgcn_permlane32_swap(__float_as_uint(lrun), __float_as_uint(lrun), false, false); lrun = __uint_as_float(rr[0]) + __uint_as_float(rr[1]); }
    if (hi == 0) wsf[ql] = 1.f / lrun;
    ATT_WAIT_L0();
    bf16_t* dst = OM + ((size_t)map * RR + row0 + wid * 32) * 512 + h * 128 + ql;
#pragma unroll
    for (int r = 0; r < 16; ++r) {
        const int q = crow(r, hi);
        const float f = wsf[q];
#pragma unroll
        for (int cb = 0; cb < 4; ++cb) dst[(size_t)q * 512 + cb * 32] = f2bf(O[cb][r] * f);
    }
}

__device__ __forceinline__ void f_gdn_prep(const bf16_t* __restrict__ p, const float* __restrict__ conv_w, const float* __restrict__ a_log,
                                                  const float* __restrict__ dt_bias, bf16_t* gq, bf16_t* gk, bf16_t* gv, float* gab, int vb) {
    const int TID = ltid();
    const int r0 = vb * 8, c = TID;
    const int b = r0 >= SS ? 1 : 0, s0 = r0 - b * SS;
    const int seg_lo = s0 < CL ? 0 : CL, seg_hi = s0 < CL ? CL : SS;
    float xin[3][12];
#pragma unroll
    for (int t = 0; t < 12; ++t) {
        const int s2 = s0 + t - 2;
        const bool ok = s2 >= seg_lo && s2 < seg_hi;
        const bf16_t* rp = p + (size_t)(b * SS + (ok ? s2 : s0)) * DINP + OGQKV + c;
#pragma unroll
        for (int j3 = 0; j3 < 3; ++j3) { const float v = bf2f(rp[j3 * 256]); xin[j3][t] = ok ? v : 0.f; }
    }
    float cw[3][5];
#pragma unroll
    for (int j3 = 0; j3 < 3; ++j3)
#pragma unroll
        for (int j = 0; j < 5; ++j) cw[j3][j] = conv_w[j * 768 + j3 * 256 + c];
#pragma unroll
    for (int i = 0; i < 8; ++i) {
        float val[3];
#pragma unroll
        for (int j3 = 0; j3 < 3; ++j3) {
            float acc = 0.f;
#pragma unroll
            for (int j = 0; j < 5; ++j) acc += xin[j3][i + j] * cw[j3][j];
            val[j3] = siluf(acc);
        }
        const float sq = wave_sum(val[0] * val[0]);
        const float sk = wave_sum(val[1] * val[1]);
        const size_t r = r0 + i;
        gq[r * 256 + c] = f2bf(val[0] * rsqrtf(sq + 1e-12f) * 0.125f);
        gk[r * 256 + c] = f2bf(val[1] * rsqrtf(sk + 1e-12f));
        gv[r * 256 + c] = f2bf(val[2]);
    }
    if (c < 128) {
        const size_t r = r0 + (c >> 4); const int q = c & 15;
        if (q < 8) {
            const float av = bf2f(p[r * DINP + OGA + q]);
            const float xx = av + dt_bias[q];
            const float sp = xx > 20.f ? xx : log1pf(expf(xx));
            gab[r * 16 + q] = -expf(a_log[q]) * sp;
        } else {
            gab[r * 16 + q] = sigmf(bf2f(p[r * DINP + OGB + (q - 8)]));
        }
    }
}

__device__ __forceinline__ void f_rwkv_prep_phase(const bf16_t* __restrict__ p, const float* __restrict__ w0, const float* __restrict__ w_up,
                                                   const float* __restrict__ a0, const float* __restrict__ a_up, const float* __restrict__ k_k,
                                                   const float* __restrict__ k_a, bf16_t* kk_o, float* w_o, bf16_t* kka_o, bf16_t* kd_o, int vb0, int nvb, int nitems, float* lds) {
    const int TID = ltid();
    float* xwT = lds;
    float* xaT = lds + 256;
    const int c = TID;
    float wu[2][32], au[2][32];
#pragma unroll
    for (int d = 0; d < 2; ++d)
#pragma unroll
        for (int j = 0; j < 32; ++j) { wu[d][j] = w_up[(d * 32 + j) * 256 + c]; au[d][j] = a_up[(d * 32 + j) * 256 + c]; }
    const float kkc = k_k[c], kac = k_a[c];
    const float w0c[2] = {w0[c], w0[256 + c]}, a0c[2] = {a0[c], a0[256 + c]};
    for (int vb = vb0; vb < nitems; vb += nvb) {
        const int r0 = vb * 8;
        __syncthreads();
        {
            const int i = TID >> 5, j = TID & 31;
            const bf16_t* pr = p + (size_t)(r0 + i) * DINP;
            xwT[j * 8 + i] = tanhf(bf2f(pr[OXW + j]));
            xaT[j * 8 + i] = bf2f(pr[OXA + j]);
        }
        float k[8], kk[8];
#pragma unroll
        for (int i = 0; i < 8; ++i) k[i] = bf2f(p[(size_t)(r0 + i) * DINP + ORKV + 256 + c]);
#pragma unroll
        for (int i = 0; i < 8; ++i) {
            const float kq = k[i] * kkc;
            const float ss = wave_sum(kq * kq);
            kk[i] = kq * rsqrtf(ss + 1e-12f);
            kk_o[(size_t)(r0 + i) * 256 + c] = f2bf(kk[i]);
        }
        __syncthreads();
#pragma unroll
        for (int d = 0; d < 2; ++d) {
            float aw[8], aa[8];
#pragma unroll
            for (int i = 0; i < 8; ++i) { aw[i] = w0c[d]; aa[i] = a0c[d]; }
#pragma unroll
            for (int j = 0; j < 32; ++j) {
                const f32x4 x0 = *(const f32x4*)(xwT + j * 8), x1 = *(const f32x4*)(xwT + j * 8 + 4);
                const f32x4 y0 = *(const f32x4*)(xaT + j * 8), y1 = *(const f32x4*)(xaT + j * 8 + 4);
#pragma unroll
                for (int i = 0; i < 4; ++i) { aw[i] += x0[i] * wu[d][j]; aw[4 + i] += x1[i] * wu[d][j]; aa[i] += y0[i] * au[d][j]; aa[4 + i] += y1[i] * au[d][j]; }
            }
#pragma unroll
            for (int i = 0; i < 8; ++i) {
                const float logw = -0.6065306597126334f * sigmf(aw[i]);
                const float ad = sigmf(aa[i]);
                const size_t r = r0 + i;
                w_o[r * 512 + d * 256 + c] = logw;
                kka_o[r * 512 + d * 256 + c] = f2bf(kk[i] * ad);
                kd_o[r * 512 + d * 256 + c] = f2bf(k[i] * (1.f + (ad - 1.f) * kac));
            }
        }
    }
}

#define MFMA16(a, b, c) __builtin_amdgcn_mfma_f32_16x16x32_bf16((a), (b), (c), 0, 0, 0)
__device__ __forceinline__ int scan_row(int b, int dir, int p) {
    const int s = dir == 0 ? p : (p < CL ? (CL - 1 - p) : (CL + (TL - 1 - (p - CL))));
    return b * SS + s;
}
__device__ __forceinline__ void mm64(const char* A, const char* Bt, f32x4 (&acc)[4], int w, int fr, int fq) {
#pragma unroll
    for (int ks = 0; ks < 2; ++ks) {
        const int co = ((ks * 4 + fq) ^ (fr >> 1)) << 4;
        const bf16x8 af = *(const bf16x8*)(A + (16 * w + fr) * 128 + co);
#pragma unroll
        for (int n = 0; n < 4; ++n) { const bf16x8 bfr = *(const bf16x8*)(Bt + (16 * n + fr) * 128 + co); acc[n] = MFMA16(bfr, af, acc[n]); }
    }
}
__device__ __forceinline__ void zero4(f32x4 (&acc)[4]) {
#pragma unroll
    for (int n = 0; n < 4; ++n) acc[n] = (f32x4){0.f, 0.f, 0.f, 0.f};
}
__device__ __forceinline__ void tile_row_write(char* T, int c, const float (&x)[64]) {
#pragma unroll
    for (int ch = 0; ch < 8; ++ch) {
        u32x4 o; o[0] = pk2bf(x[8 * ch], x[8 * ch + 1]); o[1] = pk2bf(x[8 * ch + 2], x[8 * ch + 3]); o[2] = pk2bf(x[8 * ch + 4], x[8 * ch + 5]); o[3] = pk2bf(x[8 * ch + 6], x[8 * ch + 7]);
        *(u32x4*)(T + c * 128 + ((ch ^ ((c >> 1) & 7)) << 4)) = o;
    }
}
__device__ __forceinline__ void tri_solve_tile(const float* Am, char* T, int c) {
    const int rs = (c >> 1) & 7;
    char* rowp = T + c * 128;
#pragma unroll 1
    for (int b = 0; b < 8; ++b) {
        float acc[8];
        {
            const bf16x8 v = *(const bf16x8*)(rowp + ((b ^ rs) << 4));
#pragma unroll
            for (int e = 0; e < 8; ++e) acc[e] = bf2f((bf16_t)v[e]);
        }
        const float* Ab = Am + (8 * b) * 64;
#pragma unroll 1
        for (int ch = 0; ch < b; ++ch) {
            const bf16x8 v = *(const bf16x8*)(rowp + ((ch ^ rs) << 4));
            float xv[8];
#pragma unroll
            for (int e = 0; e < 8; ++e) xv[e] = bf2f((bf16_t)v[e]);
#pragma unroll
            for (int r = 0; r < 8; ++r) {
                const f32x4 a0 = *(const f32x4*)(Ab + r * 64 + 8 * ch), a1 = *(const f32x4*)(Ab + r * 64 + 8 * ch + 4);
                acc[r] -= ((a0[0] * xv[0] + a0[1] * xv[1]) + (a0[2] * xv[2] + a0[3] * xv[3])) + ((a1[0] * xv[4] + a1[1] * xv[5]) + (a1[2] * xv[6] + a1[3] * xv[7]));
            }
        }
        f32x4 d0[8], d1[8];
#pragma unroll
        for (int r = 1; r < 8; ++r) { d0[r] = *(const f32x4*)(Ab + r * 64 + 8 * b); d1[r] = *(const f32x4*)(Ab + r * 64 + 8 * b + 4); }
#pragma unroll
        for (int r = 1; r < 8; ++r) {
            float s = 0.f;
#pragma unroll
            for (int q = 0; q < r; ++q) s += (q < 4 ? d0[r][q & 3] : d1[r][q & 3]) * acc[q];
            acc[r] -= s;
        }
        u32x4 o; o[0] = pk2bf(acc[0], acc[1]); o[1] = pk2bf(acc[2], acc[3]); o[2] = pk2bf(acc[4], acc[5]); o[3] = pk2bf(acc[6], acc[7]);
        *(u32x4*)(rowp + ((b ^ rs) << 4)) = o;
    }
}
__device__ __forceinline__ void store_perm(bf16_t* dst, const f32x4 (&acc)[4], int w, int fr, int fq) {
#pragma unroll
    for (int n = 0; n < 4; ++n) {
        u32x2 o; o[0] = pk2bf(acc[n][0], acc[n][1]); o[1] = pk2bf(acc[n][2], acc[n][3]);
        *(u32x2*)(dst + (16 * w + fr) * 64 + 32 * (n >> 1) + 8 * fq + 4 * (n & 1)) = o;
    }
}
__device__ __forceinline__ void store_acc(bf16_t* dst, const f32x4 (&acc)[4], int w, int fr, int fq) {
#pragma unroll
    for (int n = 0; n < 4; ++n)
#pragma unroll
        for (int jj = 0; jj < 4; ++jj) dst[((n * 4 + w) * 64 + (4 * fq + jj) + 16 * (fr >> 2)) * 4 + (fr & 3)] = f2bf(acc[n][jj]);
}

#define TILE(k) (lds + (k) * 8192)
#define SCAL ((float*)(lds + 73728))
__device__ __forceinline__ float tile_get(const char* T, int i, int c3, int clow) { return bf2f(*(const bf16_t*)(T + i * 128 + (((c3 ^ ((i >> 1) & 7)) << 4) | clow))); }
__device__ __forceinline__ void tile_put(char* T, int i, int c3, int clow, float v) { *(bf16_t*)(T + i * 128 + (((c3 ^ ((i >> 1) & 7)) << 4) | clow)) = f2bf(v); }
__device__ __forceinline__ void stage_tile(char* T, const bf16_t* base, size_t ld, int b, int dir, int p0, int TID) {
#pragma unroll
    for (int k = 0; k < 2; ++k) {
        const int id = TID + 256 * k, row = id >> 3, chn = id & 7;
        const size_t r = scan_row(b, dir, p0 + row);
        *(u32x4*)(T + row * 128 + ((chn ^ ((row >> 1) & 7)) << 4)) = *(const u32x4*)(base + r * ld + chn * 8);
    }
}
__device__ __forceinline__ f32x4 tile_get4(const char* T, int i, int j0) {
    const u32x2 rv = *(const u32x2*)(T + i * 128 + (((j0 >> 3) ^ ((i >> 1) & 7)) << 4) + (j0 & 7) * 2);
    return (f32x4){bf2f((bf16_t)(rv[0] & 0xffffu)), bf2f((bf16_t)(rv[0] >> 16)), bf2f((bf16_t)(rv[1] & 0xffffu)), bf2f((bf16_t)(rv[1] >> 16))};
}
__device__ __forceinline__ void tile_put4(char* T, int i, int j0, float v0, float v1, float v2, float v3) {
    u32x2 o; o[0] = pk2bf(v0, v1); o[1] = pk2bf(v2, v3);
    *(u32x2*)(T + i * 128 + (((j0 >> 3) ^ ((i >> 1) & 7)) << 4) + (j0 & 7) * 2) = o;
}

__device__ __forceinline__ void f_chunk_gdn(const bf16_t* __restrict__ gq, const bf16_t* __restrict__ gk, const bf16_t* __restrict__ gv, const float* __restrict__ gab,
                                            bf16_t* X, int chain, int n, char* lds) {
    const int TID = ltid();
    const int lane = TID & 63, w = TID >> 6, fr = lane & 15, fq = lane >> 4;
    const int dir = chain & 1, h = (chain >> 1) & 3, b = chain >> 3;
    float* gcs = SCAL; float* bts = SCAL + 64;
    float* Am = (float*)TILE(7);
    __syncthreads();
    if (TID < 64) {
        const int r = scan_row(b, dir, n * 64 + TID);
        float g = gab[(size_t)r * 16 + dir * 4 + h];
#pragma unroll
        for (int o = 1; o < 64; o <<= 1) { const float t = __shfl_up(g, o); if (lane >= o) g += t; }
        gcs[TID] = g; bts[TID] = gab[(size_t)r * 16 + 8 + dir * 4 + h];
    }
    stage_tile(TILE(0), gq + h * 64, 256, b, dir, n * 64, TID);
    stage_tile(TILE(1), gk + h * 64, 256, b, dir, n * 64, TID);
    stage_tile(TILE(3), gv + h * 64, 256, b, dir, n * 64, TID);
    __syncthreads();
    {
        const int i = 16 * w + fr; const float gi = gcs[i], bi = bts[i];
        f32x4 acc[4]; zero4(acc); mm64(TILE(1), TILE(1), acc, w, fr, fq);
#pragma unroll
        for (int nn = 0; nn < 4; ++nn)
#pragma unroll
            for (int jj = 0; jj < 4; ++jj) { const int j = 16 * nn + 4 * fq + jj; Am[i * 64 + j] = j < i ? bi * acc[nn][jj] * __expf(gi - gcs[j]) : 0.f; }
        zero4(acc); mm64(TILE(0), TILE(1), acc, w, fr, fq);
#pragma unroll
        for (int nn = 0; nn < 4; ++nn) {
            float v[4];
#pragma unroll
            for (int jj = 0; jj < 4; ++jj) { const int j = 16 * nn + 4 * fq + jj; v[jj] = j <= i ? acc[nn][jj] * __expf(gi - gcs[j]) : 0.f; }
            tile_put4(TILE(2), i, 16 * nn + 4 * fq, v[0], v[1], v[2], v[3]);
        }
    }
    __syncthreads();
    if (TID < 192) {
        const int c = lane, c3 = c >> 3, clow = (c & 7) << 1;
        float x[64];
        if (w == 0) {
#pragma unroll
            for (int i = 0; i < 64; ++i) x[i] = tile_get(TILE(3), i, c3, clow) * bts[i];
            tile_row_write(TILE(4), c, x); tri_solve_tile(Am, TILE(4), c);
        } else if (w == 1) {
#pragma unroll
            for (int i = 0; i < 64; ++i) x[i] = tile_get(TILE(1), i, c3, clow) * bts[i] * __expf(gcs[i]);
            tile_row_write(TILE(5), c, x); tri_solve_tile(Am, TILE(5), c);
        } else {
            const float g63 = gcs[63];
#pragma unroll
            for (int i = 0; i < 64; ++i) x[i] = tile_get(TILE(1), i, c3, clow) * __expf(g63 - gcs[i]);
            tile_row_write(TILE(6), c, x);
        }
    }
    __syncthreads();
    {
        bf16_t* Xi = X + ((size_t)(chain * 132 + n)) * 16384;
        const int i = 16 * w + fr;
        f32x4 acc[4];
        zero4(acc); mm64(TILE(2), TILE(4), acc, w, fr, fq); store_acc(Xi + 8192, acc, w, fr, fq);
        zero4(acc); mm64(TILE(2), TILE(5), acc, w, fr, fq);
        {
            const float eg = __expf(gcs[i]);
#pragma unroll
            for (int nn = 0; nn < 4; ++nn) { const f32x4 qv = tile_get4(TILE(0), i, 16 * nn + 4 * fq); acc[nn] = qv * eg - acc[nn]; }
            store_perm(Xi + 4096, acc, w, fr, fq);
        }
        zero4(acc); mm64(TILE(6), TILE(5), acc, w, fr, fq);
        {
            const float gt = __expf(gcs[63]);
#pragma unroll
            for (int nn = 0; nn < 4; ++nn)
#pragma unroll
                for (int jj = 0; jj < 4; ++jj) acc[nn][jj] = ((16 * nn + 4 * fq + jj) == i ? gt : 0.f) - acc[nn][jj];
            store_perm(Xi, acc, w, fr, fq);
        }
        zero4(acc); mm64(TILE(6), TILE(4), acc, w, fr, fq); store_acc(Xi + 12288, acc, w, fr, fq);
    }
}

__device__ __forceinline__ void f_chunk_rwkv(const bf16_t* __restrict__ P, const bf16_t* __restrict__ kk_i, const float* __restrict__ lw_i, const bf16_t* __restrict__ kka_i,
                                             const bf16_t* __restrict__ kd_i, bf16_t* X, int chain, int n, char* lds) {
    const int TID = ltid();
    const int lane = TID & 63, w = TID >> 6, fr = lane & 15, fq = lane >> 4;
    const int dir = chain & 1, h = (chain >> 1) & 3, b = chain >> 3;
    const int c3 = lane >> 3, clow = (lane & 7) << 1;
    float* wc = SCAL;
    float* Am = (float*)TILE(7);
    __syncthreads();
    stage_tile(TILE(0), kk_i + h * 64, 256, b, dir, n * 64, TID);
    stage_tile(TILE(1), kka_i + dir * 256 + h * 64, 512, b, dir, n * 64, TID);
    stage_tile(TILE(2), kd_i + dir * 256 + h * 64, 512, b, dir, n * 64, TID);
    stage_tile(TILE(3), P + ORKV + h * 64, DINP, b, dir, n * 64, TID);
    stage_tile(TILE(4), P + ORKV + 512 + h * 64, DINP, b, dir, n * 64, TID);
#pragma unroll
    for (int k = 0; k < 4; ++k) {
        const int id = TID + 256 * k, row = id >> 4, chn = id & 15;
        const size_t r = scan_row(b, dir, n * 64 + row);
        *(f32x4*)(Am + row * 64 + chn * 4) = *(const f32x4*)(lw_i + r * 512 + dir * 256 + h * 64 + chn * 4);
    }
    __syncthreads();
    {
        float lc = 0.f;
        char* T = TILE(w);
#pragma unroll
        for (int i = 0; i < 64; ++i) {
            const float lprev = lc; lc += Am[i * 64 + lane];
            const float e = w == 0 ? lprev : (w == 3 ? lc : -lc);
            tile_put(T, i, c3, clow, tile_get(T, i, c3, clow) * __expf(e));
        }
        if (w == 0) wc[lane] = __expf(lc);
    }
    __syncthreads();
    if (w == 0) {
        float x[64];
#pragma unroll
        for (int i = 0; i < 64; ++i) x[i] = tile_get(TILE(4), i, c3, clow);
        tile_row_write(TILE(5), lane, x);
    }
    {
        const int i = 16 * w + fr;
        f32x4 acc[4];
        zero4(acc); mm64(TILE(0), TILE(1), acc, w, fr, fq);
#pragma unroll
        for (int nn = 0; nn < 4; ++nn)
#pragma unroll
            for (int jj = 0; jj < 4; ++jj) { const int j = 16 * nn + 4 * fq + jj; Am[i * 64 + j] = j < i ? acc[nn][jj] : 0.f; }
        zero4(acc); mm64(TILE(0), TILE(2), acc, w, fr, fq);
#pragma unroll
        for (int nn = 0; nn < 4; ++nn) {
            float v[4];
#pragma unroll
            for (int jj = 0; jj < 4; ++jj) { const int j = 16 * nn + 4 * fq + jj; v[jj] = j < i ? acc[nn][jj] : 0.f; }
            tile_put4(TILE(6), i, 16 * nn + 4 * fq, v[0], v[1], v[2], v[3]);
        }
    }
    __syncthreads();
    {
        const int i = 16 * w + fr;
        f32x4 acc[4]; zero4(acc); mm64(TILE(6), TILE(5), acc, w, fr, fq);
#pragma unroll
        for (int nn = 0; nn < 4; ++nn)
#pragma unroll
            for (int jj = 0; jj < 4; ++jj) { const int c = 16 * nn + 4 * fq + jj; *(bf16_t*)(TILE(4) + c * 128 + ((((i >> 3) ^ ((c >> 1) & 7)) << 4) | ((i & 7) << 1))) = f2bf(acc[nn][jj]); }
    }
    __syncthreads();
    if (w < 2) {
        float x[64];
        if (w == 0) {
#pragma unroll
            for (int ch = 0; ch < 8; ++ch) {
                const bf16x8 v = *(const bf16x8*)(TILE(4) + lane * 128 + ((ch ^ ((lane >> 1) & 7)) << 4));
#pragma unroll
                for (int e = 0; e < 8; ++e) x[8 * ch + e] = -bf2f((bf16_t)v[e]);
            }
        } else {
#pragma unroll
            for (int i = 0; i < 64; ++i) x[i] = tile_get(TILE(0), i, c3, clow);
        }
        tile_row_write(w == 0 ? TILE(6) : TILE(0), lane, x);
        tri_solve_tile(Am, w == 0 ? TILE(6) : TILE(0), lane);
    }
    __syncthreads();
    {
        const int i = 16 * w + fr;
#pragma unroll
        for (int q = 0; q < 2; ++q) {
            f32x4 acc[4]; zero4(acc); mm64(TILE(3), TILE(1 + q), acc, w, fr, fq);
#pragma unroll
            for (int nn = 0; nn < 4; ++nn) {
                float v[4];
#pragma unroll
                for (int jj = 0; jj < 4; ++jj) { const int j = 16 * nn + 4 * fq + jj; v[jj] = j <= i ? acc[nn][jj] : 0.f; }
                tile_put4(TILE(7 + q), i, 16 * nn + 4 * fq, v[0], v[1], v[2], v[3]);
            }
        }
    }
    if (w == 0) {
        float x[64]; const float wd = wc[lane];
#pragma unroll
        for (int i = 0; i < 64; ++i) x[i] = tile_get(TILE(1), i, c3, clow) * wd;
        tile_row_write(TILE(4), lane, x);
    }
    __syncthreads();
    bf16_t* Xi = X + ((size_t)((16 + chain) * 132 + n)) * 16384;
    f32x4 sa[4];
    {
        const int i = 16 * w + fr;
        f32x4 acc[4];
        zero4(acc); mm64(TILE(7), TILE(6), acc, w, fr, fq); mm64(TILE(8), TILE(5), acc, w, fr, fq); store_acc(Xi + 8192, acc, w, fr, fq);
        zero4(acc); mm64(TILE(7), TILE(0), acc, w, fr, fq);
#pragma unroll
        for (int nn = 0; nn < 4; ++nn) { const f32x4 rv = tile_get4(TILE(3), i, 16 * nn + 4 * fq); acc[nn] = rv - acc[nn]; }
        store_perm(Xi + 4096, acc, w, fr, fq);
        zero4(acc); mm64(TILE(4), TILE(0), acc, w, fr, fq);
        {
            const float wd = wc[i];
#pragma unroll
            for (int nn = 0; nn < 4; ++nn)
#pragma unroll
                for (int jj = 0; jj < 4; ++jj) acc[nn][jj] = ((16 * nn + 4 * fq + jj) == i ? wd : 0.f) - acc[nn][jj];
            store_perm(Xi, acc, w, fr, fq);
        }
        zero4(sa); mm64(TILE(4), TILE(6), sa, w, fr, fq);
    }
    __syncthreads();
    if (w == 0) {
        float x[64]; const float wd = wc[lane];
#pragma unroll
        for (int i = 0; i < 64; ++i) x[i] = tile_get(TILE(2), i, c3, clow) * wd;
        tile_row_write(TILE(4), lane, x);
    }
    __syncthreads();
    mm64(TILE(4), TILE(5), sa, w, fr, fq); store_acc(Xi + 12288, sa, w, fr, fq);
}

struct ScanOps { bf16x8 ar[4][2], ag[4][2]; u32x2 y0[4], s0[4]; };
__device__ __forceinline__ void scan_load(ScanOps& o, const bf16_t* Xi, int slab, int lane, int c, int q) {
#pragma unroll
    for (int mb = 0; mb < 4; ++mb) {
        o.y0[mb] = *(const u32x2*)(Xi + 8192 + ((slab * 4 + mb) * 64 + lane) * 4);
        o.s0[mb] = *(const u32x2*)(Xi + 12288 + ((slab * 4 + mb) * 64 + lane) * 4);
#pragma unroll
        for (int s = 0; s < 2; ++s) {
            o.ar[mb][s] = *(const bf16x8*)(Xi + 4096 + (16 * mb + c) * 64 + 32 * s + 8 * q);
            o.ag[mb][s] = *(const bf16x8*)(Xi + (16 * mb + c) * 64 + 32 * s + 8 * q);
        }
    }
}
__device__ __forceinline__ void scan_step(const ScanOps& o, f32x4 (&S)[4], bf16_t* so, int b, int dir, int colbase, int n, int c, int q) {
    bf16x8 bS[2];
#pragma unroll
    for (int s = 0; s < 2; ++s) {
        u32x4 w; w[0] = pk2bf(S[2 * s][0], S[2 * s][1]); w[1] = pk2bf(S[2 * s][2], S[2 * s][3]); w[2] = pk2bf(S[2 * s + 1][0], S[2 * s + 1][1]); w[3] = pk2bf(S[2 * s + 1][2], S[2 * s + 1][3]);
        bS[s] = __builtin_bit_cast(bf16x8, w);
    }
#pragma unroll
    for (int mb = 0; mb < 4; ++mb) {
        f32x4 y = (f32x4){bf2f((bf16_t)(o.y0[mb][0] & 0xffffu)), bf2f((bf16_t)(o.y0[mb][0] >> 16)), bf2f((bf16_t)(o.y0[mb][1] & 0xffffu)), bf2f((bf16_t)(o.y0[mb][1] >> 16))};
        f32x4 sn = (f32x4){bf2f((bf16_t)(o.s0[mb][0] & 0xffffu)), bf2f((bf16_t)(o.s0[mb][0] >> 16)), bf2f((bf16_t)(o.s0[mb][1] & 0xffffu)), bf2f((bf16_t)(o.s0[mb][1] >> 16))};
#pragma unroll
        for (int s = 0; s < 2; ++s) { y = MFMA16(o.ar[mb][s], bS[s], y); sn = MFMA16(o.ag[mb][s], bS[s], sn); }
#pragma unroll
        for (int reg = 0; reg < 4; ++reg) {
            const int r = scan_row(b, dir, n * 64 + 16 * mb + 4 * q + reg);
            so[((size_t)dir * RR + r) * 512 + colbase + c] = f2bf(y[reg]);
        }
        S[mb] = sn;
    }
}
__device__ __forceinline__ void f_scan2(const bf16_t* __restrict__ X, bf16_t* so, int mc  ) {
    const int TID = ltid();
    const int lane = TID & 63, slab = TID >> 6, c = lane & 15, q = lane >> 4;
    const int mixer = mc >> 4, chain = mc & 15, dir = chain & 1, h = (chain >> 1) & 3, b = chain >> 3;
    const int colbase = mixer * 256 + h * 64 + slab * 16;
    f32x4 S[4];
#pragma unroll
    for (int mb = 0; mb < 4; ++mb) S[mb] = (f32x4){0.f, 0.f, 0.f, 0.f};
    const bf16_t* X0 = X + (size_t)(mc * 132) * 16384;
    ScanOps A, B;
    scan_load(A, X0, slab, lane, c, q);
#pragma unroll 1
    for (int n = 0; n < 132; n += 2) {
        scan_load(B, X0 + (size_t)(n + 1) * 16384, slab, lane, c, q);
        scan_step(A, S, so, b, dir, colbase, n, c, q);
        if (n + 2 < 132) scan_load(A, X0 + (size_t)(n + 2) * 16384, slab, lane, c, q);
        scan_step(B, S, so, b, dir, colbase, n + 1, c, q);
    }
}

__device__ __forceinline__ void f_mix_out_phase(const bf16_t* __restrict__ p, bf16_t* cat, const bf16_t* __restrict__ so, const float* __restrict__ gdn_norm,
                                                 const bf16_t* __restrict__ kd_i, const float* __restrict__ g_up, const float* __restrict__ r_k,
                                                 const float* __restrict__ gn_w, const float* __restrict__ gn_b,
                                                 const bf16_t* __restrict__ OM, const float* __restrict__ da_lambda, const float* __restrict__ da_norm, float lam_init,
                                                 int vb0, int nvb, int nitems, float* lds) {
    const int TID = ltid();
    const int c = TID;
    float* xgT = lds;
    float gu[64];
#pragma unroll
    for (int j = 0; j < 64; ++j) gu[j] = g_up[j * 256 + c];
    const float gnc = gdn_norm[c & 63], rkc = r_k[c], gw = gn_w[c], gb = gn_b[c];
    float s01 = 0.f, s23 = 0.f;
    for (int d = 0; d < 64; ++d) { s01 += da_lambda[d] * da_lambda[64 + d]; s23 += da_lambda[128 + d] * da_lambda[192 + d]; }
    const float lam = expf(s01) - expf(s23) + lam_init;
    const int hw = c >> 6, ln = c & 63;
    const float dg0 = da_norm[ln] * (1.f - lam_init), dg1 = da_norm[ln + 64] * (1.f - lam_init);
    for (int vb = vb0; vb < nitems; vb += nvb) {
        const size_t r0 = (size_t)vb * 8;
        __syncthreads();
#pragma unroll
        for (int t = 0; t < 2; ++t) { const int id = TID + 256 * t, i = id >> 6, j = id & 63; xgT[j * 8 + i] = sigmf(bf2f(p[(r0 + i) * DINP + OXG + j])); }
        {
            float a0[8], a1[8], b0[8], b1[8];
#pragma unroll
            for (int i = 0; i < 8; ++i) {
                const bf16_t* o0 = OM + (r0 + i) * 512 + hw * 128; const bf16_t* o1 = OM + ((size_t)RR + r0 + i) * 512 + hw * 128;
                a0[i] = bf2f(o0[ln]); a1[i] = bf2f(o0[ln + 64]); b0[i] = bf2f(o1[ln]); b1[i] = bf2f(o1[ln + 64]);
            }
#pragma unroll
            for (int i = 0; i < 8; ++i) {
                const float v0 = a0[i] - lam * b0[i], v1 = a1[i] - lam * b1[i];
                const float ssq = wave_sum(v0 * v0 + v1 * v1);
                const float rstd = rsqrtf(ssq * (1.f / 128.f) + 1e-6f);
                cat[(r0 + i) * DM + hw * 128 + ln] = f2bf(v0 * rstd * dg0); cat[(r0 + i) * DM + hw * 128 + ln + 64] = f2bf(v1 * rstd * dg1);
            }
        }
        {
            float o[8], gt[8];
#pragma unroll
            for (int i = 0; i < 8; ++i) { const size_t r = r0 + i; o[i] = bf2f(so[r * 512 + c]) + bf2f(so[((size_t)RR + r) * 512 + c]); gt[i] = bf2f(p[r * DINP + OGGATE + c]); }
#pragma unroll
            for (int i = 0; i < 8; ++i) {
                const float ss = wave_sum(o[i] * o[i]);
                cat[(r0 + i) * DM + 512 + c] = f2bf(o[i] * rsqrtf(ss * (1.f / 64.f) + 1e-6f) * gnc * siluf(gt[i]));
            }
        }
        {
            float yv[8], rr[8], vv[8], kds[8];
#pragma unroll
            for (int i = 0; i < 8; ++i) {
                const size_t r = r0 + i;
                yv[i] = bf2f(so[r * 512 + 256 + c]) + bf2f(so[((size_t)RR + r) * 512 + 256 + c]);
                rr[i] = bf2f(p[r * DINP + ORKV + c]); vv[i] = bf2f(p[r * DINP + ORKV + 512 + c]);
                kds[i] = bf2f(kd_i[r * 512 + c]) + bf2f(kd_i[r * 512 + 256 + c]);
            }
            __syncthreads();
            float g[8];
#pragma unroll
            for (int i = 0; i < 8; ++i) g[i] = 0.f;
#pragma unroll
            for (int j = 0; j < 64; ++j) {
                const f32x4 x0 = *(const f32x4*)(xgT + j * 8), x1 = *(const f32x4*)(xgT + j * 8 + 4);
#pragma unroll
                for (int i = 0; i < 4; ++i) { g[i] += x0[i] * gu[j]; g[4 + i] += x1[i] * gu[j]; }
            }
#pragma unroll
            for (int i = 0; i < 8; ++i) {
                const float mu = wave_sum(yv[i]) * (1.f / 64.f);
                const float dv = yv[i] - mu;
                const float var = wave_sum(dv * dv) * (1.f / 64.f);
                const float yn = dv * rsqrtf(var + 64e-5f) * gw + gb;
                const float bs = wave_sum(rr[i] * kds[i] * rkc);
                cat[(r0 + i) * DM + 768 + c] = f2bf((yn + bs * vv[i]) * g[i]);
            }
        }
    }
}

__device__ __forceinline__ void f_resid1_prep(const float* __restrict__ router, float* lds) {
    const int TID = ltid();
    __syncthreads();
    for (int i = TID; i < DM * NE; i += 256) { const int col = i >> 4, e = i & 15; lds[e * DM + col] = router[i]; }
    __syncthreads();
}
__device__ __forceinline__ void f_resid1(const float* sctx, const float* sx, float* ctxs, float* out, const float* __restrict__ mix, const float* __restrict__ g_post, const float* __restrict__ g_pre2,
                         const float* __restrict__ modl, const float* routerT, bf16_t* h2, float* aff, int vb) {
    const int TID = ltid();
    const int r = vb * 4 + (TID >> 6), lane = TID & 63;
    float* x = xrow_ptr(ctxs, out, r);
    const float* xs = xrow_cptr(sctx, sx, r);
    const float* m = modl + modrow(r) * 6 * DM;
    f32x4 v[4], xv[4]; float ss = 0.f;
#pragma unroll
    for (int j = 0; j < 4; ++j) { v[j] = *(const f32x4*)(mix + (size_t)r * DM + 4 * lane + 256 * j); xv[j] = *(const f32x4*)(xs + 4 * lane + 256 * j); ss += v[j][0] * v[j][0] + v[j][1] * v[j][1] + v[j][2] * v[j][2] + v[j][3] * v[j][3]; }
    ss = wave_sum(ss);
    const float rstd = rsqrtf(ss * (1.f / DM) + 1e-6f);
    float s2 = 0.f;
#pragma unroll
    for (int j = 0; j < 4; ++j) {
        const int c0 = 4 * lane + 256 * j;
        const f32x4 gp = *(const f32x4*)(g_post + c0), gt = *(const f32x4*)(m + 2048 + c0);
        xv[j] = xv[j] + gt * (v[j] * rstd * gp);
        *(f32x4*)(x + c0) = xv[j];
        s2 += xv[j][0] * xv[j][0] + xv[j][1] * xv[j][1] + xv[j][2] * xv[j][2] + xv[j][3] * xv[j][3];
    }
    s2 = wave_sum(s2);
    const float rstd2 = rsqrtf(s2 * (1.f / DM) + 1e-6f);
    f32x4 hv[4];
#pragma unroll
    for (int j = 0; j < 4; ++j) {
        const int c0 = 4 * lane + 256 * j;
        const f32x4 g2 = *(const f32x4*)(g_pre2 + c0), sc = *(const f32x4*)(m + 4096 + c0), sh = *(const f32x4*)(m + 3072 + c0);
        hv[j] = xv[j] * rstd2 * g2 * (1.f + sc) + sh;
        u32x2 o; o[0] = pk2bf(hv[j][0], hv[j][1]); o[1] = pk2bf(hv[j][2], hv[j][3]);
        *(u32x2*)(h2 + (size_t)r * DM + c0) = o;
    }
    float lg[NE];
#pragma unroll
    for (int e = 0; e < NE; ++e) {
        float acc = 0.f;
#pragma unroll
        for (int j = 0; j < 4; ++j) { const f32x4 rt = *(const f32x4*)(routerT + e * DM + 4 * lane + 256 * j); acc += hv[j][0] * rt[0] + hv[j][1] * rt[1] + hv[j][2] * rt[2] + hv[j][3] * rt[3]; }
        lg[e] = acc;
    }
#pragma unroll
    for (int e = 0; e < 8; ++e) { const float give = (lane & 32) ? lg[e] : lg[e + 8], keep = (lane & 32) ? lg[e + 8] : lg[e]; lg[e] = keep + __shfl_xor(give, 32); }
#pragma unroll
    for (int e = 0; e < 4; ++e) { const float give = (lane & 16) ? lg[e] : lg[e + 4], keep = (lane & 16) ? lg[e + 4] : lg[e]; lg[e] = keep + __shfl_xor(give, 16); }
#pragma unroll
    for (int e = 0; e < 2; ++e) { const float give = (lane & 8) ? lg[e] : lg[e + 2], keep = (lane & 8) ? lg[e + 2] : lg[e]; lg[e] = keep + __shfl_xor(give, 8); }
    { const float give = (lane & 4) ? lg[0] : lg[1], keep = (lane & 4) ? lg[1] : lg[0]; lg[0] = keep + __shfl_xor(give, 4); }
    float tot = lg[0];
    tot += __shfl_xor(tot, 2); tot += __shfl_xor(tot, 1);
    const int myexp = ((lane >> 5) & 1) * 8 + ((lane >> 4) & 1) * 4 + ((lane >> 3) & 1) * 2 + ((lane >> 2) & 1);
    float mxv = tot;
#pragma unroll
    for (int o = 4; o < 64; o <<= 1) mxv = fmaxf(mxv, __shfl_xor(mxv, o));
    const float ex = expf(tot - mxv);
    float sum = ex;
#pragma unroll
    for (int o = 4; o < 64; o <<= 1) sum += __shfl_xor(sum, o);
    if ((lane & 3) == 0) aff[(size_t)r * NE + myexp] = ex / sum;
}

__device__ __forceinline__ void f_topk(const float* __restrict__ aff, int* sel_lat, int* sel_ctx, int* slot, int vb, float* lds) {
    const int TID = ltid();
    unsigned* vals = (unsigned*)lds;
    unsigned* hist = (unsigned*)lds + 8192 + 256;
    unsigned* sc = hist + 256;
    unsigned* ctl = sc + 512;
    const int set = vb >> 5, b = (vb >> 4) & 1, e = vb & 15;
    const int n = set == 0 ? TL : CL, cap = set == 0 ? CAPL : CAPC;
    const int per = n >> 8;
    const int rbase = b * SS + (set == 0 ? CL : 0);
    __syncthreads();
    for (int t = TID; t < n; t += 256) vals[t + (t >> 5)] = __float_as_uint(aff[(size_t)(rbase + t) * NE + e]);
    if (TID == 0) { ctl[0] = 0u; ctl[1] = (unsigned)cap; }
    __syncthreads();
    for (int pass = 0; pass < 4; ++pass) {
        const int shift = 24 - 8 * pass;
        hist[TID] = 0u;
        __syncthreads();
        const unsigned prefix = ctl[0];
        const unsigned pmask = pass == 0 ? 0u : (0xffffffffu << (shift + 8));
        for (int j = 0; j < per; ++j) {
            const int t = TID * per + j;
            const unsigned v = vals[t + (t >> 5)];
            if ((v & pmask) == prefix) atomicAdd(&hist[(v >> shift) & 255u], 1u);
        }
        __syncthreads();
        {
            const unsigned hc = hist[255 - TID], rem = ctl[1];
            sc[TID] = hc; __syncthreads();
            for (int o = 1; o < 256; o <<= 1) { const unsigned add = TID >= o ? sc[TID - o] : 0u; __syncthreads(); sc[TID] += add; __syncthreads(); }
            const unsigned cum = sc[TID];
            __syncthreads();
            if (cum >= rem && cum - hc < rem) { ctl[0] = prefix | ((unsigned)(255 - TID) << shift); ctl[1] = rem - (cum - hc); }
        }
        __syncthreads();
    }
    const unsigned thr = ctl[0], need_eq = ctl[1];
    unsigned cg = 0u, ce = 0u;
    for (int j = 0; j < per; ++j) { const int t = TID * per + j; const unsigned v = vals[t + (t >> 5)]; cg += v > thr ? 1u : 0u; ce += v == thr ? 1u : 0u; }
    sc[TID] = ce; __syncthreads();
    for (int o = 1; o < 256; o <<= 1) { const unsigned add = TID >= o ? sc[TID - o] : 0u; __syncthreads(); sc[TID] += add; __syncthreads(); }
    const unsigned eq_before = sc[TID] - ce;
    const unsigned eq_take = eq_before >= need_eq ? 0u : (need_eq - eq_before < ce ? need_eq - eq_before : ce);
    const unsigned csel = cg + eq_take;
    sc[256 + TID] = csel; __syncthreads();
    for (int o = 1; o < 256; o <<= 1) { const unsigned add = TID >= o ? sc[256 + TID - o] : 0u; __syncthreads(); sc[256 + TID] += add; __syncthreads(); }
    unsigned pos = sc[256 + TID] - csel;
    unsigned eq_seen = eq_before;
    for (int j = 0; j < per; ++j) {
        const int t = TID * per + j; const unsigned v = vals[t + (t >> 5)];
        bool take = v > thr;
        if (v == thr) { take = eq_seen < need_eq; ++eq_seen; }
        int sl = -1;
        if (take) { sl = (int)pos; ++pos; if (set == 0) sel_lat[(b * NE + e) * CAPL + sl] = rbase + t; else sel_ctx[(b * NE + e) * CAPC + sl] = rbase + t; }
        slot[(size_t)e * RR + rbase + t] = sl;
    }
}

__device__ __forceinline__ void f_resid2(float* ctxs, float* out, const bf16_t* __restrict__ ye_lat, const bf16_t* __restrict__ ye_ctx, const int* __restrict__ slot,
                         const float* __restrict__ g_post, const float* __restrict__ modl, const float* g_next, const float* modn, bf16_t* hn, int vb) {
    const int TID = ltid();
    const int r = vb * 4 + (TID >> 6), lane = TID & 63;
    float* x = xrow_ptr(ctxs, out, r);
    const float* m = modl + modrow(r) * 6 * DM;
    const int b = r >= SS ? 1 : 0, s = r - b * SS;
    if (!g_next && s < CL) return;
    const int myslot = slot[(size_t)(lane & 15) * RR + r];
    f32x4 xv[4];
#pragma unroll
    for (int j = 0; j < 4; ++j) xv[j] = *(const f32x4*)(x + 4 * lane + 256 * j);
    f32x4 y[4];
#pragma unroll
    for (int j = 0; j < 4; ++j) y[j] = (f32x4){0.f, 0.f, 0.f, 0.f};
    unsigned long long mask = __ballot(myslot >= 0) & 0xffffull;
    while (mask) {
        const int e = __builtin_ctzll(mask); mask &= mask - 1;
        const int sl = __shfl(myslot, e);
        const bf16_t* src = s < CL ? ye_ctx + ((size_t)(b * NE + e) * CAPC + sl) * DM : ye_lat + ((size_t)(b * NE + e) * CAPL + sl) * DM;
#pragma unroll
        for (int j = 0; j < 4; ++j) {
            const u32x2 w = *(const u32x2*)(src + 4 * lane + 256 * j);
            y[j][0] += bf2f((bf16_t)(w[0] & 0xffffu)); y[j][1] += bf2f((bf16_t)(w[0] >> 16)); y[j][2] += bf2f((bf16_t)(w[1] & 0xffffu)); y[j][3] += bf2f((bf16_t)(w[1] >> 16));
        }
    }
    float ss = 0.f;
#pragma unroll
    for (int j = 0; j < 4; ++j) ss += y[j][0] * y[j][0] + y[j][1] * y[j][1] + y[j][2] * y[j][2] + y[j][3] * y[j][3];
    ss = wave_sum(ss);
    const float rstd = rsqrtf(ss * (1.f / DM) + 1e-6f);
#pragma unroll
    for (int j = 0; j < 4; ++j) {
        const int c0 = 4 * lane + 256 * j;
        const f32x4 gp = *(const f32x4*)(g_post + c0), gt = *(const f32x4*)(m + 5120 + c0);
        xv[j] = xv[j] + gt * (y[j] * rstd * gp);
        *(f32x4*)(x + c0) = xv[j];
    }
    if (g_next) {
        const float* mn = modn + modrow(r) * 6 * DM;
        float s2 = 0.f;
#pragma unroll
        for (int j = 0; j < 4; ++j) s2 += xv[j][0] * xv[j][0] + xv[j][1] * xv[j][1] + xv[j][2] * xv[j][2] + xv[j][3] * xv[j][3];
        s2 = wave_sum(s2);
        const float rstd2 = rsqrtf(s2 * (1.f / DM) + 1e-6f);
#pragma unroll
        for (int j = 0; j < 4; ++j) {
            const int c0 = 4 * lane + 256 * j;
            const f32x4 gg = *(const f32x4*)(g_next + c0), sc = *(const f32x4*)(mn + 1024 + c0), sh = *(const f32x4*)(mn + c0);
            const f32x4 o4 = xv[j] * rstd2 * gg * (1.f + sc) + sh;
            u32x2 o; o[0] = pk2bf(o4[0], o4[1]); o[1] = pk2bf(o4[2], o4[3]);
            *(u32x2*)(hn + (size_t)r * DM + c0) = o;
        }
    }
}

#define XB_TMO      128
#define XB_XCNT(j)  (256  + 64 * (j))
#define XB_XSUB(j)  (1280 + 64 * (j))
#define XB_XGEN(j)  (2304 + 64 * (j))
#define XB_TOP      3328
#define XB_TOPGEN   3392
#define XCD_BAR_WORDS 3456
#define XB_SPIN_CAP (1u << 18)
__device__ __forceinline__ unsigned xb_ld(unsigned* p)              { return __hip_atomic_load(p, __ATOMIC_RELAXED, __HIP_MEMORY_SCOPE_AGENT); }
__device__ __forceinline__ unsigned xb_add(unsigned* p, unsigned v) { return __hip_atomic_fetch_add(p, v, __ATOMIC_RELAXED, __HIP_MEMORY_SCOPE_AGENT); }
__device__ __forceinline__ unsigned xb_xcc_id() { return (unsigned)__builtin_amdgcn_s_getreg((3 << 11) | 20) & 0xFu; }
#define XB_SPIN(cond, bar) do { unsigned _sp = 0; while (cond) { __builtin_amdgcn_s_sleep(1); \
    if ((++_sp & 255u) == 0u) { if (xb_ld(&(bar)[XB_TMO])) break; if (_sp > XB_SPIN_CAP) { atomicAdd(&(bar)[XB_TMO], 1u); break; } } } } while (0)
__device__ __forceinline__ void xcd_barrier_complete(unsigned* bar, unsigned x, unsigned& nloc, unsigned& nx) {
    const unsigned G = gridDim.x * gridDim.y * gridDim.z;
    unsigned sum, cntx, mine, sp = 0u;
    for (;;) {
        sum = 0u; cntx = 0u; mine = 0u;
#pragma unroll
        for (unsigned j = 0; j < 16; ++j) { const unsigned c = xb_ld(&bar[XB_XCNT(j)]); sum += c; cntx += (c > 0u) ? 1u : 0u; mine = (j == x) ? c : mine; }
        if (sum == G) break;
        __builtin_amdgcn_s_sleep(1);
        if ((++sp & 255u) == 0u) { if (xb_ld(&bar[XB_TMO])) break; if (sp > XB_SPIN_CAP) { atomicAdd(&bar[XB_TMO], 1u); break; } }
    }
    nloc = mine > 0u ? mine : 1u; nx = cntx > 0u ? cntx : 1u;
}
__device__ __forceinline__ void xcd_barrier(unsigned* bar, volatile unsigned* st) {
    asm volatile("s_waitcnt vmcnt(0)" ::: "memory");
    __syncthreads();
    if (threadIdx.x == 0) {
        __builtin_amdgcn_s_waitcnt(0);
        const unsigned x = st[2];
        unsigned nloc = st[0], nx = st[1];
        if (nloc == 0u) { xcd_barrier_complete(bar, x, nloc, nx); st[0] = nloc; st[1] = nx; }
        const unsigned old = xb_add(&bar[XB_XSUB(x)], 1u);
        const unsigned gen = old / nloc;
        if (old + 1u == (gen + 1u) * nloc) {
            __builtin_amdgcn_fence(__ATOMIC_RELEASE, "agent");
            asm volatile("s_waitcnt vmcnt(0)" ::: "memory");
            const unsigned og = xb_add(&bar[XB_TOP], 1u);
            const unsigned tg = og / nx;
            if (og + 1u == (tg + 1u) * nx) xb_add(&bar[XB_TOPGEN], 1u);
            else XB_SPIN(xb_ld(&bar[XB_TOPGEN]) == tg, bar);
            __builtin_amdgcn_fence(__ATOMIC_ACQUIRE, "agent");
            xb_add(&bar[XB_XGEN(x)], 1u);
            asm volatile("s_waitcnt vmcnt(0)" ::: "memory");
        } else {
            XB_SPIN(xb_ld(&bar[XB_XGEN(x)]) == gen, bar);
            __builtin_amdgcn_fence(__ATOMIC_ACQUIRE, "agent");
            asm volatile("s_waitcnt vmcnt(0)" ::: "memory");
        }
    }
    __syncthreads();
}
#ifndef CHUNKREP
#define CHUNKREP 1
#endif
#ifndef REPMASK
#define REPMASK 0
#endif
#define REPS(k) for (int rep_ = 0; rep_ < (((REPMASK) >> (k)) & 1) + 1; ++rep_)
struct MP { const float* in[30]; float* out; char* ws; };
enum { I_X = 0, I_C, I_CTX, I_CCTX, I_WMOD, I_BMOD, I_NPRE, I_NPOST, I_WIN, I_WOUT, I_LAM, I_DAN, I_GCONV, I_GALOG, I_GDT, I_GNORM,
       I_W0, I_WUP, I_A0, I_AUP, I_GUP, I_KK, I_KA, I_RK, I_GNW, I_GNB, I_ROUTER, I_MGATE, I_MUP, I_MDOWN };
constexpr int PB_NPRE = 0, PB_NPOST = PB_NPRE + 4096, PB_LAM = PB_NPOST + 4096, PB_DAN = PB_LAM + 512, PB_GCONV = PB_DAN + 256, PB_GALOG = PB_GCONV + 7680,
              PB_GDT = PB_GALOG + 16, PB_GNORM = PB_GDT + 16, PB_W0 = PB_GNORM + 128, PB_WUP = PB_W0 + 1024, PB_A0 = PB_WUP + 32768, PB_AUP = PB_A0 + 1024,
              PB_GUP = PB_AUP + 32768, PB_KK = PB_GUP + 32768, PB_KA = PB_KK + 512, PB_RK = PB_KA + 512, PB_GNW = PB_RK + 512, PB_GNB = PB_GNW + 512,
              PB_ROUTER = PB_GNB + 512, PB_END = PB_ROUTER + 32768;
constexpr size_t al256c(size_t x) { return (x + 255) & ~(size_t)255; }
constexpr size_t WS_BAR = 0, WS_CNT = 16384, WS_PRM = 16384 + 256, WS_MOD = al256c(WS_PRM + (size_t)PB_END * 4), WS_CTXS = al256c(WS_MOD + (size_t)2 * 3 * 6 * DM * 4),
                 WS_AFF = al256c(WS_CTXS + (size_t)NB * CL * DM * 4), WS_TAB = al256c(WS_AFF + (size_t)RR * NE * 4), WS_SLOT = al256c(WS_TAB + (size_t)128 * 16 * 8),
                 WS_SELL = al256c(WS_SLOT + (size_t)NE * RR * 4), WS_SELC = al256c(WS_SELL + (size_t)32 * CAPL * 4), WS_WTIN = al256c(WS_SELC + (size_t)32 * CAPC * 4),
                 WS_WTOUT = al256c(WS_WTIN + (size_t)2 * DINP * DM * 2), WS_BUFA = al256c(WS_WTOUT + (size_t)2 * DM * DM * 2), WS_SO = al256c(WS_BUFA + (size_t)RR * DM * 2),
                 WS_P = al256c(WS_SO + (size_t)2 * RR * 512 * 2), WS_R3 = al256c(WS_P + (size_t)RR * DINP * 2), WS_VT = al256c(WS_R3 + (size_t)RR * 6208),
                 WS_OM = al256c(WS_VT + (size_t)NB * 4 * 128 * SS * 2), WS_XC = al256c(WS_OM + (size_t)2 * RR * 512 * 2), WS_END = al256c(WS_XC + (size_t)32 * 132 * 16384 * 2);

__device__ __forceinline__ char* lptr(char* p) { asm volatile("" : "+s"(p)); return p; }
#define PHASE char* const W = lptr(a.ws); float* const out = (float*)lptr((char*)a.out); (void)W; (void)out;
#define bar ((unsigned*)(W + WS_BAR))
#define cnt ((int*)(W + WS_CNT))
#define prm ((float*)(W + WS_PRM))
#define mod ((float*)(W + WS_MOD))
#define ctxs ((float*)(W + WS_CTXS))
#define aff ((float*)(W + WS_AFF))
#define tab ((float2*)(W + WS_TAB))
#define slot ((int*)(W + WS_SLOT))
#define sel_lat ((int*)(W + WS_SELL))
#define sel_ctx ((int*)(W + WS_SELC))
#define wt_in ((bf16_t*)(W + WS_WTIN))
#define wt_out ((bf16_t*)(W + WS_WTOUT))
#define bufA ((bf16_t*)(W + WS_BUFA))
#define so ((bf16_t*)(W + WS_SO))
#define P ((bf16_t*)(W + WS_P))
#define R3 ((bf16_t*)(W + WS_R3))
#define VT ((bf16_t*)(W + WS_VT))
#define XC ((bf16_t*)(W + WS_XC))
#define OM ((bf16_t*)(W + WS_OM))
#define gq R3
#define gk (R3 + (size_t)RR * 256)
#define gv (R3 + (size_t)RR * 512)
#define kk_b (R3 + (size_t)RR * 768)
#define kka_b (R3 + (size_t)RR * 1024)
#define kd_b (R3 + (size_t)RR * 1536)
#define w_b ((float*)(R3 + (size_t)RR * 2048))
#define gab (w_b + (size_t)RR * 512)
#define mix ((float*)R3)
#define ye_lat R3
#define ye_ctx (R3 + (size_t)32 * CAPL * DM)
#define hid_lat P
#define hid_ctx (P + (size_t)32 * CAPL * DM)
#define h bufA
#define cat bufA
#define h2 bufA
#define wt_gu XC
#define wt_dn (XC + (size_t)NE * 2 * DM * DM)
#define modl (mod + (size_t)i * 3 * 6 * DM)
#define GBAR { PHASE xcd_barrier(bar, (volatile unsigned*)(lds + 18432 + 132)); }

__global__ __launch_bounds__(256, 2) void mega(MP a) {
    __shared__ __attribute__((aligned(16))) float lds[18432 + 256];
    const int nb = gridDim.x, bid = blockIdx.x;
    if (threadIdx.x == 0) {
        volatile unsigned* st = (volatile unsigned*)(lds + 18432 + 132);
        st[0] = 0u; st[1] = 0u; st[2] = xb_xcc_id();
        (void)xb_add(&((unsigned*)(a.ws + WS_BAR))[XB_XCNT(st[2])], 1u);
    }
    __syncthreads();

    {
    PHASE
    if (bid == 0 && threadIdx.x < 64) cnt[threadIdx.x] = 0;
    {
        const int gt = lsgpr(bid) * 256 + ltid(), gn = nb * 256;
#define CPY(idx, off, n) for (int q_ = gt; q_ < (n); q_ += gn) prm[(off) + q_] = a.in[idx][q_];
        CPY(I_NPRE, PB_NPRE, 4096) CPY(I_NPOST, PB_NPOST, 4096) CPY(I_LAM, PB_LAM, 512) CPY(I_DAN, PB_DAN, 256) CPY(I_GCONV, PB_GCONV, 7680) CPY(I_GALOG, PB_GALOG, 16)
        CPY(I_GDT, PB_GDT, 16) CPY(I_GNORM, PB_GNORM, 128) CPY(I_W0, PB_W0, 1024) CPY(I_WUP, PB_WUP, 32768) CPY(I_A0, PB_A0, 1024) CPY(I_AUP, PB_AUP, 32768)
        CPY(I_GUP, PB_GUP, 32768) CPY(I_KK, PB_KK, 512) CPY(I_KA, PB_KA, 512) CPY(I_RK, PB_RK, 512) CPY(I_GNW, PB_GNW, 512) CPY(I_GNB, PB_GNB, 512) CPY(I_ROUTER, PB_ROUTER, 32768)
#undef CPY
    }
    REPS(0) {
    for (int vb = lsgpr(bid); vb < 384; vb += nb) f_mod1(a.in[I_C], a.in[I_CCTX], a.in[I_WMOD], (float*)XC, vb, lds);
    for (int i = lsgpr(bid) * 256 + ltid(); i < 128 * 16; i += nb * 256) {
        int pos = i >> 4, f = i & 15;
        float ang = (float)pos * powf(10000.f, -(float)f / 16.f);
        tab[i] = make_float2(cosf(ang), sinf(ang));
    }
    {
        const int T_IN = 2 * 16 * 28, T_OUT = 2 * 16 * 8;
        for (int vb = lsgpr(bid); vb < T_IN + T_OUT; vb += nb) {
            int t = vb;
            if (t < T_IN) { int l = t / (16 * 28), q = t % (16 * 28); f_wconv(a.in[I_WIN] + (size_t)l * DM * DIN, DIN, wt_in + (size_t)l * DINP * DM, 0, q / 28, q % 28, lds); continue; }
            t -= T_IN;
            { int l = t / 128, q = t % 128; f_wconv(a.in[I_WOUT] + (size_t)l * DM * DM, DM, wt_out + (size_t)l * DM * DM, 0, q / 8, q % 8, lds); }
        }
    }
    }
    }
    GBAR
    { PHASE for (int vb = lsgpr(bid); vb < (2 * 3 * 6 * DM) / 256; vb += nb) f_mod2((const float*)XC, a.in[I_BMOD], mod, vb); }
    GBAR

    _Pragma("unroll") for (int i = 0; i < 2; ++i) {
        const float lam_init = 0.8f - 0.6f * expf(-0.3f * (float)i);
        if (i == 0) {
        { PHASE
        if (i == 0) REPS(1) for (int vb = lsgpr(bid); vb < RR / 4; vb += nb) f_normmod(i == 0 ? a.in[I_CTX] : (const float*)ctxs, i == 0 ? a.in[I_X] : (const float*)out, (prm + PB_NPRE) + (size_t)(i * 2 + 0) * DM, modl, 0, 1024, h, vb);
        }
        GBAR
        }
        { PHASE
        REPS(2) for (int vb = lsgpr(bid); vb < 132 * 28; vb += nb) {
            const int mt = vb / 28, nt = vb % 28;
            RowDense ap{h + (size_t)mt * 128 * DM, DM}; RowDense bp{wt_in + (size_t)i * DINP * DM + (size_t)nt * 128 * DM, DM};
            EpiInProj ep{P, VT, tab, mt * 128, nt * 128};
            gemm128(ap, bp, DM, ep, (char*)lds);
        }
        }
        GBAR
        { PHASE
        REPS(3) for (int vb = lsgpr(bid); vb < RR / 8; vb += nb) f_gdn_prep(P, (prm + PB_GCONV) + (size_t)i * 5 * 768, (prm + PB_GALOG) + i * 8, (prm + PB_GDT) + i * 8, gq, gk, gv, gab, vb);
        REPS(4) f_rwkv_prep_phase(P, (prm + PB_W0) + i * 512, (prm + PB_WUP) + (size_t)i * 2 * 32 * 256, (prm + PB_A0) + i * 512, (prm + PB_AUP) + (size_t)i * 2 * 32 * 256,
                                  (prm + PB_KK) + i * 256, (prm + PB_KA) + i * 256, kk_b, w_b, kka_b, kd_b, lsgpr(bid), nb, RR / 8, lds);
        }
        GBAR
        { PHASE
        for (int vb_ = lsgpr(bid); vb_ < 32 * 132 * CHUNKREP; vb_ += nb) {
            const int vb = vb_ % (32 * 132);
            const int mc = vb / 132, n = vb % 132;
            if (mc < 16) f_chunk_gdn(gq, gk, gv, gab, XC, mc, n, (char*)lds);
            else f_chunk_rwkv(P, kk_b, w_b, kka_b, kd_b, XC, mc - 16, n, (char*)lds);
        }
        }
        GBAR
        { PHASE
        REPS(6) if (lsgpr(bid) < 32) f_scan2(XC, so, bid);
        REPS(7) {
            const int per_q = i == 0 ? 132 : 128;
            int* sidx = (int*)(lds + 18432 + 128);
            const int q0 = (int)(((volatile unsigned*)(lds + 18432 + 132))[2] & 7u);
            for (int qi = 0; qi < 8; ++qi) {
                const int q = (q0 + qi) & 7;
                for (;;) {
                    __syncthreads();
                    if (threadIdx.x == 0) *sidx = atomicAdd(cnt + 16 * (i + 2 * rep_) + q, 1);
                    __syncthreads();
                    const int u = *sidx;
                    if (u >= per_q) break;
                    const int uqb = u < 128 ? 2 + (u >> 1) : ((u - 128) >> 1);
                    f_attn(P, VT, OM, q, u & 1, uqb, (char*)lds);
                }
            }
        }
        }
        GBAR
        { PHASE
        REPS(8) f_mix_out_phase(P, cat, so, (prm + PB_GNORM) + i * 64, kd_b, (prm + PB_GUP) + (size_t)i * 64 * 256, (prm + PB_RK) + i * 256, (prm + PB_GNW) + i * 256, (prm + PB_GNB) + i * 256,
                                OM, (prm + PB_LAM) + (size_t)i * 256, (prm + PB_DAN) + (size_t)i * 128, lam_init, lsgpr(bid), nb, RR / 8, lds);
        REPS(9) for (int vb = lsgpr(bid); vb < 3 * 2048; vb += nb) {
            const int which = vb / 2048, q = vb % 2048, e = q / 128, qq = q % 128;
            const size_t le = (size_t)(i * NE + e);
            if (which == 0) f_wconv(a.in[I_MGATE] + le * DM * DM, DM, wt_gu + (size_t)e * 2 * DM * DM, 1, qq / 8, qq % 8, lds);
            else if (which == 1) f_wconv(a.in[I_MUP] + le * DM * DM, DM, wt_gu + (size_t)e * 2 * DM * DM, 2, qq / 8, qq % 8, lds);
            else f_wconv(a.in[I_MDOWN] + le * DM * DM, DM, wt_dn + (size_t)e * DM * DM, 0, qq / 8, qq % 8, lds);
        }
        }
        GBAR
        { PHASE
        REPS(10) for (int vb = lsgpr(bid); vb < 132 * 8; vb += nb) {
            const int mt = vb / 8, nt = vb % 8;
            RowDense ap{cat + (size_t)mt * 128 * DM, DM}; RowDense bp{wt_out + (size_t)i * DM * DM + (size_t)nt * 128 * DM, DM};
            EpiF32 ep{mix, DM, mt * 128, nt * 128};
            gemm128(ap, bp, DM, ep, (char*)lds);
        }
        }
        GBAR
        { PHASE
        f_resid1_prep((prm + PB_ROUTER) + (size_t)i * DM * NE, lds);
        for (int vb = lsgpr(bid); vb < RR / 4; vb += nb) f_resid1(i == 0 ? a.in[I_CTX] : (const float*)ctxs, i == 0 ? a.in[I_X] : (const float*)out, ctxs, out, mix, (prm + PB_NPOST) + (size_t)(i * 2 + 0) * DM, (prm + PB_NPRE) + (size_t)(i * 2 + 1) * DM, modl, lds, h2, aff, vb);
        }
        GBAR
        { PHASE
        REPS(11) for (int vb = lsgpr(bid); vb < (i == 0 ? 64 : 32); vb += nb) f_topk(aff, sel_lat, sel_ctx, slot, vb, lds);
        }
        GBAR
        { PHASE
        REPS(12) for (int vb = lsgpr(bid); vb < 32 * 8 * 16 + (i == 0 ? 32 * 16 : 0); vb += nb) {
            int g, mt, nt, cap; const int* sel; bf16_t* hid;
            if (vb < 32 * 8 * 16) { g = vb / 128; mt = (vb % 128) / 16; nt = vb % 16; cap = CAPL; sel = sel_lat + g * CAPL; hid = hid_lat + (size_t)g * CAPL * DM; }
            else { int t = vb - 32 * 8 * 16; g = t / 16; mt = 0; nt = t % 16; cap = CAPC; sel = sel_ctx + g * CAPC; hid = hid_ctx + (size_t)g * CAPC * DM; }
            const int e = g % NE;
            RowGather ap{h2, sel + mt * 128, cap - mt * 128}; RowDense bp{wt_gu + ((size_t)e * 2 * DM + (size_t)nt * 128) * DM, DM};
            EpiMoE1 ep{hid, mt * 128, nt * 128, cap};
            gemm128(ap, bp, DM, ep, (char*)lds);
        }
        }
        GBAR
        { PHASE
        REPS(13) for (int vb = lsgpr(bid); vb < 32 * 8 * 8 + (i == 0 ? 32 * 8 : 0); vb += nb) {
            int g, mt, nt, cap; const int* sel; const bf16_t* hid; bf16_t* ye;
            if (vb < 32 * 8 * 8) { g = vb / 64; mt = (vb % 64) / 8; nt = vb % 8; cap = CAPL; sel = sel_lat + g * CAPL; hid = hid_lat + (size_t)g * CAPL * DM; ye = ye_lat + (size_t)g * CAPL * DM; }
            else { int t = vb - 32 * 8 * 8; g = t / 8; mt = 0; nt = t % 8; cap = CAPC; sel = sel_ctx + g * CAPC; hid = hid_ctx + (size_t)g * CAPC * DM; ye = ye_ctx + (size_t)g * CAPC * DM; }
            const int e = g % NE;
            RowDense ap{hid + (size_t)mt * 128 * DM, DM}; RowDense bp{wt_dn + ((size_t)e * DM + (size_t)nt * 128) * DM, DM};
            EpiMoE2 ep{ye, aff, sel, e, mt * 128, nt * 128, cap};
            gemm128(ap, bp, DM, ep, (char*)lds);
        }
        }
        GBAR
        { PHASE
        for (int vb = lsgpr(bid); vb < RR / 4; vb += nb) f_resid2(ctxs, out, ye_lat, ye_ctx, slot, (prm + PB_NPOST) + (size_t)(i * 2 + 1) * DM, modl, i == 0 ? (prm + PB_NPRE) + (size_t)2 * DM : (const float*)nullptr, mod + (size_t)3 * 6 * DM, h, vb);
        }
        GBAR
    }
}

#undef bar
#undef cnt
#undef prm
#undef mod
#undef ctxs
#undef aff
#undef tab
#undef slot
#undef sel_lat
#undef sel_ctx
#undef wt_in
#undef wt_out
#undef bufA
#undef so
#undef P
#undef R3
#undef VT
#undef XC
#undef OM
#undef gq
#undef gk
#undef gv
#undef kk_b
#undef kka_b
#undef kd_b
#undef w_b
#undef gab
#undef mix
#undef ye_lat
#undef ye_ctx
#undef hid_lat
#undef hid_ctx
#undef h
#undef cat
#undef h2
#undef wt_gu
#undef wt_dn
#undef modl
extern "C" void kernel_launch(void* const* d_in, const int* in_sizes, int n_in, void* d_out, int out_size, void* d_ws, size_t ws_size, hipStream_t stream) {
    static int grid_blocks = 0;
    if (!grid_blocks) {
        int dev = 0, cus = 0, per_cu = 0;
        (void)hipGetDevice(&dev);
        (void)hipDeviceGetAttribute(&cus, hipDeviceAttributeMultiprocessorCount, dev);
        (void)hipOccupancyMaxActiveBlocksPerMultiprocessor(&per_cu, mega, 256, 0);
        if (per_cu < 1) per_cu = 1;
        if (per_cu > 2) per_cu = 2;
        grid_blocks = cus * per_cu;
    }
    if (WS_END > ws_size) { fprintf(stderr, "workspace too small: need %zu have %zu\n", (size_t)WS_END, ws_size); return; }
    MP a{};
    for (int i = 0; i < 30; ++i) a.in[i] = (const float*)d_in[i];
    a.out = (float*)d_out; a.ws = (char*)d_ws;
    (void)hipMemsetAsync((char*)d_ws + WS_BAR, 0, 16384 + 256, stream);
    void* args[] = {&a};
    hipError_t e = hipLaunchCooperativeKernel((void*)mega, dim3(grid_blocks), dim3(256), args, 0, stream);
    if (e != hipSuccess) fprintf(stderr, "cooperative launch failed: %s (grid %d)\n", hipGetErrorString(e), grid_blocks);
}
```
